# Optimizing an MI355X kernel written in HIP

```python
import math
import jax, jax.numpy as jnp
from jax import lax
import numpy as np

D_MODEL = 1024
BATCH = 8
SEQ = 4096
DEPTH = 4

HEAD_DIM = 64
N_HEADS = D_MODEL // HEAD_DIM
SWA_HEADS = N_HEADS // 4
SWA_KV_HEADS = SWA_HEADS // 2
SWA_WINDOW = 128
FOX_HEADS = N_HEADS // 4
NSA_HEADS = N_HEADS // 2
NSA_KV_HEADS = NSA_HEADS // 4
NSA_CMP_LEN = 32
NSA_CMP_STRIDE = 16
NSA_CMP_HIDDEN = 2 * HEAD_DIM
NSA_SLC_BLOCK = 64
NSA_TOPK = 16
NSA_WINDOW = 512
NSA_QUERY_BLOCK = 64
QUERY_BLOCK = 128
REL_BUCKETS = 32
REL_MAX_DISTANCE = 1024
BIAS_HEADS = SWA_HEADS + NSA_HEADS
FFN_HIDDEN = ((8 * D_MODEL + 3 * 256 - 1) // (3 * 256)) * 256
ADA_CHUNKS = 6
RMS_EPS = 1e-6
NEG_INF = -1e30
FORCE_SELECT = 1e30
SWA_WIDTH = SWA_HEADS * HEAD_DIM
FOX_WIDTH = FOX_HEADS * HEAD_DIM
NSA_WIDTH = NSA_HEADS * HEAD_DIM
NSA_KV_WIDTH = NSA_KV_HEADS * HEAD_DIM
IN_SPLITS = (
    SWA_WIDTH, SWA_KV_HEADS * HEAD_DIM, SWA_KV_HEADS * HEAD_DIM,
    FOX_WIDTH, FOX_WIDTH, FOX_WIDTH, FOX_HEADS,
    NSA_WIDTH,
    NSA_KV_WIDTH, NSA_KV_WIDTH,
    NSA_KV_WIDTH, NSA_KV_WIDTH,
    NSA_KV_WIDTH, NSA_KV_WIDTH,
    NSA_HEADS * 3,
)
N_IN = sum(IN_SPLITS)

kernel_name = "hybrid_swa_fox_nsa_block"


def rms_norm(x, gain):
    x32 = x.astype(jnp.float32)
    y = x32 * lax.rsqrt(jnp.mean(x32 * x32, axis=-1, keepdims=True) + RMS_EPS)
    return (y * gain.astype(jnp.float32)).astype(x.dtype)


def t5_bucket(dist):
    n = jnp.maximum(dist, 0)
    max_exact = REL_BUCKETS // 2
    nf = jnp.maximum(n, 1).astype(jnp.float32)
    large = max_exact + (jnp.log(nf / max_exact) / math.log(REL_MAX_DISTANCE / max_exact)
                         * (REL_BUCKETS - max_exact)).astype(jnp.int32)
    large = jnp.minimum(large, REL_BUCKETS - 1)
    return jnp.where(n < max_exact, n, large)


def split_heads(t, n_heads):
    return t.reshape(t.shape[0], t.shape[1], n_heads, HEAD_DIM)


def banded_attention(q, k, v, window, bias_table, sinks):
    b, s_len, h, d = q.shape
    hkv = k.shape[2]
    g = h // hkv
    n_blk = s_len // QUERY_BLOCK
    n_back = -(-(window - 1) // QUERY_BLOCK)
    pad = n_back * QUERY_BLOCK
    lk = pad + QUERY_BLOCK
    kp = jnp.pad(k, ((0, 0), (pad, 0), (0, 0), (0, 0)))
    vp = jnp.pad(v, ((0, 0), (pad, 0), (0, 0), (0, 0)))
    dist = jnp.arange(QUERY_BLOCK)[:, None] + pad - jnp.arange(lk)[None, :]
    in_window = (dist >= 0) & (dist < window)
    bias = bias_table[t5_bucket(dist)].astype(jnp.float32).transpose(2, 0, 1).reshape(hkv, g, QUERY_BLOCK, lk)
    q_blocks = jnp.moveaxis(q.reshape(b, n_blk, QUERY_BLOCK, hkv, g, d), 1, 0)
    scale = 1.0 / math.sqrt(d)

    def one_block(args):
        i, q_blk = args
        start = i * QUERY_BLOCK
        k_blk = lax.dynamic_slice_in_dim(kp, start, lk, axis=1)
        v_blk = lax.dynamic_slice_in_dim(vp, start, lk, axis=1)
        key_pos = start - pad + jnp.arange(lk)
        valid = in_window & (key_pos >= 0)[None, :]
        logits = jnp.einsum('bqhgd,bkhd->bhgqk', q_blk, k_blk).astype(jnp.float32) * scale + bias
        logits = jnp.where(valid, logits, NEG_INF)
        if sinks is None:
            p = jax.nn.softmax(logits, axis=-1)
        else:
            sink = sinks.astype(jnp.float32).reshape(1, hkv, g, 1, 1)
            m = jnp.maximum(jnp.max(logits, axis=-1, keepdims=True), sink)
            e = jnp.exp(logits - m)
            p = e / (jnp.sum(e, axis=-1, keepdims=True) + jnp.exp(sink - m))
        return jnp.einsum('bhgqk,bkhd->bqhgd', p.astype(v.dtype), v_blk)

    out = lax.map(one_block, (jnp.arange(n_blk), q_blocks))
    return jnp.moveaxis(out, 0, 1).reshape(b, s_len, h * d)


def forgetting_attention(q, k, v, log_f):
    b, s_len, h, d = q.shape
    n_blk = s_len // QUERY_BLOCK
    cum = lax.cumsum(log_f.astype(jnp.float32), axis=1)
    cum_k = cum.transpose(0, 2, 1)
    q_blocks = jnp.moveaxis(q.reshape(b, n_blk, QUERY_BLOCK, h, d), 1, 0)
    cum_q_blocks = jnp.moveaxis(cum_k.reshape(b, h, n_blk, QUERY_BLOCK), 2, 0)
    key_pos = jnp.arange(s_len)
    scale = 1.0 / math.sqrt(d)

    def one_block(args):
        i, q_blk, cq = args
        q_pos = i * QUERY_BLOCK + jnp.arange(QUERY_BLOCK)
        logits = (jnp.einsum('bqhd,bkhd->bhqk', q_blk, k).astype(jnp.float32) * scale
                  + (cq[..., None] - cum_k[:, :, None, :]))
        logits = jnp.where(key_pos[None, :] <= q_pos[:, None], logits, NEG_INF)
        p = jax.nn.softmax(logits, axis=-1)
        return jnp.einsum('bhqk,bkhd->bqhd', p.astype(v.dtype), v)

    out = lax.map(one_block, (jnp.arange(n_blk), q_blocks, cum_q_blocks))
    return jnp.moveaxis(out, 0, 1).reshape(b, s_len, h * d)


def compress_blocks(x, pe, w1, w2):
    b, s_len, hkv, d = x.shape
    n_c = (s_len - NSA_CMP_LEN) // NSA_CMP_STRIDE + 1
    idx = jnp.arange(n_c)[:, None] * NSA_CMP_STRIDE + jnp.arange(NSA_CMP_LEN)[None, :]
    blocks = x[:, idx] + pe[None, None, :, None, :]
    flat = blocks.transpose(0, 1, 3, 2, 4).reshape(b, n_c, hkv, NSA_CMP_LEN * d)
    return jax.nn.gelu(flat @ w1) @ w2


def nsa_attention(q, k_c, v_c, k_s, v_s, k_w, v_w, gates, cmp_pe, cmp_w1, cmp_w2, bias_table):
    b, s_len, h, d = q.shape
    hkv = k_s.shape[2]
    g = h // hkv
    scale = 1.0 / math.sqrt(d)
    qg = q.reshape(b, s_len, hkv, g, d)
    pos = jnp.arange(s_len)

    k_cmp = compress_blocks(k_c, cmp_pe[0], cmp_w1[0], cmp_w2[0])
    v_cmp = compress_blocks(v_c, cmp_pe[1], cmp_w1[1], cmp_w2[1])
    n_c = k_cmp.shape[1]
    blk_end = jnp.arange(n_c) * NSA_CMP_STRIDE + NSA_CMP_LEN - 1
    dist_c = pos[:, None] - blk_end[None, :]
    valid_c = dist_c >= 0
    bias_c = bias_table[t5_bucket(dist_c)].astype(jnp.float32).transpose(2, 0, 1).reshape(hkv, g, s_len, n_c)
    logits = jnp.einsum('bthgd,bnhd->bhgtn', qg, k_cmp).astype(jnp.float32) * scale + bias_c
    logits = jnp.where(valid_c, logits, NEG_INF)
    p_cmp = jnp.where(valid_c, jax.nn.softmax(logits, axis=-1), 0.0)
    o_cmp = jnp.einsum('bhgtn,bnhd->bthgd', p_cmp.astype(v_cmp.dtype), v_cmp)

    n_s = s_len // NSA_SLC_BLOCK
    top_k = min(NSA_TOPK, n_s)
    c_start = jnp.arange(n_c) * NSA_CMP_STRIDE
    s_start = jnp.arange(n_s) * NSA_SLC_BLOCK
    overlap = jnp.clip(jnp.minimum(c_start[:, None] + NSA_CMP_LEN, s_start[None, :] + NSA_SLC_BLOCK)
                       - jnp.maximum(c_start[:, None], s_start[None, :]), 0, None).astype(jnp.float32) / NSA_CMP_LEN
    importance = jnp.einsum('bhgtn,ns->bhts', p_cmp, overlap)
    q_blk_id = pos // NSA_SLC_BLOCK
    blk = jnp.arange(n_s)
    forced = (blk[None, :] == 0) | (blk[None, :] == q_blk_id[:, None]) | (blk[None, :] == q_blk_id[:, None] - 1)
    future = blk[None, :] > q_blk_id[:, None]
    importance = jnp.where(forced, FORCE_SELECT, jnp.where(future, NEG_INF, importance))
    _, sel = lax.top_k(importance, top_k)

    k_blocks = k_s.reshape(b, n_s, NSA_SLC_BLOCK, hkv, d).transpose(0, 3, 1, 2, 4)
    v_blocks = v_s.reshape(b, n_s, NSA_SLC_BLOCK, hkv, d).transpose(0, 3, 1, 2, 4)
    bias_sel_tab = bias_table.reshape(REL_BUCKETS, hkv, g).transpose(1, 0, 2)
    nq = s_len // NSA_QUERY_BLOCK
    q_blocks = jnp.moveaxis(qg.reshape(b, nq, NSA_QUERY_BLOCK, hkv, g, d), 1, 0)
    sel_blocks = jnp.moveaxis(sel.reshape(b, hkv, nq, NSA_QUERY_BLOCK, top_k), 2, 0)
    bi = jnp.arange(b)[:, None, None, None]
    hi = jnp.arange(hkv)[None, :, None, None]
    n_sel = top_k * NSA_SLC_BLOCK

    def one_block(args):
        i, q_blk, sel_blk = args
        k_g = k_blocks[bi, hi, sel_blk].reshape(b, hkv, NSA_QUERY_BLOCK, n_sel, d)
        v_g = v_blocks[bi, hi, sel_blk].reshape(b, hkv, NSA_QUERY_BLOCK, n_sel, d)
        tok_pos = (sel_blk[..., None] * NSA_SLC_BLOCK + jnp.arange(NSA_SLC_BLOCK)).reshape(b, hkv, NSA_QUERY_BLOCK, n_sel)
        q_pos = i * NSA_QUERY_BLOCK + jnp.arange(NSA_QUERY_BLOCK)
        dist = q_pos[None, None, :, None] - tok_pos
        bias = bias_sel_tab[hi, t5_bucket(dist)].astype(jnp.float32).transpose(0, 1, 4, 2, 3)
        logits = jnp.einsum('bqhgd,bhqnd->bhgqn', q_blk, k_g).astype(jnp.float32) * scale + bias
        logits = jnp.where((dist >= 0)[:, :, None], logits, NEG_INF)
        p = jax.nn.softmax(logits, axis=-1)
        return jnp.einsum('bhgqn,bhqnd->bqhgd', p.astype(v_g.dtype), v_g)

    o_slc = jnp.moveaxis(lax.map(one_block, (jnp.arange(nq), q_blocks, sel_blocks)), 0, 1)

    o_win = banded_attention(q, k_w, v_w, NSA_WINDOW, bias_table, None).reshape(b, s_len, h, d)

    o = (gates[..., 0:1] * o_cmp.reshape(b, s_len, h, d)
         + gates[..., 1:2] * o_slc.reshape(b, s_len, h, d)
         + gates[..., 2:3] * o_win)
    return o.reshape(b, s_len, h * d)


def setup_inputs(seed: int = 0) -> dict:
    key = jax.random.key(seed)
    ks = jax.random.split(key, 20)

    def normal(k, shape, scale):
        return jax.random.normal(k, shape, jnp.float32) * scale

    def gain(k):
        return 1.0 + normal(k, (DEPTH, D_MODEL), 0.05)

    return {
        "x": normal(ks[0], (BATCH, SEQ, D_MODEL), 1.0),
        "c": normal(ks[1], (BATCH, D_MODEL), 1.0),
        "rel_bias": normal(ks[2], (REL_BUCKETS, BIAS_HEADS), 0.5),
        "ada_w": normal(ks[3], (DEPTH, D_MODEL, ADA_CHUNKS * D_MODEL), D_MODEL ** -0.5),
        "ada_b": normal(ks[4], (DEPTH, ADA_CHUNKS * D_MODEL), 0.02),
        "attn_pre_norm": gain(ks[5]),
        "attn_post_norm": gain(ks[6]),
        "ffn_pre_norm": gain(ks[7]),
        "ffn_post_norm": gain(ks[8]),
        "w_in": normal(ks[9], (DEPTH, D_MODEL, N_IN), D_MODEL ** -0.5),
        "forget_bias": 3.0 + normal(ks[10], (DEPTH, FOX_HEADS), 0.5),
        "swa_sinks": normal(ks[11], (DEPTH, SWA_HEADS), 0.5),
        "cmp_pos": normal(ks[12], (DEPTH, 2, NSA_CMP_LEN, HEAD_DIM), 0.1),
        "cmp_w1": normal(ks[13], (DEPTH, 2, NSA_CMP_LEN * HEAD_DIM, NSA_CMP_HIDDEN), (NSA_CMP_LEN * HEAD_DIM) ** -0.5),
        "cmp_w2": normal(ks[14], (DEPTH, 2, NSA_CMP_HIDDEN, HEAD_DIM), NSA_CMP_HIDDEN ** -0.5),
        "group_norm": gain(ks[15]),
        "w_out": normal(ks[16], (DEPTH, D_MODEL, D_MODEL), D_MODEL ** -0.5),
        "ffn_w_gate": normal(ks[17], (DEPTH, D_MODEL, FFN_HIDDEN), D_MODEL ** -0.5),
        "ffn_w_up": normal(ks[18], (DEPTH, D_MODEL, FFN_HIDDEN), D_MODEL ** -0.5),
        "ffn_w_down": normal(ks[19], (DEPTH, FFN_HIDDEN, D_MODEL), FFN_HIDDEN ** -0.5),
    }


def reference(x, c, rel_bias, ada_w, ada_b, attn_pre_norm, attn_post_norm, ffn_pre_norm, ffn_post_norm,
              w_in, forget_bias, swa_sinks, cmp_pos, cmp_w1, cmp_w2, group_norm, w_out,
              ffn_w_gate, ffn_w_up, ffn_w_down):
    b, s_len, _ = x.shape
    offsets = np.cumsum(IN_SPLITS)[:-1].tolist()
    c_act = jax.nn.silu(c)
    bias_swa = rel_bias[:, :SWA_HEADS]
    bias_nsa = rel_bias[:, SWA_HEADS:]
    for layer in range(DEPTH):
        mod = c_act @ ada_w[layer] + ada_b[layer]
        shift_a, scale_a, gate_a, shift_f, scale_f, gate_f = [m[:, None, :] for m in jnp.split(mod, ADA_CHUNKS, axis=-1)]

        h = rms_norm(x, attn_pre_norm[layer]) * (1 + scale_a) + shift_a
        proj = h @ w_in[layer]
        qa, ka, va, qb, kb, vb, fb, qc, kc, vc, ksl, vsl, kw, vw, gc = jnp.split(proj, offsets, axis=-1)

        o_swa = banded_attention(split_heads(qa, SWA_HEADS), split_heads(ka, SWA_KV_HEADS),
                                 split_heads(va, SWA_KV_HEADS), SWA_WINDOW, bias_swa, swa_sinks[layer])
        log_f = jax.nn.log_sigmoid(fb.astype(jnp.float32) + forget_bias[layer].astype(jnp.float32))
        o_fox = forgetting_attention(split_heads(qb, FOX_HEADS), split_heads(kb, FOX_HEADS),
                                     split_heads(vb, FOX_HEADS), log_f)
        gates = jax.nn.sigmoid(gc.reshape(b, s_len, NSA_HEADS, 3))
        o_nsa = nsa_attention(split_heads(qc, NSA_HEADS),
                              split_heads(kc, NSA_KV_HEADS), split_heads(vc, NSA_KV_HEADS),
                              split_heads(ksl, NSA_KV_HEADS), split_heads(vsl, NSA_KV_HEADS),
                              split_heads(kw, NSA_KV_HEADS), split_heads(vw, NSA_KV_HEADS),
                              gates, cmp_pos[layer], cmp_w1[layer], cmp_w2[layer], bias_nsa)
        gn = group_norm[layer]
        mixed = jnp.concatenate([
            rms_norm(o_swa, gn[:SWA_WIDTH]),
            rms_norm(o_fox, gn[SWA_WIDTH:SWA_WIDTH + FOX_WIDTH]),
            rms_norm(o_nsa, gn[SWA_WIDTH + FOX_WIDTH:]),
        ], axis=-1)
        y = mixed @ w_out[layer]
        x = x + gate_a * rms_norm(y, attn_post_norm[layer])

        h = rms_norm(x, ffn_pre_norm[layer]) * (1 + scale_f) + shift_f
        y = (jax.nn.silu(h @ ffn_w_gate[layer]) * (h @ ffn_w_up[layer])) @ ffn_w_down[layer]
        x = x + gate_f * rms_norm(y, ffn_post_norm[layer])
    return x
```

```cpp
#include <hip/hip_runtime.h>
#include <cstdio>
#include <cstdint>
#include <type_traits>

#ifndef F32_MODE
#define F32_MODE 0
#endif

constexpr int DM = 1024, NB = 8, SEQ = 4096, DEPTH = 4, HD = 64;
constexpr int M = NB * SEQ;
constexpr int NIN = 2588, NPROJ = 2816, FFN = 2816;
constexpr float RMS_EPS = 1e-6f;
constexpr float LOG2E = 1.4426950408889634f;
constexpr float QSCALE = 0.125f * LOG2E;
constexpr int C_QA = 0, C_KA = 256, C_VA = 384, C_QB = 512, C_KB = 768, C_VB = 1024, C_QC = 1280, C_KC = 1792, C_VC = 1920,
              C_KS = 2048, C_VS = 2176, C_KW = 2304, C_VW = 2432, C_FB = 2560, C_GC = 2564;

#if F32_MODE
typedef float act_t;
__device__ __forceinline__ float ldA(const act_t* p) { return *p; }
__device__ __forceinline__ void stA(act_t* p, float v) { *p = v; }
#else
typedef unsigned short act_t;
__device__ __forceinline__ float ldA(const act_t* p) { return __uint_as_float(((unsigned)*p) << 16); }
__device__ __forceinline__ void stA(act_t* p, float v) { unsigned u = __float_as_uint(v); *p = (act_t)((u + 0x7fffu + ((u >> 16) & 1u)) >> 16); }
#endif

constexpr size_t MiB = 1u << 20;
constexpr size_t WS_MOD = 1 * MiB, WS_LOGF = 2 * MiB, WS_CUM = 2 * MiB + 512 * 1024, WS_GATES = 3 * MiB, WS_KCMP = 6 * MiB, WS_VCMP = 7 * MiB,
                 WS_SEL = 8 * MiB, WS_IMP = 9 * MiB, WS_STATS = 25 * MiB;
#if F32_MODE
constexpr size_t WS_RH = 32 * MiB, WS_R1 = 160 * MiB, WS_Y = WS_R1, WS_Y2 = WS_RH, WS_END = 512 * MiB;
#else
constexpr size_t WS_RH = 32 * MiB, WS_Y = 96 * MiB, WS_Y2 = WS_Y, WS_R1 = 224 * MiB, WS_W = 400 * MiB, WS_END = 512 * MiB;
#endif

__device__ __forceinline__ int t5_bucket(int dist) {
    if (dist < 16) return dist < 0 ? 0 : dist;
    int b = 16;
    b += dist >= 21; b += dist >= 27; b += dist >= 35; b += dist >= 46; b += dist >= 59; b += dist >= 77; b += dist >= 99; b += dist >= 128;
    b += dist >= 166; b += dist >= 216; b += dist >= 280; b += dist >= 363; b += dist >= 470; b += dist >= 609; b += dist >= 790;
    return b;
}
__device__ __forceinline__ float wave_sum(float v) {
#pragma unroll
    for (int o = 1; o < 64; o <<= 1) v += __shfl_xor(v, o);
    return v;
}

__device__ __forceinline__ int lane_id_fresh() { int x; asm volatile("v_mbcnt_lo_u32_b32 %0, -1, 0\n\tv_mbcnt_hi_u32_b32 %0, -1, %0" : "=v"(x)); return x; }
namespace pg8 {
#define PG8_LAS __attribute__((address_space(3)))
typedef unsigned short bf16_t;
typedef short bf16x8 __attribute__((ext_vector_type(8)));
typedef float f32x4 __attribute__((ext_vector_type(4)));
typedef unsigned u32x4 __attribute__((ext_vector_type(4)));
constexpr int BM = 256, BK = 64, HALF = 128, HTB = HALF * BK * 2  , STAGE_BYTES = 8 * HTB, NXCD = 8, WGM = 8;

__host__ __device__ __forceinline__ int lds_byte(int r, int c) { const int st = (r >> 4) * 2 + (c >> 5), rr = r & 15, cc = c & 31, ob = rr * 64 + cc * 2; return st * 1024 + (ob ^ (((ob >> 9) & 1) << 5)); }
__host__ __device__ __forceinline__ void stage_rc(int b, int& R, int& C) { const int st = b / 1024, sb = b % 1024, swz = sb ^ (((sb >> 9) & 1) << 5); R = (st >> 1) * 16 + swz / 64; C = (st & 1) * 32 + (swz % 64) / 2; }
__host__ __device__ __forceinline__ int perm32(int rho) { const int n = rho >> 4, i = rho & 15; return 8 * (i >> 2) + 4 * n + (i & 3); }

struct Unit { int pm, pn; };
struct Gemm { const bf16_t* A; const bf16_t* Bt; int M, N, K; };

struct StaticOrder {
    int nM, nN, nwg, G, c;
    __host__ __device__ __forceinline__ void init(int M, int N, int G_, int c_) { nM = M / BM; nN = N / BM; nwg = nM * nN; G = G_; c = c_; }
    __host__ __device__ __forceinline__ bool next(int i, Unit& u) const {
        const long L = (long)i * G + c; if (L >= nwg) return false;
        int wgid = (int)L; { const int q = nwg / NXCD, r = nwg % NXCD, xcd = wgid % NXCD, off = wgid / NXCD; wgid = (xcd < r ? xcd * (q + 1) : r * (q + 1) + (xcd - r) * q) + off; }
        const int nig = WGM * nN, gid = wgid / nig, fm = gid * WGM, gsz = (nM - fm) < WGM ? (nM - fm) : WGM;
        u.pm = fm + ((wgid % nig) % gsz); u.pn = (wgid % nig) / gsz; return true;
    }
    __device__ __forceinline__ void a_ready(const Unit&) const {}
    __device__ __forceinline__ void done(const Unit&) const {}
};

__device__ __forceinline__ unsigned cvt_pk_bf16(float lo, float hi) { unsigned r; asm volatile("v_cvt_pk_bf16_f32 %0, %1, %2" : "=v"(r) : "v"(lo), "v"(hi)); return r; }
struct NoKHook { static constexpr bool ACTIVE = false; };
template <class Epi, class Sched, bool ALIGN_EPI = false, bool SP2 = false, class KH = NoKHook>
__device__ __forceinline__ void gemm_phase(PG8_LAS unsigned char* lds, const Gemm g, const Sched& S, const Epi& E, int wv, const KH& kh = KH()) {
    int tid_l = wv * 64 + lane_id_fresh(); asm volatile("" : "+v"(tid_l));
    const int tid = tid_l, wid = __builtin_amdgcn_readfirstlane(tid >> 6), lane = tid & 63, wr = wid >> 2, wc = wid & 3, fr = lane & 15, fq = lane >> 4;
    const int K = g.K, nt = K / BK;
    unsigned voffA[2], voffB[2];
#pragma unroll
    for (int i = 0; i < 2; ++i) { int R, C; stage_rc(tid * 16 + i * 8192, R, C); const int Rb = Epi::PERM ? ((R & ~31) + perm32(R & 31)) : R;
        voffA[i] = (unsigned)(R * K + C) * 2u; voffB[i] = (unsigned)(Rb * K + C) * 2u; }
    const size_t kstep = (size_t)(BK * 2);
    const size_t hstep = (size_t)HALF * K * 2;
    const size_t tstep = 2 * hstep;
    const unsigned ldsw = (unsigned)wid * 1024u;
    const int aoff = lds_byte(wr * 64 + fr, fq * 8), boff = lds_byte(wc * 32 + fr, fq * 8);
#define PG8_SA(b, h) (((b) * 2 + (h)) * HTB)
#define PG8_SB(b, h) ((4 + (b) * 2 + (h)) * HTB)
#define PG8_STAGE(bufoff, gbase, voff) do { _Pragma("unroll") for (int _i = 0; _i < 2; ++_i) \
        __builtin_amdgcn_global_load_lds((const unsigned*)((const char*)(gbase) + (voff)[_i]), (PG8_LAS unsigned*)(lds + (bufoff) + ldsw + _i * 8192), 16, 0, 0); } while (0)
#define PG8_LDA(dst, b, h) do { _Pragma("unroll") for (int m = 0; m < 4; ++m) _Pragma("unroll") for (int k = 0; k < 2; ++k) dst[m][k] = *(const PG8_LAS bf16x8*)(lds + PG8_SA(b, h) + aoff + m * 2048 + k * 1024); } while (0)
#define PG8_LDB(dst, b, h) do { _Pragma("unroll") for (int n = 0; n < 2; ++n) _Pragma("unroll") for (int k = 0; k < 2; ++k) dst[n][k] = *(const PG8_LAS bf16x8*)(lds + PG8_SB(b, h) + boff + n * 2048 + k * 1024); } while (0)
#define PG8_MMA(ai, bj, At, Bt) do { __builtin_amdgcn_s_setprio(1); _Pragma("unroll") for (int m = 0; m < 4; ++m) _Pragma("unroll") for (int n = 0; n < 2; ++n) _Pragma("unroll") for (int k = 0; k < 2; ++k) \
        acc[ai][bj][m][n] = __builtin_amdgcn_mfma_f32_16x16x32_bf16(Bt[n][k], At[m][k], acc[ai][bj][m][n], 0, 0, 0); __builtin_amdgcn_s_setprio(0); } while (0)
#define PG8_WAIT_V(n) asm volatile("s_waitcnt vmcnt(" #n ")" ::: "memory")
#define PG8_WAIT_L(n) asm volatile("s_waitcnt lgkmcnt(" #n ")" ::: "memory")
#define PG8_BAR __builtin_amdgcn_s_barrier()
#define PG8_SCHED __builtin_amdgcn_sched_barrier(0)
    Unit cur, nxt; int ui = 0;
    if (!S.next(0, cur)) return;
    f32x4 acc[2][2][4][2];
#pragma unroll
    for (int a = 0; a < 2; ++a)
#pragma unroll
        for (int b = 0; b < 2; ++b)
#pragma unroll
            for (int m = 0; m < 4; ++m)
#pragma unroll
                for (int n = 0; n < 2; ++n) acc[a][b][m][n] = (f32x4){0.f, 0.f, 0.f, 0.f};
    bf16x8 At[4][2], B0[2][2], B1[2][2];
    const char* cA = (const char*)g.A + (size_t)cur.pm * tstep; const char* cB = (const char*)g.Bt + (size_t)cur.pn * tstep;
    S.a_ready(cur);
    if constexpr (SP2) {
        PG8_STAGE(PG8_SB(0, 0), cB, voffB); PG8_STAGE(PG8_SB(0, 1), cB + hstep, voffB); PG8_STAGE(PG8_SA(0, 0), cA, voffA); PG8_STAGE(PG8_SA(0, 1), cA + hstep, voffA);
        if (wr == 1) PG8_BAR;
        PG8_WAIT_V(2); PG8_BAR;
        PG8_STAGE(PG8_SB(1, 0), cB + kstep, voffB); PG8_STAGE(PG8_SA(1, 0), cA + kstep, voffA); PG8_STAGE(PG8_SB(1, 1), cB + hstep + kstep, voffB);
        PG8_WAIT_V(6); PG8_BAR;
    } else {
        PG8_STAGE(PG8_SB(0, 0), cB, voffB); PG8_STAGE(PG8_SA(0, 0), cA, voffA); PG8_STAGE(PG8_SB(0, 1), cB + hstep, voffB); PG8_STAGE(PG8_SA(0, 1), cA + hstep, voffA);
        if (wr == 1) PG8_BAR;
        PG8_WAIT_V(4); PG8_BAR;
        PG8_STAGE(PG8_SB(1, 0), cB + kstep, voffB); PG8_STAGE(PG8_SA(1, 0), cA + kstep, voffA); PG8_STAGE(PG8_SB(1, 1), cB + hstep + kstep, voffB);
        PG8_WAIT_V(6); PG8_BAR;
    }
    for (;;) {
        const bool has_next = S.next(ui + 1, nxt);
        const char* nA = has_next ? (const char*)g.A + (size_t)nxt.pm * tstep : cA; const char* nB = has_next ? (const char*)g.Bt + (size_t)nxt.pn * tstep : cB;
        for (int t = 0; t < nt; t += 2) {
            if constexpr (KH::ACTIVE) { if (t == KH::T1 || t == KH::T2) kh.apply(acc, t, ui, wr, fr); }
            const bool last = (t == nt - 2);
            const char* a1 = cA + (size_t)(t + 1) * kstep;
            const char* a2 = last ? nA : cA + (size_t)(t + 2) * kstep; const char* b2 = last ? nB : cB + (size_t)(t + 2) * kstep;
            const char* a3 = a2 + kstep; const char* b3 = b2 + kstep;
            if (last && has_next) S.a_ready(nxt);
            if constexpr (SP2) {
            PG8_LDB(B0, 0, 0); PG8_LDB(B1, 0, 1); PG8_SCHED; PG8_LDA(At, 0, 0); PG8_STAGE(PG8_SA(1, 1), a1 + hstep, voffA);
            PG8_WAIT_V(8); PG8_WAIT_L(0); PG8_BAR; PG8_MMA(0, 0, At, B0); PG8_MMA(0, 1, At, B1); PG8_BAR; PG8_SCHED;
            PG8_LDA(At, 0, 1); PG8_STAGE(PG8_SB(0, 0), b2, voffB); PG8_STAGE(PG8_SB(0, 1), b2 + hstep, voffB); PG8_STAGE(PG8_SA(0, 0), a2, voffA);
            PG8_WAIT_V(8); PG8_WAIT_L(0); PG8_BAR; PG8_MMA(1, 0, At, B0); PG8_MMA(1, 1, At, B1); PG8_BAR; PG8_SCHED;
            PG8_LDB(B0, 1, 0); PG8_LDB(B1, 1, 1); PG8_SCHED; PG8_LDA(At, 1, 0); PG8_STAGE(PG8_SA(0, 1), a2 + hstep, voffA);
            PG8_WAIT_V(8); PG8_WAIT_L(0); PG8_BAR; PG8_MMA(0, 0, At, B0); PG8_MMA(0, 1, At, B1); PG8_BAR; PG8_SCHED;
            PG8_LDA(At, 1, 1); PG8_STAGE(PG8_SB(1, 0), b3, voffB); PG8_STAGE(PG8_SB(1, 1), b3 + hstep, voffB); PG8_STAGE(PG8_SA(1, 0), a3, voffA);
            PG8_WAIT_V(8); PG8_WAIT_L(0); PG8_BAR; PG8_MMA(1, 0, At, B0); PG8_MMA(1, 1, At, B1); PG8_BAR; PG8_SCHED;
            } else {
            PG8_LDB(B0, 0, 0); PG8_SCHED; PG8_LDA(At, 0, 0); PG8_STAGE(PG8_SA(1, 1), a1 + hstep, voffA);
            PG8_WAIT_L(8); PG8_BAR; PG8_WAIT_L(0); PG8_MMA(0, 0, At, B0); PG8_BAR; PG8_SCHED;
            PG8_LDB(B1, 0, 1); PG8_STAGE(PG8_SB(0, 0), b2, voffB);
            PG8_BAR; PG8_WAIT_L(0); PG8_MMA(0, 1, At, B1); PG8_BAR;
            PG8_LDA(At, 0, 1); PG8_STAGE(PG8_SA(0, 0), a2, voffA);
            PG8_BAR; PG8_WAIT_L(0); PG8_MMA(1, 0, At, B0); PG8_BAR; PG8_SCHED;
            PG8_STAGE(PG8_SB(0, 1), b2 + hstep, voffB);
            PG8_WAIT_V(6); PG8_BAR; PG8_MMA(1, 1, At, B1); PG8_BAR;
            PG8_LDB(B0, 1, 0); PG8_SCHED; PG8_LDA(At, 1, 0); PG8_STAGE(PG8_SA(0, 1), a2 + hstep, voffA);
            PG8_WAIT_L(8); PG8_BAR; PG8_WAIT_L(0); PG8_MMA(0, 0, At, B0); PG8_BAR; PG8_SCHED;
            PG8_LDB(B1, 1, 1); PG8_STAGE(PG8_SB(1, 0), b3, voffB);
            PG8_BAR; PG8_WAIT_L(0); PG8_MMA(0, 1, At, B1); PG8_BAR;
            PG8_LDA(At, 1, 1); PG8_STAGE(PG8_SA(1, 0), a3, voffA);
            PG8_BAR; PG8_WAIT_L(0); PG8_MMA(1, 0, At, B0); PG8_BAR; PG8_SCHED;
            PG8_STAGE(PG8_SB(1, 1), b3 + hstep, voffB);
            PG8_WAIT_V(6); PG8_BAR; PG8_MMA(1, 1, At, B1); PG8_BAR;
            }
        }
        if constexpr (ALIGN_EPI) { if (wr == 0) PG8_BAR; }
        if constexpr (!Epi::AFTER_DRAIN) { E(acc, cur, wr, wc, fr, fq); S.done(cur); }
        if (!has_next) break;
#pragma unroll
        for (int a = 0; a < 2; ++a)
#pragma unroll
            for (int b = 0; b < 2; ++b)
#pragma unroll
                for (int m = 0; m < 4; ++m)
#pragma unroll
                    for (int n = 0; n < 2; ++n) acc[a][b][m][n] = (f32x4){0.f, 0.f, 0.f, 0.f};
        cur = nxt; cA = nA; cB = nB; ++ui;
        if constexpr (ALIGN_EPI) { if (wr == 1) PG8_BAR; }
    }
    PG8_WAIT_V(0);
    if constexpr (!ALIGN_EPI) { if (wr == 0) PG8_BAR; }
    PG8_BAR;
    if constexpr (Epi::AFTER_DRAIN) { E.fused(acc, cur, wr, wc, fr, fq, lds, wid, lane); S.done(cur); }
#undef PG8_SA
#undef PG8_SB
#undef PG8_STAGE
#undef PG8_LDA
#undef PG8_LDB
#undef PG8_MMA
#undef PG8_WAIT_V
#undef PG8_WAIT_L
#undef PG8_BAR
#undef PG8_SCHED
}
}
#define LAS __attribute__((address_space(3)))
#define XB_TMO      128
#define XB_XCNT(j)  (256  + 64 * (j))
#define XB_XSUB(j)  (1280 + 64 * (j))
#define XB_XGEN(j)  (2304 + 64 * (j))
#define XB_TOP      3328
#define XB_TOPGEN   3392
#define XCD_BAR_WORDS 3456
#define XB_SPIN_CAP (1u << 18)

__device__ __forceinline__ unsigned xb_ld(unsigned* p)              { return __hip_atomic_load(p, __ATOMIC_RELAXED, __HIP_MEMORY_SCOPE_AGENT); }
__device__ __forceinline__ unsigned xb_add(unsigned* p, unsigned v) { return __hip_atomic_fetch_add(p, v, __ATOMIC_RELAXED, __HIP_MEMORY_SCOPE_AGENT); }
__device__ __forceinline__ unsigned xb_xcc_id() { return (unsigned)__builtin_amdgcn_s_getreg((3 << 11) | 20) & 0xFu; }
#define XB_SPIN(cond, bar) do { unsigned _sp = 0; while (cond) { __builtin_amdgcn_s_sleep(1); \
    if ((++_sp & 255u) == 0u) { if (xb_ld(&(bar)[XB_TMO])) break; if (_sp > XB_SPIN_CAP) { atomicAdd(&(bar)[XB_TMO], 1u); break; } } } } while (0)

struct XcdBarrier {
    unsigned* bar; unsigned x; int wv;
    volatile LAS unsigned* st;
};

__device__ __forceinline__ bool xb_thread0(int wv) { return wv == 0 && lane_id_fresh() == 0; }
__device__ __forceinline__ XcdBarrier xcd_barrier_post(unsigned* bar, volatile LAS unsigned* st, int wv) {
    XcdBarrier b; b.bar = bar; b.x = xb_xcc_id(); b.st = st; b.wv = wv;
    if (xb_thread0(wv)) (void)xb_add(&bar[XB_XCNT(b.x)], 1u);
    return b;
}
__device__ __forceinline__ void xcd_barrier_complete(unsigned* bar, unsigned x, unsigned& nloc, unsigned& nx) {
    const unsigned G = gridDim.x * gridDim.y * gridDim.z;
    unsigned sum, cnt, mine, sp = 0u;
    for (;;) {
        sum = 0u; cnt = 0u; mine = 0u;
#pragma unroll
        for (unsigned j = 0; j < 16; ++j) { const unsigned c = xb_ld(&bar[XB_XCNT(j)]); sum += c; cnt += (c > 0u) ? 1u : 0u; mine = (j == x) ? c : mine; }
        if (sum == G) break;
        __builtin_amdgcn_s_sleep(1);
        if ((++sp & 255u) == 0u) { if (xb_ld(&bar[XB_TMO])) break; if (sp > XB_SPIN_CAP) { atomicAdd(&bar[XB_TMO], 1u); break; } }
    }
    nloc = mine > 0u ? mine : 1u; nx = cnt > 0u ? cnt : 1u;
}

__device__ __forceinline__ void xcd_barrier(const XcdBarrier& b) {
    asm volatile("s_waitcnt vmcnt(0)" ::: "memory");
    __syncthreads();
    if (xb_thread0(b.wv)) {
        unsigned* bar = b.bar;
        __builtin_amdgcn_s_waitcnt(0);
        unsigned nloc = b.st[0], nx = b.st[1];
        if (nloc == 0u) { xcd_barrier_complete(bar, b.x, nloc, nx); b.st[0] = nloc; b.st[1] = nx; }
        const unsigned old = xb_add(&bar[XB_XSUB(b.x)], 1u);
        const unsigned gen = old / nloc;
        if (old + 1u == (gen + 1u) * nloc) {
            __builtin_amdgcn_fence(__ATOMIC_RELEASE, "agent");
            asm volatile("s_waitcnt vmcnt(0)" ::: "memory");
            const unsigned og = xb_add(&bar[XB_TOP], 1u);
            const unsigned tg = og / nx;
            if (og + 1u == (tg + 1u) * nx) xb_add(&bar[XB_TOPGEN], 1u);
            else XB_SPIN(xb_ld(&bar[XB_TOPGEN]) == tg, bar);
            __builtin_amdgcn_fence(__ATOMIC_ACQUIRE, "agent");
            xb_add(&bar[XB_XGEN(b.x)], 1u);
            asm volatile("s_waitcnt vmcnt(0)" ::: "memory");
        } else {
            XB_SPIN(xb_ld(&bar[XB_XGEN(b.x)]) == gen, bar);
            __builtin_amdgcn_fence(__ATOMIC_ACQUIRE, "agent");
            asm volatile("s_waitcnt vmcnt(0)" ::: "memory");
        }
    }
    __syncthreads();
}

#undef LAS
#define GAS __attribute__((address_space(1)))
#define LAS __attribute__((address_space(3)))
typedef unsigned short bf16;
typedef unsigned v4u __attribute__((ext_vector_type(4)));
typedef unsigned v2u __attribute__((ext_vector_type(2)));
typedef float f32x4 __attribute__((ext_vector_type(4)));
#define LDS_WAIT() asm volatile("s_waitcnt lgkmcnt(0)" ::: "memory")
#define VM_WAIT() asm volatile("s_waitcnt vmcnt(0)" ::: "memory")
__device__ __forceinline__ unsigned f2bf(float f) { unsigned u = __builtin_bit_cast(unsigned, f); return (u + 0x7fffu + ((u >> 16) & 1u)) >> 16; }
__device__ __forceinline__ unsigned pk2(float lo, float hi) { return f2bf(lo) | (f2bf(hi) << 16); }
__device__ __forceinline__ float bf_lo(unsigned w) { return __uint_as_float(w << 16); }
__device__ __forceinline__ float bf_hi(unsigned w) { return __uint_as_float(w & 0xffff0000u); }

constexpr int NWAVES = 8, NTHR = 512;
constexpr int RING_BYTES = 131072, LDSCTL_OFF = RING_BYTES, LDS_BYTES = 147456;
constexpr size_t WL_STRIDE = 26 * MiB, WL_IN = 0, WL_OUT = 6 * MiB, WL_GU = 8 * MiB, WL_DOWN = 19 * MiB, WL_CW2 = 24 * MiB + 512 * 1024, WL_CW1 = 25 * MiB;
constexpr size_t WS_SS = 9 * MiB;
constexpr int L_RF = LDSCTL_OFF + 2048;
constexpr size_t WS_B2 = 600 * 1024;
constexpr size_t WS_CB1P = 704 * 1024;
constexpr size_t WS_CB1 = 512 * 1024;
constexpr int CW_BAR = 1024, CW_Q = 8192;
static_assert(WS_W + 4 * WL_STRIDE <= WS_END, "weights fit");

enum { PH_PROJ = 0, PH_PREP = 1, PH_ATT = 2, PH_GN = 3, PH_WOUT = 4, PH_NORM2 = 5, PH_GU = 6, PH_DOWN = 7, PH_NORM3 = 8, NPH = 9 };
struct MArgs { const float* in[20]; float* out; unsigned char* ws; int lay_lo, lay_hi, ph_lo, ph_hi; int do_pro, use_bar, att_mask, pad; };

struct Frame { LAS unsigned char* lds; int tid, lane, wave, gw, NGW; };
typedef const __attribute__((address_space(4))) unsigned char* kargp_t;
__device__ __forceinline__ kargp_t kargp() { kargp_t p = (kargp_t)__builtin_amdgcn_kernarg_segment_ptr(); asm volatile("" : "+s"(p)); return p; }
#define KIN(i) (*(const float* const __attribute__((address_space(4)))*)(kargp() + 8 * (i)))
#define KOUT (*(float* const __attribute__((address_space(4)))*)(kargp() + 160))
#define KWS (*(unsigned char* const __attribute__((address_space(4)))*)(kargp() + 168))
#define KINT(k) (*(const int __attribute__((address_space(4)))*)(kargp() + 176 + 4 * (k)))
static_assert(sizeof(MArgs) == 208, "MArgs layout");

__device__ __forceinline__ int maprow(int code, int n) {
    switch (code) {
        case 1: return n < 1280 ? n : n < 1284 ? n + 1280 : n < 2564 ? n - 4 : n;
        case 2: return (n >> 7) * 256 + (n & 127);
        case 3: return (n >> 7) * 256 + 128 + (n & 127);
        default: return n;
    }
}
struct TrDesc { const float* W; int K, N; bf16* WT; int code; const float* ks; int item; };
__device__ __forceinline__ void tr_load(const TrDesc& d, f32x4 (&v)[8], int lane) {
    const int nblk = (d.N + 31) / 32, kb = d.item / nblk, nb = d.item % nblk, k0 = 64 * kb, n0 = 32 * nb;
    const int n4 = (lane & 7) * 4, nn = n0 + n4;
#pragma unroll
    for (int i = 0; i < 8; ++i) { const int kk = 8 * i + (lane >> 3);
        v[i] = nn < d.N ? *(const GAS f32x4*)(d.W + (size_t)(k0 + kk) * d.N + nn) : (f32x4){0.f, 0.f, 0.f, 0.f};
        if (d.ks) v[i] = v[i] * d.ks[k0 + kk]; }
}
__device__ __forceinline__ void tr_finish(const TrDesc& d, const f32x4 (&v)[8], LAS float* scr, int lane) {
    const int nblk = (d.N + 31) / 32, kb = d.item / nblk, nb = d.item % nblk, k0 = 64 * kb, n0 = 32 * nb;
    const int n4 = (lane & 7) * 4;
#pragma unroll
    for (int i = 0; i < 8; ++i) { const int kk = 8 * i + (lane >> 3);
        scr[kk * 33 + n4] = v[i].x; scr[kk * 33 + n4 + 1] = v[i].y; scr[kk * 33 + n4 + 2] = v[i].z; scr[kk * 33 + n4 + 3] = v[i].w; }
    LDS_WAIT(); asm volatile("" ::: "memory");
    const int c = lane & 7;
#pragma unroll
    for (int j = 0; j < 4; ++j) { const int n = (lane >> 3) + 8 * j; const LAS float* s = scr + (8 * c) * 33 + n;
        v4u o; o.x = pk2(s[0 * 33], s[1 * 33]); o.y = pk2(s[2 * 33], s[3 * 33]); o.z = pk2(s[4 * 33], s[5 * 33]); o.w = pk2(s[6 * 33], s[7 * 33]);
        if (n0 + n < d.N) *(GAS v4u*)(d.WT + (size_t)maprow(d.code, n0 + n) * d.K + k0 + 8 * c) = o; }
    LDS_WAIT(); asm volatile("" ::: "memory");
}

__device__ __forceinline__ void pro_a(const Frame& F) {
    unsigned char* ws = KWS;
    {
        LAS float* ca = (LAS float*)F.lds;
        LAS float* red = (LAS float*)(F.lds + 32768);
        const float* c = KIN(1);
        for (int i = F.tid; i < 8192; i += NTHR) { const float v = c[i]; ca[i] = v / (1.f + __expf(-v)); }
        __syncthreads();
        float* mod = (float*)(ws + WS_MOD);
        for (int task = blockIdx.x; task < DEPTH * 96; task += gridDim.x) {
            const int l = task / 96, n0 = (task % 96) * 64;
            const int cg = F.lane & 15, kq = F.lane >> 4;
            const float* w = KIN(3) + (size_t)l * 1024 * 6144 + n0 + 4 * cg;
            f32x4 acc[8];
#pragma unroll
            for (int b = 0; b < 8; ++b) acc[b] = (f32x4){0.f, 0.f, 0.f, 0.f};
            const int kb = F.wave * 128 + kq;
#pragma unroll 8
            for (int i = 0; i < 32; ++i) { const int k = kb + 4 * i; const f32x4 wv = *(const GAS f32x4*)(w + (size_t)k * 6144);
#pragma unroll
                for (int b = 0; b < 8; ++b) acc[b] += wv * ca[b * 1024 + k]; }
#pragma unroll
            for (int b = 0; b < 8; ++b)
#pragma unroll
                for (int e = 0; e < 4; ++e) { float v = acc[b][e]; v += __shfl_xor(v, 16); v += __shfl_xor(v, 32); if (kq == 0) red[(F.wave * 8 + b) * 64 + 4 * cg + e] = v; }
            __syncthreads();
            { const int b = F.tid >> 6, n = F.tid & 63; float s = 0.f;
#pragma unroll
              for (int wv = 0; wv < 8; ++wv) s += red[(wv * 8 + b) * 64 + n];
              mod[(size_t)(l * 8 + b) * 6144 + n0 + n] = s + KIN(4)[l * 6144 + n0 + n]; }
            __syncthreads();
        }
    }
    {
        LAS float* scr = (LAS float*)(F.lds + F.wave * 16384);
        constexpr int I_IN = 16 * 81, I_OUT = 16 * 32, I_G = 16 * 88, I_D = 44 * 32, I_C1 = 32 * 4, I_C2 = 2 * 2;
        constexpr int PER_L = I_IN + I_OUT + 2 * I_G + I_D + 2 * I_C1 + 2 * I_C2;
        auto decode = [&](int it, TrDesc& d) {
            const int l = it / PER_L; int r = it % PER_L;
            unsigned char* wl = ws + WS_W + (size_t)l * WL_STRIDE;
            if (r < I_IN) { d = TrDesc{KIN(9) + (size_t)l * DM * NIN, DM, NIN, (bf16*)(wl + WL_IN), 1, nullptr, r}; return; } r -= I_IN;
            if (r < I_OUT) { d = TrDesc{KIN(16) + (size_t)l * DM * DM, DM, DM, (bf16*)(wl + WL_OUT), 0, KIN(15) + l * DM, r}; return; } r -= I_OUT;
            if (r < I_G) { d = TrDesc{KIN(17) + (size_t)l * DM * FFN, DM, FFN, (bf16*)(wl + WL_GU), 2, nullptr, r}; return; } r -= I_G;
            if (r < I_G) { d = TrDesc{KIN(18) + (size_t)l * DM * FFN, DM, FFN, (bf16*)(wl + WL_GU), 3, nullptr, r}; return; } r -= I_G;
            if (r < I_D) { d = TrDesc{KIN(19) + (size_t)l * FFN * DM, FFN, DM, (bf16*)(wl + WL_DOWN), 0, nullptr, r}; return; } r -= I_D;
            if (r < 2 * I_C1) { const int kv = r / I_C1; d = TrDesc{KIN(13) + (size_t)(l * 2 + kv) * 2048 * 128, 2048, 128, (bf16*)(wl + WL_CW1) + (size_t)kv * 128 * 2048, 0, nullptr, r % I_C1}; return; } r -= 2 * I_C1;
            { const int kv = r / I_C2; d = TrDesc{KIN(14) + (size_t)(l * 2 + kv) * 128 * 64, 128, 64, (bf16*)(wl + WL_CW2) + (size_t)kv * 64 * 128, 0, nullptr, r % I_C2}; }
        };
        for (int it = F.gw; it < DEPTH * PER_L; it += 2 * F.NGW) {
            const bool two = it + F.NGW < DEPTH * PER_L;
            TrDesc da, db; decode(it, da); decode(two ? it + F.NGW : it, db);
            f32x4 va[8], vb[8]; tr_load(da, va, F.lane); if (two) tr_load(db, vb, F.lane);
            tr_finish(da, va, scr, F.lane); if (two) tr_finish(db, vb, scr, F.lane);
        }
        for (int it = F.gw; it < DEPTH * 228; it += F.NGW) { const int l = it / 228, row = NIN + it % 228;
            GAS v4u* p = (GAS v4u*)(ws + WS_W + (size_t)l * WL_STRIDE + WL_IN + (size_t)row * DM * 2);
            p[F.lane] = (v4u){0u, 0u, 0u, 0u}; p[64 + F.lane] = (v4u){0u, 0u, 0u, 0u}; }
        { const int gt = blockIdx.x * NTHR + F.tid;
          if (gt < 12 * 1152) { const int hd = gt / 1152, dist = gt % 1152; ((float*)(ws + WS_B2))[gt] = KIN(2)[t5_bucket(dist) * 12 + hd] * LOG2E; } }
        { LAS float* red = (LAS float*)(F.lds + 12288);
          for (int task = blockIdx.x; task < DEPTH * 2 * 32; task += gridDim.x) {
              const int lk = task >> 5, i0 = (task & 31) * 64 + (F.tid >> 7) * 16, j = F.tid & 127;
              const float* pe = KIN(12) + (size_t)lk * 2048 + i0; const float* w1 = KIN(13) + ((size_t)lk * 2048 + i0) * 128 + j; float s = 0.f;
#pragma unroll
              for (int i = 0; i < 16; ++i) s += pe[i] * w1[(size_t)i * 128];
              __syncthreads(); red[F.tid] = s; __syncthreads();
              if (F.tid < 128) ((float*)(ws + WS_CB1P))[(size_t)task * 128 + F.tid] = (red[F.tid] + red[128 + F.tid]) + (red[256 + F.tid] + red[384 + F.tid]); } }
    }
}
__device__ __forceinline__ void cb1_finish(const Frame& F) {
    unsigned char* ws = KWS;
    const int gt = blockIdx.x * NTHR + F.tid;
    if (gt < DEPTH * 2 * 128) { const int j = gt & 127, lk = gt >> 7; const float* pp = (const float*)(ws + WS_CB1P) + (size_t)lk * 32 * 128 + j; float s = 0.f;
#pragma unroll
        for (int c = 0; c < 32; ++c) s += pp[c * 128];
        ((float*)(ws + WS_CB1))[gt] = s; }
}

__device__ __forceinline__ void norm_phase(const Frame& F, const float* xin, const bf16* y, const float* g_post, const float* mod_post, int gate_chunk,
                                           const bf16* y2, const float* g_post2, int gate_chunk2, float* xout,
                                           const float* g_pre, const float* mod_pre, int scale_chunk, int shift_chunk, bf16* h, const bf16* xin16 = nullptr, bf16* xout16 = nullptr) {
    const size_t x16 = (size_t)F.gw * 32768 + 16384;
    const int row0 = F.gw * 16, b = row0 / SEQ;
    const f32x4 z4 = {0.f, 0.f, 0.f, 0.f};
    f32x4 gg[4], gg2[4], gqs[4], sh[4];
#pragma unroll
    for (int j = 0; j < 4; ++j) { const int col = j * 256 + F.lane * 4;
        gg[j] = y ? *(const GAS f32x4*)(mod_post + (size_t)b * 6144 + gate_chunk * 1024 + col) * *(const GAS f32x4*)(g_post + col) : z4;
        gg2[j] = y2 ? *(const GAS f32x4*)(mod_post + (size_t)b * 6144 + gate_chunk2 * 1024 + col) * *(const GAS f32x4*)(g_post2 + col) : z4;
        gqs[j] = h ? *(const GAS f32x4*)(g_pre + col) * (*(const GAS f32x4*)(mod_pre + (size_t)b * 6144 + scale_chunk * 1024 + col) + 1.f) : z4;
        sh[j] = h ? *(const GAS f32x4*)(mod_pre + (size_t)b * 6144 + shift_chunk * 1024 + col) : z4; }
    struct Raw { v2u ya[4], yb[4], y2a[4], y2b[4], xa[4], xb[4]; };
    auto fetch = [&](int i, Raw& r) {
        const size_t oa = (size_t)(row0 + i) * DM + F.lane * 4, ob = oa + DM;
#pragma unroll
        for (int j = 0; j < 4; ++j) {
            if (y) { r.ya[j] = *(const GAS v2u*)(y + oa + j * 256); r.yb[j] = *(const GAS v2u*)(y + ob + j * 256); }
            if (y2) { r.y2a[j] = *(const GAS v2u*)(y2 + oa + j * 256); r.y2b[j] = *(const GAS v2u*)(y2 + ob + j * 256); }
            if (xin16) { r.xa[j] = *(const GAS v2u*)(xin16 + x16 + (size_t)i * DM + j * 256 + F.lane * 4); r.xb[j] = *(const GAS v2u*)(xin16 + x16 + (size_t)(i + 1) * DM + j * 256 + F.lane * 4); } }
    };
    auto unpk = [](const v2u& w) { return (f32x4){bf_lo(w.x), bf_hi(w.x), bf_lo(w.y), bf_hi(w.y)}; };
    auto process = [&](int i, const Raw& r) {
        const int rowa = row0 + i, rowb = rowa + 1;
        f32x4 va[4], vb[4], ua[4], ub[4];
#pragma unroll
        for (int j = 0; j < 4; ++j) {
            if (xin16) { va[j] = unpk(r.xa[j]); vb[j] = unpk(r.xb[j]); }
            else { va[j] = *(const GAS f32x4*)(xin + (size_t)rowa * DM + j * 256 + F.lane * 4); vb[j] = *(const GAS f32x4*)(xin + (size_t)rowb * DM + j * 256 + F.lane * 4); } }
        auto add_branch = [&](const v2u (&wa)[4], const v2u (&wb)[4], const f32x4 (&g)[4]) {
            float ssa = 0.f, ssb = 0.f;
#pragma unroll
            for (int j = 0; j < 4; ++j) { ua[j] = unpk(wa[j]); ssa += (ua[j].x * ua[j].x + ua[j].y * ua[j].y) + (ua[j].z * ua[j].z + ua[j].w * ua[j].w);
                ub[j] = unpk(wb[j]); ssb += (ub[j].x * ub[j].x + ub[j].y * ub[j].y) + (ub[j].z * ub[j].z + ub[j].w * ub[j].w); }
            const float ra = rsqrtf(wave_sum(ssa) * (1.f / DM) + RMS_EPS), rb = rsqrtf(wave_sum(ssb) * (1.f / DM) + RMS_EPS);
#pragma unroll
            for (int j = 0; j < 4; ++j) { va[j] += g[j] * (ua[j] * ra); vb[j] += g[j] * (ub[j] * rb); }
        };
        if (y) add_branch(r.ya, r.yb, gg);
        if (y2) add_branch(r.y2a, r.y2b, gg2);
        if (xout16) {
#pragma unroll
            for (int j = 0; j < 4; ++j) { v2u wa, wb; wa.x = pk2(va[j].x, va[j].y); wa.y = pk2(va[j].z, va[j].w); wb.x = pk2(vb[j].x, vb[j].y); wb.y = pk2(vb[j].z, vb[j].w);
                *(GAS v2u*)(xout16 + x16 + (size_t)i * DM + j * 256 + F.lane * 4) = wa; *(GAS v2u*)(xout16 + x16 + (size_t)(i + 1) * DM + j * 256 + F.lane * 4) = wb;
                va[j] = unpk(wa); vb[j] = unpk(wb); }
        } else if (xout) {
#pragma unroll
            for (int j = 0; j < 4; ++j) { *(GAS f32x4*)(xout + (size_t)rowa * DM + j * 256 + F.lane * 4) = va[j]; *(GAS f32x4*)(xout + (size_t)rowb * DM + j * 256 + F.lane * 4) = vb[j]; }
        }
        if (h) {
            float ssa = 0.f, ssb = 0.f;
#pragma unroll
            for (int j = 0; j < 4; ++j) { ssa += (va[j].x * va[j].x + va[j].y * va[j].y) + (va[j].z * va[j].z + va[j].w * va[j].w); ssb += (vb[j].x * vb[j].x + vb[j].y * vb[j].y) + (vb[j].z * vb[j].z + vb[j].w * vb[j].w); }
            const float ra = rsqrtf(wave_sum(ssa) * (1.f / DM) + RMS_EPS), rb = rsqrtf(wave_sum(ssb) * (1.f / DM) + RMS_EPS);
#pragma unroll
            for (int j = 0; j < 4; ++j) { const int col = j * 256 + F.lane * 4;
                const f32x4 oa = va[j] * ra * gqs[j] + sh[j]; v2u w; w.x = pk2(oa.x, oa.y); w.y = pk2(oa.z, oa.w); *(GAS v2u*)(h + (size_t)rowa * DM + col) = w;
                const f32x4 ob = vb[j] * rb * gqs[j] + sh[j]; v2u w2; w2.x = pk2(ob.x, ob.y); w2.y = pk2(ob.z, ob.w); *(GAS v2u*)(h + (size_t)rowb * DM + col) = w2; }
        }
    };
    Raw ra0, ra1; fetch(0, ra0);
    for (int i = 0; i < 16; i += 4) {
        fetch(i + 2, ra1); process(i, ra0);
        if (i + 4 < 16) fetch(i + 4, ra0);
        process(i + 2, ra1);
    }
}
__device__ __forceinline__ void groupnorm_phase(const Frame& F, bf16* O, const float* gn) {
    for (int row = F.gw; row < M; row += F.NGW) {
        f32x4 v[4]; float ss[4];
#pragma unroll
        for (int j = 0; j < 4; ++j) { const v2u w = *(const GAS v2u*)(O + (size_t)row * DM + j * 256 + F.lane * 4);
            v[j] = (f32x4){bf_lo(w.x), bf_hi(w.x), bf_lo(w.y), bf_hi(w.y)}; ss[j] = (v[j].x * v[j].x + v[j].y * v[j].y) + (v[j].z * v[j].z + v[j].w * v[j].w); }
        const float r0 = rsqrtf(wave_sum(ss[0]) * (1.f / 256.f) + RMS_EPS), r1 = rsqrtf(wave_sum(ss[1]) * (1.f / 256.f) + RMS_EPS), r2 = rsqrtf(wave_sum(ss[2] + ss[3]) * (1.f / 512.f) + RMS_EPS);
#pragma unroll
        for (int j = 0; j < 4; ++j) { const float r = j == 0 ? r0 : j == 1 ? r1 : r2; const int col = j * 256 + F.lane * 4;
            const f32x4 o = v[j] * r * *(const GAS f32x4*)(gn + col);
            v2u w; w.x = pk2(o.x, o.y); w.y = pk2(o.z, o.w);
            *(GAS v2u*)(O + (size_t)row * DM + col) = w; }
    }
}

namespace pg8 {
__device__ __forceinline__ f32x4 smul(const f32x4& a, float s) {
    float z = 0.f; asm("" : "+v"(z));
    return (f32x4){a[0] * s, __builtin_fmaf(a[1], s, z), a[2] * s, __builtin_fmaf(a[3], s, z)}; }
struct EpiProj {
    static constexpr bool PERM = true, AFTER_DRAIN = false;
    bf16_t* proj; float* logf; float* gates; const float* fbias;
    __device__ __forceinline__ void operator()(const f32x4 (&acc)[2][2][4][2], const Unit& u, int wr, int wc, int fr, int fq) const {
        const int row0 = u.pm * BM + wr * 64 + fr;
        {
            const float sc = (u.pn == 0 || u.pn == 2 || u.pn == 5 || u.pn == 6) ? QSCALE : 1.f;
            const int col0 = u.pn * BM + wc * 32 + 8 * fq;
#pragma unroll
            for (int ai = 0; ai < 2; ++ai)
#pragma unroll
                for (int m = 0; m < 4; ++m) { bf16_t* rowp = proj + (size_t)(row0 + ai * HALF + m * 16) * NPROJ + col0;
#pragma unroll
                    for (int bj = 0; bj < 2; ++bj) { const f32x4 v0 = smul(acc[ai][bj][m][0], sc), v1 = smul(acc[ai][bj][m][1], sc);
                        u32x4 w; w.x = cvt_pk_bf16(v0[0], v0[1]); w.y = cvt_pk_bf16(v0[2], v0[3]); w.z = cvt_pk_bf16(v1[0], v1[1]); w.w = cvt_pk_bf16(v1[2], v1[3]);
                        *(u32x4*)(rowp + bj * HALF) = w; } }
        }
    }
};
struct EpiY {
    static constexpr bool PERM = true, AFTER_DRAIN = false;
    bf16_t* out; int ldc;
    __device__ __forceinline__ void operator()(const f32x4 (&acc)[2][2][4][2], const Unit& u, int wr, int wc, int fr, int fq) const {
        const int row0 = u.pm * BM + wr * 64 + fr, col0 = u.pn * BM + wc * 32 + 8 * fq;
#pragma unroll
        for (int ai = 0; ai < 2; ++ai)
#pragma unroll
            for (int m = 0; m < 4; ++m) { bf16_t* rowp = out + (size_t)(row0 + ai * HALF + m * 16) * ldc + col0;
#pragma unroll
                for (int bj = 0; bj < 2; ++bj) { const f32x4 v0 = acc[ai][bj][m][0], v1 = acc[ai][bj][m][1];
                    u32x4 w; w.x = cvt_pk_bf16(v0[0], v0[1]); w.y = cvt_pk_bf16(v0[2], v0[3]); w.z = cvt_pk_bf16(v1[0], v1[1]); w.w = cvt_pk_bf16(v1[2], v1[3]);
                    *(u32x4*)(rowp + bj * HALF) = w; } }
    }
};
struct GnHook { static constexpr bool ACTIVE = true; static constexpr int T1 = 4, T2 = 8;
    const PG8_LAS f32x4* rf;
    __device__ __forceinline__ void apply(f32x4 (&acc)[2][2][4][2], int t, int ui, int wr, int fr) const {
#pragma unroll
        for (int ai = 0; ai < 2; ++ai)
#pragma unroll
            for (int m = 0; m < 4; ++m) { const f32x4 f = rf[(ui & 1) * 256 + ai * HALF + wr * 64 + m * 16 + fr]; const float sc = (t == T1) ? f[0] : f[1];
#pragma unroll
                for (int bj = 0; bj < 2; ++bj)
#pragma unroll
                    for (int n = 0; n < 2; ++n) acc[ai][bj][m][n] = smul(acc[ai][bj][m][n], sc); }
    }
};
struct EpiYGn {
    static constexpr bool PERM = true, AFTER_DRAIN = false;
    bf16_t* out; int ldc; const PG8_LAS f32x4* rf; int pm0;
    __device__ __forceinline__ void operator()(const f32x4 (&acc)[2][2][4][2], const Unit& u, int wr, int wc, int fr, int fq) const {
        const int row0 = u.pm * BM + wr * 64 + fr, col0 = u.pn * BM + wc * 32 + 8 * fq; const int slot = (u.pm == pm0) ? 0 : 256;
#pragma unroll
        for (int ai = 0; ai < 2; ++ai)
#pragma unroll
            for (int m = 0; m < 4; ++m) { bf16_t* rowp = out + (size_t)(row0 + ai * HALF + m * 16) * ldc + col0; const float sc = rf[slot + ai * HALF + wr * 64 + m * 16 + fr][2];
#pragma unroll
                for (int bj = 0; bj < 2; ++bj) { const f32x4 v0 = smul(acc[ai][bj][m][0], sc), v1 = smul(acc[ai][bj][m][1], sc);
                    u32x4 w; w.x = cvt_pk_bf16(v0[0], v0[1]); w.y = cvt_pk_bf16(v0[2], v0[3]); w.z = cvt_pk_bf16(v1[0], v1[1]); w.w = cvt_pk_bf16(v1[2], v1[3]);
                    *(u32x4*)(rowp + bj * HALF) = w; } }
    }
};
struct EpiSwiglu {
    static constexpr bool PERM = true, AFTER_DRAIN = false;
    bf16_t* out;
    __device__ __forceinline__ void operator()(const f32x4 (&acc)[2][2][4][2], const Unit& u, int wr, int wc, int fr, int fq) const {
        const int row0 = u.pm * BM + wr * 64 + fr, col0 = u.pn * HALF + wc * 32 + 8 * fq;
#pragma unroll
        for (int ai = 0; ai < 2; ++ai)
#pragma unroll
            for (int m = 0; m < 4; ++m) { float o[8];
#pragma unroll
                for (int n = 0; n < 2; ++n)
#pragma unroll
                    for (int e = 0; e < 4; ++e) { const float g = acc[ai][0][m][n][e], up = acc[ai][1][m][n][e]; o[4 * n + e] = g * __builtin_amdgcn_rcpf(1.f + __expf(-g)) * up; }
                u32x4 w; w.x = cvt_pk_bf16(o[0], o[1]); w.y = cvt_pk_bf16(o[2], o[3]); w.z = cvt_pk_bf16(o[4], o[5]); w.w = cvt_pk_bf16(o[6], o[7]);
                *(u32x4*)(out + (size_t)(row0 + ai * HALF + m * 16) * FFN + col0) = w; }
    }
};
}
namespace att {
typedef short bf16x8 __attribute__((ext_vector_type(8)));
typedef short s16x4 __attribute__((ext_vector_type(4)));
typedef short v4i16_t __attribute__((ext_vector_type(4)));
typedef float f32x16 __attribute__((ext_vector_type(16)));
typedef float f32x2_t __attribute__((ext_vector_type(2)));
typedef __bf16 bf16x2_t __attribute__((ext_vector_type(2)));
typedef LAS const char* lcp;
constexpr int L_K = 0, L_V = 16384, L_AUX = 32768;
constexpr float NEG_INF = -__builtin_inff();
constexpr float SM_THR = 8.f;
struct St { float m, l; f32x16 o0, o1; };

__device__ __forceinline__ unsigned cvtpk(float lo, float hi) { f32x2_t v = {lo, hi}; bf16x2_t b = __builtin_convertvector(v, bf16x2_t); return __builtin_bit_cast(unsigned, b); }
__device__ __forceinline__ float ex2(float x) { return __builtin_amdgcn_exp2f(x); }
__device__ __forceinline__ float xhalf_max(float m) { auto rr = __builtin_amdgcn_permlane32_swap(__float_as_uint(m), __float_as_uint(m), false, false); return fmaxf(__uint_as_float(rr[0]), __uint_as_float(rr[1])); }
__device__ __forceinline__ float xhalf_sum(float m) { auto rr = __builtin_amdgcn_permlane32_swap(__float_as_uint(m), __float_as_uint(m), false, false); return __uint_as_float(rr[0]) + __uint_as_float(rr[1]); }
#define ATT_WAIT_BAR(N) asm volatile("s_waitcnt vmcnt(" #N ") lgkmcnt(0)\n\ts_barrier" ::: "memory")
#define ATT_BAR() asm volatile("s_waitcnt lgkmcnt(0)\n\ts_barrier" ::: "memory")

__device__ __forceinline__ void glds16(const void* gsrc, unsigned lds_dst) { unsigned keep;
    asm volatile("s_mov_b32 %0, m0\n\ts_mov_b32 m0, %2\n\ts_nop 0\n\tglobal_load_lds_dwordx4 %1, off\n\ts_mov_b32 m0, %0" : "=&s"(keep) : "v"(gsrc), "s"(lds_dst) : "memory"); }
__device__ __forceinline__ void dma_k(const bf16* Krow0, int pitch, LAS unsigned char* kbuf, int wid, int lane) {
    const bf16* src = Krow0 + (size_t)lane * pitch + 8 * wid;
    glds16(src, (unsigned)__builtin_amdgcn_readfirstlane((int)(unsigned)(uintptr_t)(kbuf + wid * 1024)));
}
__device__ __forceinline__ void dma_v(const bf16* Vrow0, int pitch, LAS unsigned char* vbuf, int wid, int lane) {
    const bf16* src = Vrow0 + (size_t)(16 * (wid & 3) + (lane >> 2)) * pitch + 32 * (wid >> 2) + 8 * (lane & 3);
    glds16(src, (unsigned)__builtin_amdgcn_readfirstlane((int)(unsigned)(uintptr_t)(vbuf + wid * 1024)));
}
__device__ __forceinline__ s16x4 vtr(lcp p) { return __builtin_bit_cast(s16x4, __builtin_amdgcn_ds_read_tr16_b64_v4i16((LAS v4i16_t*)p)); }


struct Pf { bf16x8 f[4]; };
__device__ __forceinline__ void load_kf(bf16x8 (&kf)[8], lcp kb, int r32, int hi) {
    lcp k0 = kb + hi * 1024 + r32 * 16;
#pragma unroll
    for (int d0 = 0; d0 < 4; ++d0) { kf[2 * d0] = *(const LAS bf16x8*)(k0 + d0 * 2048); kf[2 * d0 + 1] = *(const LAS bf16x8*)(k0 + d0 * 2048 + 512); }
}
__device__ __forceinline__ void load_vf(bf16x8 (&vf)[8], lcp vb, int lane, int hi) {
    lcp vp = vb + ((lane >> 4) & 1) * 32 + (lane & 3) * 8 + (4 * hi + ((lane & 15) >> 2)) * 64;
#pragma unroll
    for (int k = 0; k < 4; ++k) {
        const s16x4 a0 = vtr(vp + k * 1024), a1 = vtr(vp + k * 1024 + 512), b0 = vtr(vp + 4096 + k * 1024), b1 = vtr(vp + 4096 + k * 1024 + 512);
        vf[2 * k] = (bf16x8){a0[0], a0[1], a0[2], a0[3], a1[0], a1[1], a1[2], a1[3]}; vf[2 * k + 1] = (bf16x8){b0[0], b0[1], b0[2], b0[3], b1[0], b1[1], b1[2], b1[3]};
    }
}
__device__ __forceinline__ void qk_mfma(f32x16& p0, f32x16& p1, const bf16x8 (&kf)[8], const bf16x8 (&qf)[4]) {
#pragma unroll
    for (int d0 = 0; d0 < 4; ++d0) { p0 = __builtin_amdgcn_mfma_f32_32x32x16_bf16(kf[2 * d0], qf[d0], p0, 0, 0, 0); p1 = __builtin_amdgcn_mfma_f32_32x32x16_bf16(kf[2 * d0 + 1], qf[d0], p1, 0, 0, 0); }
}
__device__ __forceinline__ void pv_mfma(St& st, const bf16x8 (&vf)[8], const Pf& pf) {
#pragma unroll
    for (int k = 0; k < 4; ++k) { st.o0 = __builtin_amdgcn_mfma_f32_32x32x16_bf16(vf[2 * k], pf.f[k], st.o0, 0, 0, 0); st.o1 = __builtin_amdgcn_mfma_f32_32x32x16_bf16(vf[2 * k + 1], pf.f[k], st.o1, 0, 0, 0); }
}
__device__ __forceinline__ void pack_p(Pf& pf, const f32x16& p0, const f32x16& p1) {
    unsigned w[16];
#pragma unroll
    for (int i = 0; i < 8; ++i) { w[i] = cvtpk(p0[2 * i], p0[2 * i + 1]); w[8 + i] = cvtpk(p1[2 * i], p1[2 * i + 1]); }
#pragma unroll
    for (int k = 0; k < 4; ++k) { v4u t = {w[4 * k], w[4 * k + 1], w[4 * k + 2], w[4 * k + 3]}; pf.f[k] = __builtin_bit_cast(bf16x8, t); }
}
__device__ __forceinline__ void softmax(St& st, f32x16& p0, f32x16& p1, Pf& pf, bool live = true, float cadd = 0.f) {
    float mxa = fmaxf(p0[0], p1[0]), mxb = fmaxf(p0[1], p1[1]);
#pragma unroll
    for (int r = 2; r < 16; r += 2) { mxa = fmaxf(fmaxf(mxa, p0[r]), p1[r]); mxb = fmaxf(fmaxf(mxb, p0[r + 1]), p1[r + 1]); }
    float mx = xhalf_max(fmaxf(mxa, mxb)) + cadd;
    if (!live) mx = NEG_INF;
    const float mn = fmaxf(st.m, mx);
    if (__any(mn > st.m)) { const float f = ex2(st.m - mn); st.l *= f;
#pragma unroll
        for (int r = 0; r < 16; ++r) { st.o0[r] *= f; st.o1[r] *= f; }
        st.m = mn; }
    const float ms = live ? mn - cadd : -NEG_INF;
    float s = 0.f;
#pragma unroll
    for (int r = 0; r < 16; ++r) { p0[r] = ex2(p0[r] - ms); p1[r] = ex2(p1[r] - ms); s += p0[r] + p1[r]; }
    st.l += s;
    pack_p(pf, p0, p1);
}
__device__ __forceinline__ void st_init(St& st, float m0, float l0) { st.m = m0; st.l = l0;
#pragma unroll
    for (int r = 0; r < 16; ++r) { st.o0[r] = 0.f; st.o1[r] = 0.f; } }
__device__ __forceinline__ void store_o(bf16* obase, const f32x16& o0, const f32x16& o1, float sc, int lane, float* ssp, LAS unsigned char* stg) {
    const int r32 = lane & 31, hi = lane >> 5;
    float ss = 0.f;
#pragma unroll
    for (int a = 0; a < 4; ++a) {
        float v[8];
#pragma unroll
        for (int e = 0; e < 4; ++e) { v[e] = o0[4 * a + e] * sc; v[4 + e] = o1[4 * a + e] * sc; }
#pragma unroll
        for (int e = 0; e < 8; ++e) ss += v[e] * v[e];
        v2u w0, w1; w0.x = cvtpk(v[0], v[1]); w0.y = cvtpk(v[2], v[3]); w1.x = cvtpk(v[4], v[5]); w1.y = cvtpk(v[6], v[7]);
        *(LAS v2u*)(stg + r32 * 144 + (8 * a + 4 * hi) * 2) = w0; *(LAS v2u*)(stg + r32 * 144 + 64 + (8 * a + 4 * hi) * 2) = w1; }
    ss = xhalf_sum(ss);
    if (hi == 0) *ssp = ss;
    asm volatile("s_waitcnt lgkmcnt(0)" ::: "memory");
#pragma unroll
    for (int i = 0; i < 4; ++i) { const int row = 8 * i + (lane >> 3), ch = lane & 7; const v4u v = *(const LAS v4u*)(stg + row * 144 + ch * 16); *(GAS v4u*)(obase + (size_t)row * DM + ch * 8) = v; }
}
__device__ __forceinline__ int unit_fetch_issue(unsigned* ctr, int wv) {
    int v = 0;
    if (wv == 0 && lane_id_fresh() == 0) v = (int)__hip_atomic_fetch_add(ctr, 1u, __ATOMIC_RELAXED, __HIP_MEMORY_SCOPE_AGENT);
    return v;
}
__device__ __forceinline__ int unit_fetch_commit(int v, volatile LAS int* slot, int wv) {
    if (wv == 0 && lane_id_fresh() == 0) *slot = v;
    __syncthreads();
    const int r = *slot;
    __syncthreads();
    return r;
}
__device__ __forceinline__ int next_unit(unsigned* ctr, volatile LAS int* slot, int wv) {
    if (wv == 0 && lane_id_fresh() == 0) *slot = (int)__hip_atomic_fetch_add(ctr, 1u, __ATOMIC_RELAXED, __HIP_MEMORY_SCOPE_AGENT);
    __syncthreads();
    const int v = *slot;
    __syncthreads();
    return v;
}

template <int N> struct TabVals { float v[(N + NTHR - 1) / NTHR]; };
template <int N> __device__ __forceinline__ void tab_load(TabVals<N>& tv, int dmax, const float* b2, int col, int tid) {
#pragma unroll
    for (int it = 0; it < (N + NTHR - 1) / NTHR; ++it) { const int dist = dmax - (tid + it * NTHR); const int dc = dist < 0 ? 0 : dist > 1151 ? 1151 : dist; tv.v[it] = b2[col * 1152 + dc]; }
}
template <int N> __device__ __forceinline__ void tab_store(const TabVals<N>& tv, LAS float* T, int dmax, int lo, int hi, int tid) {
#pragma unroll
    for (int it = 0; it < (N + NTHR - 1) / NTHR; ++it) { const int i = tid + it * NTHR, dist = dmax - i; if (i < N) T[i] = (dist >= lo && dist < hi) ? tv.v[it] : NEG_INF; }
}
__device__ __forceinline__ void init_tab(f32x16& p0, f32x16& p1, const LAS float* tl) {
    asm volatile("" : "+v"(tl));
#pragma unroll
    for (int r = 0; r < 16; ++r) { p0[r] = tl[(r & 3) + 8 * (r >> 2)]; p1[r] = tl[32 + (r & 3) + 8 * (r >> 2)]; }
}
#define ATT_SCHED() __builtin_amdgcn_sched_barrier(0)
#ifndef HOIST_FOX
#define HOIST_FOX 1
#define HOIST_SWA 1
#define HOIST_CMP 0
#define HOIST_SLC 1
#endif
#ifndef STAG_FROM
#define STAG_FROM 4
#endif
#ifndef DMA_LATE
#define DMA_LATE 1
#endif
#ifndef SLC_ZC
#define SLC_ZC 1
#endif
#ifndef SLC_WINDOW
#define SLC_WINDOW 1
#endif
#ifndef STAG_FOX
#define STAG_FOX 1
#define STAG_SWA 1
#define STAG_CMP 1
#define STAG_SLC 1
#define STAG_WIN 1
#endif
__device__ __forceinline__ void load_k2(bf16x8 (&k2)[2], lcp kb, int d0, int r32, int hi) { lcp k0 = kb + hi * 1024 + r32 * 16 + d0 * 2048; k2[0] = *(const LAS bf16x8*)k0; k2[1] = *(const LAS bf16x8*)(k0 + 512); }
__device__ __forceinline__ void load_v2(bf16x8 (&v2)[2], lcp vb, int k, int lane, int hi) {
    lcp vp = vb + ((lane >> 4) & 1) * 32 + (lane & 3) * 8 + (4 * hi + ((lane & 15) >> 2)) * 64 + k * 1024;
    const s16x4 a0 = vtr(vp), a1 = vtr(vp + 512), b0 = vtr(vp + 4096), b1 = vtr(vp + 4096 + 512);
    v2[0] = (bf16x8){a0[0], a0[1], a0[2], a0[3], a1[0], a1[1], a1[2], a1[3]}; v2[1] = (bf16x8){b0[0], b0[1], b0[2], b0[3], b1[0], b1[1], b1[2], b1[3]};
}
template <int BASE, class Hook> __device__ __forceinline__ bf16x8 exp_chunk(const f32x16& c, float ms, float& s, Hook&& hook, int t, int k) {
    float e[8];
#pragma unroll
    for (int j = 0; j < 8; ++j) { e[j] = c[BASE + j] - ms; }
    float t0, t1, t2, t3; unsigned w0, w1, w2, w3;
    asm("v_exp_f32 %0, %0\n\tv_exp_f32 %1, %1\n\tv_exp_f32 %2, %2\n\tv_exp_f32 %3, %3\n\tv_exp_f32 %4, %4\n\tv_exp_f32 %5, %5\n\tv_exp_f32 %6, %6\n\tv_exp_f32 %7, %7\n\t"
        "v_add_f32 %8, %0, %1\n\tv_add_f32 %9, %2, %3\n\tv_cvt_pk_bf16_f32 %13, %0, %1\n\tv_add_f32 %10, %4, %5\n\tv_cvt_pk_bf16_f32 %14, %2, %3\n\tv_add_f32 %11, %6, %7\n\t"
        "v_add_f32 %8, %8, %9\n\tv_cvt_pk_bf16_f32 %15, %4, %5\n\tv_add_f32 %10, %10, %11\n\tv_cvt_pk_bf16_f32 %16, %6, %7\n\tv_add_f32 %8, %8, %10\n\tv_add_f32 %12, %12, %8"
        : "+v"(e[0]), "+v"(e[1]), "+v"(e[2]), "+v"(e[3]), "+v"(e[4]), "+v"(e[5]), "+v"(e[6]), "+v"(e[7]), "=&v"(t0), "=&v"(t1), "=&v"(t2), "=&v"(t3), "+v"(s),
          "=&v"(w0), "=&v"(w1), "=&v"(w2), "=&v"(w3));
    hook(t, k, e, ms);
    v4u w = {w0, w1, w2, w3};
    return __builtin_bit_cast(bf16x8, w);
}
__device__ __forceinline__ float softmax_head(St& st, const f32x16& p0, const f32x16& p1, bool live, float cadd, float& tmax) {
    float mxa = fmaxf(p0[0], p1[0]), mxb = fmaxf(p0[1], p1[1]);
#pragma unroll
    for (int r = 2; r < 16; r += 2) { mxa = fmaxf(fmaxf(mxa, p0[r]), p1[r]); mxb = fmaxf(fmaxf(mxb, p0[r + 1]), p1[r + 1]); }
    float mx = xhalf_max(fmaxf(mxa, mxb)) + cadd;
    if (!live) mx = NEG_INF;
    tmax = mx;
    if (__any(mx > st.m + SM_THR)) { const float mn = fmaxf(st.m, mx); const float f = ex2(st.m - mn); st.l *= f;
#pragma unroll
        for (int r = 0; r < 16; ++r) { st.o0[r] *= f; st.o1[r] *= f; }
        st.m = mn; }
    return live ? st.m - cadd : -NEG_INF;
}
#define MFMA32 __builtin_amdgcn_mfma_f32_32x32x16_bf16
template <int REL, class F, class... A> __device__ __forceinline__ decltype(auto) call_r(F& f, int t, A&... a) {
    if constexpr (std::is_invocable_v<F&, std::integral_constant<int, REL>, int, A&...>) return f(std::integral_constant<int, REL>{}, t, a...);
    else return f(t, a...);
}
template <int REL, class Init> __device__ __forceinline__ bool init_z(Init& init, int t, f32x16& p0, f32x16& p1) {
    if constexpr (std::is_same_v<decltype(call_r<REL>(init, t, p0, p1)), bool>) return call_r<REL>(init, t, p0, p1); else { call_r<REL>(init, t, p0, p1); return false; }
}
template <int REL, class Init> __device__ __forceinline__ void init_full(Init& init, int t, f32x16& p0, f32x16& p1) {
    if (init_z<REL>(init, t, p0, p1)) {
#pragma unroll
        for (int r = 0; r < 16; ++r) { p0[r] = 0.f; p1[r] = 0.f; } }
}
#define ZERO16 ((f32x16){0.f, 0.f, 0.f, 0.f, 0.f, 0.f, 0.f, 0.f, 0.f, 0.f, 0.f, 0.f, 0.f, 0.f, 0.f, 0.f})
#define QK0(KF) do { if (zi) { n0 = MFMA32(KF[0], qf[0], ZERO16, 0, 0, 0); n1 = MFMA32(KF[1], qf[0], ZERO16, 0, 0, 0); } else { n0 = MFMA32(KF[0], qf[0], n0, 0, 0, 0); n1 = MFMA32(KF[1], qf[0], n1, 0, 0, 0); } } while (0)
template <bool FAST = false, bool HOOKED = false, int STAG = 0, int PRE = 0, class Src, class Act, class Init, class Post, class Valu, class Pv, class Sargs, class Hook>
__device__ __forceinline__ void tile_loop_x(LAS unsigned char* lds, int nt, int pitch, const bf16x8 (&qf)[4], St* fst, Src src, Act act, Init init, Post post, Valu valu, Pv pv, Sargs sargs, Hook hook, int wid, int lane) {
    if (nt <= 0) return;
    const int r32 = lane & 31, hi = lane >> 5;
    if constexpr (PRE == 0) { const bf16 *kp, *vp; call_r<0>(src, 0, kp, vp); dma_k(kp, pitch, lds + L_K, wid, lane); dma_v(vp, pitch, lds + L_V, wid, lane); }
    if constexpr (PRE != 1) { if (nt > 1) { const bf16 *kp, *vp; call_r<1>(src, 1, kp, vp); dma_k(kp, pitch, lds + L_K + 8192, wid, lane); } }
    if (PRE == 2 && nt > 1) ATT_WAIT_BAR(1);
    else ATT_WAIT_BAR(0);
    f32x16 a0, a1, b0, b1;
    if (FAST || act(0)) { bf16x8 kf[8]; load_kf(kf, (lcp)(lds + L_K), r32, hi); init_full<0>(init, 0, a0, a1); qk_mfma(a0, a1, kf, qf); post(0, a0, a1); }
    auto step = [&](int t, f32x16& c0, f32x16& c1, f32x16& n0, f32x16& n1) {
        const int cur = (t & 1) * 8192, nxt = 8192 - cur;
        ATT_WAIT_BAR(0);
        auto issue_dma = [&]() {
            if (t + 2 < nt) { const bf16 *kp, *vp; call_r<2>(src, t + 2, kp, vp); dma_k(kp, pitch, lds + L_K + cur, wid, lane); }
            { const bf16 *kp, *vp; call_r<1>(src, t + 1, kp, vp); dma_v(vp, pitch, lds + L_V + nxt, wid, lane); } };
        if (!FAST || !DMA_LATE) issue_dma();
        const bool an = FAST || act(t + 1), ac = FAST || act(t);
        if constexpr (FAST) { {
            St& st = *fst; bool live; float cadd; call_r<0>(sargs, t, live, cadd);
            lcp kn = (lcp)(lds + L_K + nxt); lcp vc = (lcp)(lds + L_V + cur);
            bf16x8 ka[2], va[2], kb[2], vb[2];
            const bool zi = init_z<1>(init, t + 1, n0, n1); load_k2(ka, kn, 0, r32, hi);
            float tmax; const float ms = softmax_head(st, c0, c1, live, cadd, tmax);
            const bool alive = HOOKED || !__all(tmax < st.m - 150.f);
            if (alive) load_v2(va, vc, 0, lane, hi);
            float sacc = 0.f;
            if (DMA_LATE) issue_dma();
            ATT_SCHED();
            if constexpr (STAG == 1) {
                bf16x8 pa = {0, 0, 0, 0, 0, 0, 0, 0}, pb = {0, 0, 0, 0, 0, 0, 0, 0};
                { load_k2(kb, kn, 1, r32, hi); if (alive) { load_v2(vb, vc, 1, lane, hi); pa = exp_chunk<0>(c0, ms, sacc, hook, t, 0); } }
                ATT_SCHED();
                { if (alive) pb = exp_chunk<8>(c0, ms, sacc, hook, t, 1);
                  QK0(ka); if (alive) { st.o0 = MFMA32(va[0], pa, st.o0, 0, 0, 0); st.o1 = MFMA32(va[1], pa, st.o1, 0, 0, 0); } }
                ATT_SCHED();
                { load_k2(ka, kn, 2, r32, hi); if (alive) { load_v2(va, vc, 2, lane, hi); pa = exp_chunk<0>(c1, ms, sacc, hook, t, 2); }
                  n0 = MFMA32(kb[0], qf[1], n0, 0, 0, 0); n1 = MFMA32(kb[1], qf[1], n1, 0, 0, 0); if (alive) { st.o0 = MFMA32(vb[0], pb, st.o0, 0, 0, 0); st.o1 = MFMA32(vb[1], pb, st.o1, 0, 0, 0); } }
                ATT_SCHED();
                { load_k2(kb, kn, 3, r32, hi); if (alive) { load_v2(vb, vc, 3, lane, hi); pb = exp_chunk<8>(c1, ms, sacc, hook, t, 3); }
                  n0 = MFMA32(ka[0], qf[2], n0, 0, 0, 0); n1 = MFMA32(ka[1], qf[2], n1, 0, 0, 0); if (alive) { st.o0 = MFMA32(va[0], pa, st.o0, 0, 0, 0); st.o1 = MFMA32(va[1], pa, st.o1, 0, 0, 0); } }
                ATT_SCHED();
                { n0 = MFMA32(kb[0], qf[3], n0, 0, 0, 0); n1 = MFMA32(kb[1], qf[3], n1, 0, 0, 0); if (alive) { st.o0 = MFMA32(vb[0], pb, st.o0, 0, 0, 0); st.o1 = MFMA32(vb[1], pb, st.o1, 0, 0, 0); } }
                ATT_SCHED();
                st.l += sacc; post(t + 1, n0, n1);
                return;
            }
            { load_k2(kb, kn, 1, r32, hi); bf16x8 pk = {0, 0, 0, 0, 0, 0, 0, 0}; if (alive) { load_v2(vb, vc, 1, lane, hi); pk = exp_chunk<0>(c0, ms, sacc, hook, t, 0); }
              QK0(ka); if (alive) { st.o0 = MFMA32(va[0], pk, st.o0, 0, 0, 0); st.o1 = MFMA32(va[1], pk, st.o1, 0, 0, 0); } }
            ATT_SCHED();
            { load_k2(ka, kn, 2, r32, hi); bf16x8 pk = {0, 0, 0, 0, 0, 0, 0, 0}; if (alive) { load_v2(va, vc, 2, lane, hi); pk = exp_chunk<8>(c0, ms, sacc, hook, t, 1); }
              n0 = MFMA32(kb[0], qf[1], n0, 0, 0, 0); n1 = MFMA32(kb[1], qf[1], n1, 0, 0, 0); if (alive) { st.o0 = MFMA32(vb[0], pk, st.o0, 0, 0, 0); st.o1 = MFMA32(vb[1], pk, st.o1, 0, 0, 0); } }
            ATT_SCHED();
            { load_k2(kb, kn, 3, r32, hi); bf16x8 pk = {0, 0, 0, 0, 0, 0, 0, 0}; if (alive) { load_v2(vb, vc, 3, lane, hi); pk = exp_chunk<0>(c1, ms, sacc, hook, t, 2); }
              n0 = MFMA32(ka[0], qf[2], n0, 0, 0, 0); n1 = MFMA32(ka[1], qf[2], n1, 0, 0, 0); if (alive) { st.o0 = MFMA32(va[0], pk, st.o0, 0, 0, 0); st.o1 = MFMA32(va[1], pk, st.o1, 0, 0, 0); } }
            ATT_SCHED();
            { bf16x8 pk = {0, 0, 0, 0, 0, 0, 0, 0}; if (alive) pk = exp_chunk<8>(c1, ms, sacc, hook, t, 3);
              n0 = MFMA32(kb[0], qf[3], n0, 0, 0, 0); n1 = MFMA32(kb[1], qf[3], n1, 0, 0, 0); if (alive) { st.o0 = MFMA32(vb[0], pk, st.o0, 0, 0, 0); st.o1 = MFMA32(vb[1], pk, st.o1, 0, 0, 0); } }
            ATT_SCHED();
            st.l += sacc; post(t + 1, n0, n1);
            return;
        } }
        bf16x8 kf[8], vf[8]; Pf pf;
        if (an) { load_kf(kf, (lcp)(lds + L_K + nxt), r32, hi); init_full<1>(init, t + 1, n0, n1); ATT_SCHED(); }
        if (ac) { valu(t, c0, c1, pf); ATT_SCHED(); load_vf(vf, (lcp)(lds + L_V + cur), lane, hi); ATT_SCHED(); }
        if (an) { qk_mfma(n0, n1, kf, qf); post(t + 1, n0, n1); }
        if (ac) pv(t, vf, pf);
    };
    auto last = [&](int t, f32x16& c0, f32x16& c1) { ATT_WAIT_BAR(0);
        if constexpr (FAST) {
            St& st = *fst; bool live; float cadd; call_r<0>(sargs, t, live, cadd); lcp vc = (lcp)(lds + L_V + (t & 1) * 8192);
            bf16x8 vf[8]; load_vf(vf, vc, lane, hi);
            float tmax; const float ms = softmax_head(st, c0, c1, live, cadd, tmax); float sacc = 0.f; Pf pf;
            pf.f[0] = exp_chunk<0>(c0, ms, sacc, hook, t, 0); pf.f[1] = exp_chunk<8>(c0, ms, sacc, hook, t, 1); pf.f[2] = exp_chunk<0>(c1, ms, sacc, hook, t, 2); pf.f[3] = exp_chunk<8>(c1, ms, sacc, hook, t, 3);
            st.l += sacc; pv_mfma(st, vf, pf);
        } else {
        if (act(t)) { bf16x8 vf[8]; Pf pf; load_vf(vf, (lcp)(lds + L_V + (t & 1) * 8192), lane, hi); valu(t, c0, c1, pf); pv(t, vf, pf); } } };
    int t = 0;
    for (; t + 2 < nt; t += 2) { step(t, a0, a1, b0, b1); step(t + 1, b0, b1, a0, a1); }
    if (t + 1 < nt) { step(t, a0, a1, b0, b1); last(t + 1, b0, b1); } else last(t, a0, a1);
    ATT_BAR();
}
__device__ __forceinline__ void prologue_dma(LAS unsigned char* lds, int nt, int pitch, const bf16* k0, const bf16* v0, const bf16* k1, int wid, int lane) {
    dma_k(k0, pitch, lds + L_K, wid, lane); dma_v(v0, pitch, lds + L_V, wid, lane);
    if (nt > 1) dma_k(k1, pitch, lds + L_K + 8192, wid, lane);
}
template <class Src, class Act, class Init, class Post, class Valu, class Pv>
__device__ __forceinline__ void tile_loop(LAS unsigned char* lds, int nt, int pitch, const bf16x8 (&qf)[4], Src src, Act act, Init init, Post post, Valu valu, Pv pv, int wid, int lane) {
    tile_loop_x<false, false, 0>(lds, nt, pitch, qf, (St*)nullptr, src, act, init, post, valu, pv, [](int, bool&, float&) {}, [](int, int, const float (&)[8], float) {}, wid, lane);
}
template <int STAG = 0, int PRE = 0, class Src, class Act, class Init, class Post, class Sargs>
__device__ __forceinline__ void tile_loop_std(LAS unsigned char* lds, int nt, int pitch, const bf16x8 (&qf)[4], St& st, Src src, Act act, Init init, Post post, Sargs sargs, int wid, int lane) {
    auto valu = [&](int t, f32x16& p0, f32x16& p1, Pf& pf) { bool live; float cadd; call_r<0>(sargs, t, live, cadd); softmax(st, p0, p1, pf, live, cadd); };
    auto pv = [&](int t, const bf16x8 (&vf)[8], const Pf& pf) { pv_mfma(st, vf, pf); };
    auto nohook = [](int, int, const float (&)[8], float) {};
    if (STAG && wid >= STAG_FROM) tile_loop_x<true, false, 1, PRE>(lds, nt, pitch, qf, &st, src, act, init, post, valu, pv, sargs, nohook, wid, lane);
    else tile_loop_x<true, false, 0, PRE>(lds, nt, pitch, qf, &st, src, act, init, post, valu, pv, sargs, nohook, wid, lane);
}
template <int STAG = 0, int PRE = 0, class Src, class Init, class Post, class Sargs, class Hook>
__device__ __forceinline__ void tile_loop_hooked(LAS unsigned char* lds, int nt, int pitch, const bf16x8 (&qf)[4], St& st, Src src, Init init, Post post, Sargs sargs, Hook hook, int wid, int lane) {
    auto act = [](int) { return true; }; auto valu = [&](int t, f32x16& p0, f32x16& p1, Pf& pf) {}; auto pv = [&](int t, const bf16x8 (&vf)[8], const Pf& pf) {};
    if (STAG && wid >= STAG_FROM) tile_loop_x<true, true, 1, PRE>(lds, nt, pitch, qf, &st, src, act, init, post, valu, pv, sargs, hook, wid, lane);
    else tile_loop_x<true, true, 0, PRE>(lds, nt, pitch, qf, &st, src, act, init, post, valu, pv, sargs, hook, wid, lane);
}
#define SARGS_STD [](int, bool& live, float& cadd) { live = true; cadd = 0.f; }
#define ACT_ALL [](int) { return true; }
#define POST_NONE [](int, f32x16&, f32x16&) {}

__device__ __forceinline__ void fox_unit(LAS unsigned char* lds, int wv, const bf16* proj, const float* cum, bf16* O, float* ssq, int b, int h, int qb) {
    int tid_l = wv * 64 + lane_id_fresh(); asm volatile("" : "+v"(tid_l));
    const int tid = tid_l, lane = tid & 63, r32 = lane & 31, hi = lane >> 5, wid = __builtin_amdgcn_readfirstlane(tid >> 6);
    const int t0 = qb * 256, tw0 = t0 + 32 * wid, tq = tw0 + r32;
    bf16x8 qf[4];
    { const bf16* qp = proj + (size_t)(b * SEQ + tq) * NPROJ + C_QB + h * 64 + 8 * hi;
#pragma unroll
      for (int d0 = 0; d0 < 4; ++d0) qf[d0] = *(const GAS bf16x8*)(qp + 16 * d0); }
    const bf16* Kb = proj + (size_t)(b * SEQ) * NPROJ + C_KB + h * 64; const bf16* Vb = proj + (size_t)(b * SEQ) * NPROJ + C_VB + h * 64;
    const int NT = 4 * (qb + 1);
    if (HOIST_FOX) prologue_dma(lds, NT, NPROJ, Kb + (size_t)(64 * (NT - 1)) * NPROJ, Vb + (size_t)(64 * (NT - 1)) * NPROJ, Kb + (size_t)(64 * (NT - 2)) * NPROJ, wid, lane);
    LAS float* cs = (LAS float*)(lds + L_AUX);
    { LAS float* wt = (LAS float*)(lds + L_AUX + 16384);
      const float* src = cum + (size_t)(b * 4 + h) * SEQ + tid * 8;
      f32x4 v0 = {0.f, 0.f, 0.f, 0.f}, v1 = v0;
      if (tid * 8 < t0 + 256) { v0 = *(const GAS f32x4*)src; v1 = *(const GAS f32x4*)(src + 4); }
      const float sm = ((v0.x + v0.y) + (v0.z + v0.w)) + ((v1.x + v1.y) + (v1.z + v1.w));
      float x = sm;
#pragma unroll
      for (int o = 1; o < 64; o <<= 1) { const float tt = __shfl_up(x, o); if (lane >= o) x += tt; }
      if (lane == 63) wt[wid] = x;
      ATT_BAR();
      float run = x - sm;
      for (int w = 0; w < wid; ++w) run += wt[w];
      f32x4 o0, o1; run += v0.x; o0.x = run; run += v0.y; o0.y = run; run += v0.z; o0.z = run; run += v0.w; o0.w = run;
      run += v1.x; o1.x = run; run += v1.y; o1.y = run; run += v1.z; o1.z = run; run += v1.w; o1.w = run;
      *(LAS f32x4*)(cs + tid * 8) = o0 * (-LOG2E); *(LAS f32x4*)(cs + tid * 8 + 4) = o1 * (-LOG2E); }
    St st; st_init(st, -1e30f, 0.f);
    tile_loop_std<STAG_FOX, HOIST_FOX>(lds, NT, NPROJ, qf, st,
        [&](int i, const bf16*& kp, const bf16*& vp) { const int s0 = 64 * (NT - 1 - i); kp = Kb + (size_t)s0 * NPROJ; vp = Vb + (size_t)s0 * NPROJ; },
        [&](int i) { return 64 * (NT - 1 - i) <= tw0 + 31; },
        [&](int i, f32x16& p0, f32x16& p1) { const int s0 = 64 * (NT - 1 - i);
#pragma unroll
            for (int a = 0; a < 4; ++a) { const f32x4 c0 = *(const LAS f32x4*)(cs + s0 + 8 * a + 4 * hi), c1 = *(const LAS f32x4*)(cs + s0 + 32 + 8 * a + 4 * hi);
#pragma unroll
                for (int e = 0; e < 4; ++e) { p0[4 * a + e] = c0[e]; p1[4 * a + e] = c1[e]; } } },
        [&](int i, f32x16& p0, f32x16& p1) { const int s0 = 64 * (NT - 1 - i);
            if (s0 + 63 > tw0) { asm volatile("" ::: "memory");
#pragma unroll
                for (int r = 0; r < 16; ++r) { const int kv = s0 + (r & 3) + 8 * (r >> 2) + 4 * hi; if (kv > tq) p0[r] = NEG_INF; if (kv + 32 > tq) p1[r] = NEG_INF; } } },
        SARGS_STD, wid, lane);
    const float inv = 1.f / xhalf_sum(st.l);
    store_o(O + (size_t)(b * SEQ + tw0) * DM + 256 + h * 64, st.o0, st.o1, inv, lane, ssq + (size_t)(b * SEQ + tq) * 16 + 4 + h, lds + wid * 4608);
}
__device__ __forceinline__ void fox_phase(LAS unsigned char* lds, int wv, const bf16* proj, const float* cum, bf16* O, float* ssq, unsigned* ctr) {
    volatile LAS int* slot = (volatile LAS int*)(lds + LDSCTL_OFF + 64);
    for (int idx = (int)blockIdx.x; idx < 512; idx = (int)gridDim.x + next_unit(ctr, slot, wv)) {
        fox_unit(lds, wv, proj, cum, O, ssq, (idx & 31) >> 2, idx & 3, 15 - (idx >> 5));
    }
}

__device__ __forceinline__ void swa_unit(LAS unsigned char* lds, int wv, const bf16* proj, const float* rel_bias, const float* sinks, bf16* O, float* ssq, int b, int hkv, int qblk) {
    int tid_l = wv * 64 + lane_id_fresh(); asm volatile("" : "+v"(tid_l));
    const int tid = tid_l, lane = tid & 63, r32 = lane & 31, hi = lane >> 5, wid = __builtin_amdgcn_readfirstlane(tid >> 6);
    const int hq = 2 * hkv + (wid >> 2), t0 = qblk * 128, tq = t0 + 32 * (wid & 3) + r32;
    bf16x8 qf[4];
    { const bf16* qp = proj + (size_t)(b * SEQ + tq) * NPROJ + C_QA + hq * 64 + 8 * hi;
#pragma unroll
      for (int d0 = 0; d0 < 4; ++d0) qf[d0] = *(const GAS bf16x8*)(qp + 16 * d0); }
    const int k0 = (t0 == 0) ? 2 : 0;
    const bf16* Kb = proj + (size_t)(b * SEQ) * NPROJ + C_KA + hkv * 64; const bf16* Vb = proj + (size_t)(b * SEQ) * NPROJ + C_VA + hkv * 64;
    if (HOIST_SWA) { const int s00 = t0 - 128 + 64 * k0; prologue_dma(lds, 4 - k0, NPROJ, Kb + (size_t)s00 * NPROJ, Vb + (size_t)s00 * NPROJ, Kb + (size_t)(s00 + 64) * NPROJ, wid, lane); }
    LAS float* T = (LAS float*)(lds + L_AUX);
    { TabVals<384> ta, tb; tab_load(ta, 255, rel_bias, 2 * hkv, tid); tab_load(tb, 255, rel_bias, 2 * hkv + 1, tid);
      ATT_SCHED();
      tab_store(ta, T, 255, 0, 128, tid); tab_store(tb, T + 384, 255, 0, 128, tid); }
    const LAS float* Tw = T + (wid >> 2) * 384;
    St st; st_init(st, sinks[hq] * LOG2E, hi == 0 ? 1.f : 0.f);
    tile_loop_std<STAG_SWA, HOIST_SWA>(lds, 4 - k0, NPROJ, qf, st,
        [&](int t, const bf16*& kp, const bf16*& vp) { const int s0 = t0 - 128 + 64 * (k0 + t); kp = Kb + (size_t)s0 * NPROJ; vp = Vb + (size_t)s0 * NPROJ; },
        ACT_ALL,
        [&](int t, f32x16& p0, f32x16& p1) { const int s0 = t0 - 128 + 64 * (k0 + t); init_tab(p0, p1, Tw + (255 - (tq - s0) + 4 * hi)); },
        POST_NONE,
        SARGS_STD, wid, lane);
    const float inv = 1.f / xhalf_sum(st.l);
    store_o(O + (size_t)(b * SEQ + t0 + 32 * (wid & 3)) * DM + hq * 64, st.o0, st.o1, inv, lane, ssq + (size_t)(b * SEQ + tq) * 16 + hq, lds + wid * 4608);
}
__device__ __forceinline__ void swa_phase(LAS unsigned char* lds, int wv, const bf16* proj, const float* rel_bias, const float* sinks, bf16* O, float* ssq, unsigned* ctr) {
    volatile LAS int* slot = (volatile LAS int*)(lds + LDSCTL_OFF + 64);
    for (int idx = (int)blockIdx.x; idx < 512; idx = (int)gridDim.x + next_unit(ctr, slot, wv)) {
        swa_unit(lds, wv, proj, rel_bias, sinks, O, ssq, idx >> 6, (idx >> 5) & 1, idx & 31);
    }
}

constexpr int L_TSLC = L_AUX, N_TSLC = 1216, L_TWIN = L_TSLC + 4 * N_TSLC * 4, N_TWIN = 704, L_IMPB = L_TWIN + 4 * N_TWIN * 4, IMP_LD = 65;
static_assert(L_IMPB + 4 * 64 * IMP_LD * 4 <= RING_BYTES, "NSA LDS map");
constexpr int L_SELM = LDSCTL_OFF + 256, L_TLIST = LDSCTL_OFF + 1024, L_MREF = LDSCTL_OFF + 2048, L_MFIN = L_MREF + 4096;
__device__ __forceinline__ void nsa_unit(LAS unsigned char* lds, int wv, const bf16* proj, const bf16* kcmp, const bf16* vcmp, const float* rel_bias, const float* gates, bf16* O, float* ssq, int b, int hkv, int qb) {
    int tid_l = wv * 64 + lane_id_fresh(); asm volatile("" : "+v"(tid_l));
    const int tid = tid_l, lane = tid & 63, r32 = lane & 31, hi = lane >> 5, wid = __builtin_amdgcn_readfirstlane(tid >> 6);
    const int g = wid >> 1, h8 = 4 * hkv + g, t0 = qb * 64, qrow = 32 * (wid & 1) + r32, tw0 = t0 + 32 * (wid & 1), tq = t0 + qrow;
    bf16x8 qf[4];
    { const bf16* qp = proj + (size_t)(b * SEQ + tq) * NPROJ + C_QC + h8 * 64 + 8 * hi;
#pragma unroll
      for (int d0 = 0; d0 < 4; ++d0) qf[d0] = *(const GAS bf16x8*)(qp + 16 * d0); }
    const float* gp = gates + (size_t)(b * SEQ + tq) * 24 + h8 * 3;
    const float g_cmp = gp[0], g_slc = gp[1], g_win = gp[2];
    const bf16* Kc = kcmp + (size_t)((b * 2 + hkv) * 256) * 64; const bf16* Vc = vcmp + (size_t)((b * 2 + hkv) * 256) * 64;
    const int NTC = (4 * qb + 2) / 64 + 1;
    if (HOIST_CMP) prologue_dma(lds, NTC, 64, Kc, Vc, Kc + 64 * 64, wid, lane);
    LAS float* TS = (LAS float*)(lds + L_TSLC); LAS float* TW = (LAS float*)(lds + L_TWIN);
    { TabVals<N_TSLC> vs[4]; TabVals<N_TWIN> vw[4];
#pragma unroll
      for (int gg = 0; gg < 4; ++gg) { tab_load(vs[gg], 1151, rel_bias, 4 + 4 * hkv + gg, tid); tab_load(vw[gg], 639, rel_bias, 4 + 4 * hkv + gg, tid); }
      ATT_SCHED();
#pragma unroll
      for (int gg = 0; gg < 4; ++gg) { tab_store(vs[gg], TS + gg * N_TSLC, 1151, 0, 1 << 30, tid); tab_store(vw[gg], TW + gg * N_TWIN, 639, 0, 512, tid); } }
    const LAS float* Ts = TS + g * N_TSLC; const LAS float* Tw = TW + g * N_TWIN;
    LAS float* impb = (LAS float*)(lds + L_IMPB);
    volatile LAS unsigned long long* selm = (volatile LAS unsigned long long*)(lds + L_SELM);
    volatile LAS int* tlist = (volatile LAS int*)(lds + L_TLIST);
    f32x16 os0, os1;
    auto cmp_src = [&](int t, const bf16*& kp, const bf16*& vp) { kp = Kc + (size_t)t * 64 * 64; vp = Vc + (size_t)t * 64 * 64; };
    auto cmp_init = [&](int t, f32x16& p0, f32x16& p1) {
        const int dbase = tq - 31 - 16 * (64 * t + 4 * hi);
#pragma unroll
        for (int r = 0; r < 16; ++r) { const int kr = (r & 3) + 8 * (r >> 2);
            int d0 = dbase - 16 * kr, d1 = d0 - 512; d0 = d0 < -1 ? -1 : d0 > 1151 ? 1151 : d0; d1 = d1 < -1 ? -1 : d1 > 1151 ? 1151 : d1;
            p0[r] = Ts[1151 - d0]; p1[r] = Ts[1151 - d1]; }
    };
    LAS float* mref = (LAS float*)(lds + L_MREF);
    LAS float* mfin = (LAS float*)(lds + L_MFIN);
    { St st; st_init(st, -1e30f, 0.f); float carry = 0.f, ms_prev = 0.f;
      LAS float* ip = impb + (g * 64 + qrow) * IMP_LD + hi;
      tile_loop_hooked<STAG_CMP, HOIST_CMP>(lds, NTC, 64, qf, st, cmp_src, cmp_init, POST_NONE, SARGS_STD,
        [&](int t, int k, const float (&e)[8], float ms) {
            if (k == 0) { if (t > 0) carry *= ex2(ms_prev - ms); ms_prev = ms; if (hi == 0) mref[(g * 64 + qrow) * 4 + t] = ms; }
            const float own0 = (e[0] + e[1]) + (e[2] + 0.5f * e[3]), own1 = (e[4] + e[5]) + (e[6] + 0.5f * e[7]);
            const float pl0 = __shfl_xor(e[3], 32), pl1 = __shfl_xor(e[7], 32);
            const int j0 = 16 * t + 4 * k;
            ip[j0] = own0 + 0.5f * (hi ? pl0 : carry); ip[j0 + 2] = own1 + 0.5f * (hi ? pl1 : pl0);
            carry = pl1; },
        wid, lane);
      const float lt = xhalf_sum(st.l); const float inv_l = lt > 0.f ? 1.f / lt : 0.f;
      if (hi == 0) { mfin[g * 64 + qrow] = st.m; mfin[256 + g * 64 + qrow] = inv_l; }
      const float sc = g_cmp * inv_l;
      os0 = st.o0 * sc; os1 = st.o1 * sc; }
    ATT_BAR();
    if (HOIST_SLC) { const bf16* Kb0 = proj + (size_t)(b * SEQ) * NPROJ + C_KS + hkv * 64; const bf16* Vb0 = proj + (size_t)(b * SEQ) * NPROJ + C_VS + hkv * 64;
      dma_k(Kb0, NPROJ, lds + L_K, wid, lane); dma_v(Vb0, NPROJ, lds + L_V, wid, lane); }
    if (qb >= 16) {
        const int q = tid >> 3, part = tid & 7;
        LAS float* v = impb + q * IMP_LD;
        float fac[4];
#pragma unroll
        for (int gg = 0; gg < 4; ++gg) fac[gg] = ex2(mref[(gg * 64 + q) * 4 + (part >> 1)] - mfin[gg * 64 + q]) * mfin[256 + gg * 64 + q];
#pragma unroll
        for (int jj = 0; jj < 8; ++jj) { const int j = 8 * part + jj; v[j] = (v[j] * fac[0] + v[64 * IMP_LD + j] * fac[1]) + (v[2 * 64 * IMP_LD + j] * fac[2] + v[3 * 64 * IMP_LD + j] * fac[3]); }
        ATT_BAR();
        unsigned long long mk = part == 0 ? (1ull | (1ull << qb) | (1ull << (qb - 1))) : 0ull;
        unsigned long long kj[8]; int rank[8];
#pragma unroll
        for (int jj = 0; jj < 8; ++jj) { kj[jj] = ((unsigned long long)__float_as_uint(v[8 * part + jj]) << 6) | (unsigned)(63 - (8 * part + jj)); rank[jj] = 3; }
        for (int k = 1; k <= qb - 2; ++k) { const unsigned long long kk = ((unsigned long long)__float_as_uint(v[k]) << 6) | (unsigned)(63 - k);
#pragma unroll
            for (int jj = 0; jj < 8; ++jj) rank[jj] += kk > kj[jj] ? 1 : 0; }
#pragma unroll
        for (int jj = 0; jj < 8; ++jj) { const int j = 8 * part + jj; if (j >= 1 && j <= qb - 2 && rank[jj] < 16) mk |= 1ull << j; }
        unsigned lo = (unsigned)mk, hh = (unsigned)(mk >> 32);
#pragma unroll
        for (int o = 1; o < 8; o <<= 1) { lo |= __shfl_xor(lo, o); hh |= __shfl_xor(hh, o); }
        if (part == 0) selm[q] = ((unsigned long long)hh << 32) | lo;
    } else {
        if (tid < 64) selm[tid] = (2ull << qb) - 1ull;
    }
    ATT_BAR();
    if (wid == 0) {
        const unsigned long long mine = selm[lane]; unsigned lo = (unsigned)mine, hh = (unsigned)(mine >> 32);
#pragma unroll
        for (int o = 1; o < 64; o <<= 1) { lo |= __shfl_xor(lo, o); hh |= __shfl_xor(hh, o); }
        if (lane == 0) { tlist[0] = __builtin_popcount(lo) + __builtin_popcount(hh); tlist[65] = (int)lo; tlist[66] = (int)hh; }
    }
    ATT_BAR();
    const unsigned long long mysel = selm[qrow];
    const int ntl = tlist[0];
    LAS float* osl = (LAS float*)(lds + L_IMPB) + wid * 2048 + lane;
#pragma unroll
    for (int r = 0; r < 16; ++r) { osl[r * 64] = os0[r]; osl[(16 + r) * 64] = os1[r]; }
    { St st; st_init(st, -1e30f, 0.f);
      const bf16* Kb = proj + (size_t)(b * SEQ) * NPROJ + C_KS + hkv * 64; const bf16* Vb = proj + (size_t)(b * SEQ) * NPROJ + C_VS + hkv * 64;
      const float cfar = Ts[1151 - 1100];
      unsigned long long rem = ((unsigned long long)(unsigned)__builtin_amdgcn_readfirstlane(tlist[66]) << 32) | (unsigned)__builtin_amdgcn_readfirstlane(tlist[65]);
      auto pop = [&]() { const int j = rem ? __builtin_ctzll(rem) : 0; rem &= rem - 1ull; return j; };
      int tc = 0, w0 = pop(), w1 = pop(), w2 = pop();
      auto tile = [&](auto rel) { constexpr int R = decltype(rel)::value; return R == 0 ? w0 : R == 1 ? w1 : w2; };
      tile_loop_std<STAG_SLC, 2 * HOIST_SLC>(lds, ntl, NPROJ, qf, st,
        [&](auto rel, int t, const bf16*& kp, const bf16*& vp) { const int s0 = 64 * tile(rel); kp = Kb + (size_t)s0 * NPROJ; vp = Vb + (size_t)s0 * NPROJ; },
        ACT_ALL,
        [&](auto rel, int t, f32x16& p0, f32x16& p1) -> bool { const int s0 = 64 * tile(rel);
            if (tw0 - s0 <= 852) { init_tab(p0, p1, Ts + (1151 - (tq - s0) + 4 * hi)); return false; }
            return true; },
        [&](int t, f32x16&, f32x16&) { if (t > tc) { tc = t; w0 = w1; w1 = w2; w2 = pop(); } },
        [&](auto rel, int t, bool& live, float& cadd) { const int j = tile(rel); live = (mysel >> j) & 1ull; cadd = (tw0 - 64 * j <= 852) ? 0.f : cfar; },
        wid, lane);
      const float sc = g_slc / xhalf_sum(st.l);
#pragma unroll
      for (int r = 0; r < 16; ++r) { osl[r * 64] += st.o0[r] * sc; osl[(16 + r) * 64] += st.o1[r] * sc; } }
    { St st; st_init(st, -1e30f, 0.f);
      const bf16* Kb = proj + (size_t)(b * SEQ) * NPROJ + C_KW + hkv * 64; const bf16* Vb = proj + (size_t)(b * SEQ) * NPROJ + C_VW + hkv * 64;
      const int j0 = qb >= 8 ? qb - 8 : 0;
      tile_loop_std<STAG_WIN>(lds, qb - j0 + 1, NPROJ, qf, st,
        [&](int t, const bf16*& kp, const bf16*& vp) { const int s0 = 64 * (j0 + t); kp = Kb + (size_t)s0 * NPROJ; vp = Vb + (size_t)s0 * NPROJ; },
        ACT_ALL,
        [&](int t, f32x16& p0, f32x16& p1) { const int s0 = 64 * (j0 + t); init_tab(p0, p1, Tw + (639 - (tq - s0) + 4 * hi)); },
        POST_NONE,
        SARGS_STD, wid, lane);
      const float sc = g_win / xhalf_sum(st.l);
#pragma unroll
      for (int r = 0; r < 16; ++r) { os0[r] = osl[r * 64] + st.o0[r] * sc; os1[r] = osl[(16 + r) * 64] + st.o1[r] * sc; } }
    { int tq2 = tq; asm volatile("" : "+v"(tq2));
      store_o(O + (size_t)(b * SEQ + tw0) * DM + 512 + h8 * 64, os0, os1, 1.f, lane, ssq + (size_t)(b * SEQ + tq2) * 16 + 8 + h8, lds + wid * 4608); }
}
__device__ __forceinline__ void nsa_phase(LAS unsigned char* lds, int wv, const bf16* proj, const bf16* kcmp, const bf16* vcmp, const float* rel_bias, const float* gates, bf16* O, float* ssq, unsigned* ctr) {
    volatile LAS int* slot = (volatile LAS int*)(lds + LDSCTL_OFF + 64);
    for (int idx = (int)blockIdx.x; idx < 1024; idx = (int)gridDim.x + next_unit(ctr, slot, wv)) {
        nsa_unit(lds, wv, proj, kcmp, vcmp, rel_bias, gates, O, ssq, (idx & 15) >> 1, idx & 1, 63 - (idx >> 4));
    }
}

constexpr int L_RED = 0, L_HID = 16384, HID_LD = 136, L_HID2 = LDSCTL_OFF + 2048;
__device__ __forceinline__ void compress_unit(LAS unsigned char* lds, int wv, const bf16* proj, const bf16* w1t, const bf16* w2t, const float* cb1, bf16* kcmp, bf16* vcmp, int u) {
    int tid_l = wv * 64 + lane_id_fresh(); asm volatile("" : "+v"(tid_l));
    const int tid = tid_l, lane = tid & 63, r32 = lane & 31, hi = lane >> 5, wid = __builtin_amdgcn_readfirstlane(tid >> 6);
    const int i16 = lane & 15, kg = lane >> 4;
    const int mt = u & 7, kv = (u >> 3) & 1, hk = (u >> 4) & 1, b = u >> 5, n0 = 32 * mt;
    const int col0 = (kv ? C_VC : C_KC) + hk * 64;
    typedef float f32x4v __attribute__((ext_vector_type(4)));
    f32x4v acc[2][8];
#pragma unroll
    for (int rb = 0; rb < 2; ++rb)
#pragma unroll
        for (int cb = 0; cb < 8; ++cb) acc[rb][cb] = (f32x4v){0.f, 0.f, 0.f, 0.f};
    const bf16x8 zero8 = {0, 0, 0, 0, 0, 0, 0, 0};
    const int na = n0 + i16, nb = n0 + 16 + i16;
    const bf16* ar0 = proj + (size_t)(b * SEQ + 16 * (na < 255 ? na : 0)) * NPROJ + col0 + 8 * kg;
    const bf16* ar1 = proj + (size_t)(b * SEQ + 16 * (nb < 255 ? nb : 0)) * NPROJ + col0 + 8 * kg;
    const bf16* br = w1t + ((size_t)kv * 128 + i16) * 2048 + 8 * kg;
#pragma unroll 2
    for (int s8 = 0; s8 < 8; ++s8) { const int k = 256 * wid + 32 * s8;
        const size_t ao = (size_t)(k >> 6) * NPROJ + (k & 63);
        bf16x8 a0 = *(const GAS bf16x8*)(ar0 + ao), a1 = *(const GAS bf16x8*)(ar1 + ao);
        if (na >= 255) a0 = zero8; if (nb >= 255) a1 = zero8;
        bf16x8 bf[8];
#pragma unroll
        for (int cb = 0; cb < 8; ++cb) bf[cb] = *(const GAS bf16x8*)(br + (size_t)cb * 16 * 2048 + k);
#pragma unroll
        for (int cb = 0; cb < 8; ++cb) { acc[0][cb] = __builtin_amdgcn_mfma_f32_16x16x32_bf16(a0, bf[cb], acc[0][cb], 0, 0, 0); acc[1][cb] = __builtin_amdgcn_mfma_f32_16x16x32_bf16(a1, bf[cb], acc[1][cb], 0, 0, 0); } }
    LAS float* part = (LAS float*)lds;
#pragma unroll
    for (int rb = 0; rb < 2; ++rb)
#pragma unroll
        for (int cb = 0; cb < 8; ++cb)
#pragma unroll
            for (int e = 0; e < 4; ++e) part[(wid * 64 + (rb * 8 + cb) * 4 + e) * 64 + lane] = acc[rb][cb][e];
    ATT_BAR();
    LAS bf16* hid = (LAS bf16*)(lds + L_HID2);
#pragma unroll
    for (int q = 0; q < 8; ++q) { const int rr = 8 * wid + q; float x = 0.f;
#pragma unroll
        for (int w8 = 0; w8 < 8; ++w8) x += part[(w8 * 64 + rr) * 64 + lane];
        const int rb = rr >> 5, cb = (rr >> 2) & 7, e = rr & 3, row = 16 * rb + 4 * kg + e, col = 16 * cb + i16;
        x += cb1[kv * 128 + col];
        const float z = 0.7978845608028654f * (x + 0.044715f * x * x * x); const float th = 1.f - 2.f / (1.f + __expf(2.f * z));
        hid[row * HID_LD + col] = (bf16)f2bf(0.5f * x * (1.f + th)); }
    ATT_BAR();
    if (wid < 2) {
        f32x16 a2;
#pragma unroll
        for (int r = 0; r < 16; ++r) a2[r] = 0.f;
        const bf16* b2 = w2t + ((size_t)kv * 64 + 32 * wid + r32) * 128 + 8 * hi;
#pragma unroll
        for (int ks = 0; ks < 8; ++ks) { const bf16x8 a = *(const LAS bf16x8*)(hid + r32 * HID_LD + 16 * ks + 8 * hi); const bf16x8 bb = *(const GAS bf16x8*)(b2 + 16 * ks);
            a2 = __builtin_amdgcn_mfma_f32_32x32x16_bf16(a, bb, a2, 0, 0, 0); }
        bf16* out = (kv ? vcmp : kcmp) + (size_t)((b * 2 + hk) * 256 + n0) * 64 + 32 * wid + r32;
#pragma unroll
        for (int r = 0; r < 16; ++r) { const int row = (r & 3) + 8 * (r >> 2) + 4 * hi; out[(size_t)row * 64] = (n0 + row < 255) ? (bf16)f2bf(a2[r]) : (bf16)0; }
    }
    ATT_BAR();
}
__device__ __forceinline__ void thin_block(LAS unsigned char* lds, int wv, const bf16* hbuf, const bf16* wt, const float* fbias, float* logf, float* gates, int tb) {
    int tid_l = wv * 64 + lane_id_fresh(); asm volatile("" : "+v"(tid_l));
    const int tid = tid_l, lane = tid & 63, wid = __builtin_amdgcn_readfirstlane(tid >> 6), i16 = lane & 15, kg = lane >> 4, r0 = 128 * tb;
    typedef float f32x4v __attribute__((ext_vector_type(4)));
    f32x4v acc[8][2];
#pragma unroll
    for (int rb = 0; rb < 8; ++rb) { acc[rb][0] = (f32x4v){0.f, 0.f, 0.f, 0.f}; acc[rb][1] = (f32x4v){0.f, 0.f, 0.f, 0.f}; }
    const bf16* ar = hbuf + (size_t)(r0 + i16) * DM + 128 * wid + 8 * kg;
    const bf16* br = wt + (size_t)(C_FB + i16) * DM + 128 * wid + 8 * kg;
#pragma unroll 2
    for (int s4 = 0; s4 < 4; ++s4) {
        bf16x8 af[8];
#pragma unroll
        for (int rb = 0; rb < 8; ++rb) af[rb] = *(const GAS bf16x8*)(ar + (size_t)rb * 16 * DM + 32 * s4);
        const bf16x8 b0 = *(const GAS bf16x8*)(br + 32 * s4), b1 = *(const GAS bf16x8*)(br + (size_t)16 * DM + 32 * s4);
#pragma unroll
        for (int rb = 0; rb < 8; ++rb) { acc[rb][0] = __builtin_amdgcn_mfma_f32_16x16x32_bf16(af[rb], b0, acc[rb][0], 0, 0, 0); acc[rb][1] = __builtin_amdgcn_mfma_f32_16x16x32_bf16(af[rb], b1, acc[rb][1], 0, 0, 0); } }
    LAS float* part = (LAS float*)lds;
#pragma unroll
    for (int rb = 0; rb < 8; ++rb)
#pragma unroll
        for (int cb = 0; cb < 2; ++cb)
#pragma unroll
            for (int e = 0; e < 4; ++e) part[(wid * 64 + (rb * 2 + cb) * 4 + e) * 64 + lane] = acc[rb][cb][e];
    ATT_BAR();
#pragma unroll
    for (int q = 0; q < 8; ++q) { const int rr = 8 * wid + q; float v = 0.f;
#pragma unroll
        for (int w8 = 0; w8 < 8; ++w8) v += part[(w8 * 64 + rr) * 64 + lane];
        const int rb = rr >> 3, cb = (rr >> 2) & 1, e = rr & 3, row = r0 + 16 * rb + 4 * kg + e, c = 16 * cb + i16;
        if (c < 4) { const float z = v + fbias[c]; logf[(size_t)((row / SEQ) * 4 + c) * SEQ + (row % SEQ)] = fminf(z, 0.f) - log1pf(__expf(-fabsf(z))); }
        else if (c < 28) gates[(size_t)row * 24 + (c - 4)] = 1.f / (1.f + __expf(-v)); }
    ATT_BAR();
}
__device__ __forceinline__ void prep_phase(LAS unsigned char* lds, int wv, const bf16* proj, const bf16* w1t, const bf16* w2t, const float* cb1, bf16* kcmp, bf16* vcmp,
                                           const bf16* hbuf, const bf16* wint, const float* fbias, float* logf, float* gates) {
    int G = gridDim.x, bx = blockIdx.x; asm volatile("" : "+s"(G), "+s"(bx));
    for (int tb = bx; tb < M / 128; tb += G) thin_block(lds, wv, hbuf, wint, fbias, logf, gates, tb);
    for (int u = bx; u < 256; u += G) compress_unit(lds, wv, proj, w1t, w2t, cb1, kcmp, vcmp, u);
}
}
#define GBX() int G = G0, bx = bx0; asm volatile("" : "+s"(G), "+s"(bx))
#define FRAME() GBX(); Frame F; { int t_ = wv * 64 + lane_id_fresh(); asm volatile("" : "+v"(t_)); F.lds = lds_raw; F.tid = t_; F.lane = t_ & 63; F.wave = __builtin_amdgcn_readfirstlane(t_ >> 6); \
        const int vcu_ = (G % 8 == 0) ? (bx % 8) * (G / 8) + bx / 8 : bx; F.gw = vcu_ * NWAVES + F.wave; F.NGW = G * NWAVES; }
#define GRID_BAR() do { if (KINT(5)) xcd_barrier(bar); } while (0)
#define WSB(off) (KWS + (off))
#define P_H ((bf16*)WSB(WS_RH))
#define P_O ((bf16*)WSB(WS_RH))
#define P_PROJ ((bf16*)WSB(WS_R1))
#define P_U ((bf16*)WSB(WS_R1))
#define P_Y ((bf16*)WSB(WS_Y))
#define P_Y2 ((bf16*)WSB(WS_Y + 64 * MiB))
#define P_MOD(l) ((const float*)WSB(WS_MOD) + (size_t)(l) * 8 * 6144)
#define P_WL(l, off) ((const bf16*)(WSB(WS_W) + (size_t)(l) * WL_STRIDE + (off)))
#define IN(p) (KINT(2) <= (p) && (p) < KINT(3))
template <int l>
__device__ __forceinline__ void layer_body(LAS unsigned char* lds_raw, int wv, const XcdBarrier& bar, int G0, int bx0) {
    if (!(l >= KINT(0) && l < KINT(1))) return;
        if (IN(PH_PROJ)) for (int rep = 0; rep <= ((KINT(7) >> PH_PROJ) & 1); ++rep) {
            GBX(); pg8::Gemm g{P_H, P_WL(l, WL_IN), M, C_FB, DM}; pg8::StaticOrder S; S.init(M, C_FB, G, bx);
            pg8::EpiProj E{P_PROJ, (float*)WSB(WS_LOGF), (float*)WSB(WS_GATES), KIN(10) + l * 4};
            pg8::gemm_phase<pg8::EpiProj, pg8::StaticOrder, true, true>(lds_raw, g, S, E, wv);
            GRID_BAR();
        }
        if (IN(PH_PREP)) for (int rep = 0; rep <= ((KINT(7) >> PH_PREP) & 1); ++rep) {
            att::prep_phase(lds_raw, wv, P_PROJ, P_WL(l, WL_CW1), P_WL(l, WL_CW2), (const float*)WSB(WS_CB1) + l * 256, (bf16*)WSB(WS_KCMP), (bf16*)WSB(WS_VCMP),
                            P_H, P_WL(l, WL_IN), KIN(10) + l * 4, (float*)WSB(WS_LOGF), (float*)WSB(WS_GATES));
            GRID_BAR();
        }
        if (IN(PH_ATT)) for (int rep = 0; rep <= ((KINT(7) >> PH_ATT) & 1); ++rep) {
            if ((rep ? KINT(7) >> 16 : KINT(6)) & 4) att::nsa_phase(lds_raw, wv, P_PROJ, (const bf16*)WSB(WS_KCMP), (const bf16*)WSB(WS_VCMP), (const float*)WSB(WS_B2), (const float*)WSB(WS_GATES), P_O, (float*)WSB(WS_SS), (unsigned*)KWS + CW_Q + 64 * (16 * rep + 4 * l + 1));
            if ((rep ? KINT(7) >> 16 : KINT(6)) & 1) att::fox_phase(lds_raw, wv, P_PROJ, (const float*)WSB(WS_LOGF), P_O, (float*)WSB(WS_SS), (unsigned*)KWS + CW_Q + 64 * (16 * rep + 4 * l + 0));
            if ((rep ? KINT(7) >> 16 : KINT(6)) & 2) att::swa_phase(lds_raw, wv, P_PROJ, (const float*)WSB(WS_B2), KIN(11) + l * 4, P_O, (float*)WSB(WS_SS), (unsigned*)KWS + CW_Q + 64 * (16 * rep + 4 * l + 2));
            GRID_BAR();
        }
        if (IN(PH_WOUT)) for (int rep = 0; rep <= ((KINT(7) >> PH_WOUT) & 1); ++rep) {
            GBX(); pg8::Gemm g{P_O, P_WL(l, WL_OUT), M, DM, DM}; pg8::StaticOrder S; S.init(M, DM, G, bx);
            LAS f32x4* rf = (LAS f32x4*)(lds_raw + L_RF);
            pg8::Unit u0, u1; const bool h0 = S.next(0, u0), h1 = S.next(1, u1);
            { int t_ = wv * 64 + lane_id_fresh(); asm volatile("" : "+v"(t_));
              const bool hv = t_ < 256 ? h0 : h1; const int row = (t_ < 256 ? u0.pm : u1.pm) * 256 + (t_ & 255);
              if (hv) { const GAS f32x4* sp = (const GAS f32x4*)((const float*)WSB(WS_SS) + (size_t)row * 16); const f32x4 a = sp[0], b = sp[1], c = sp[2], d = sp[3];
                  const float qa = ((a[0] + a[1]) + (a[2] + a[3])) * (1.f / 256.f) + RMS_EPS, qb = ((b[0] + b[1]) + (b[2] + b[3])) * (1.f / 256.f) + RMS_EPS,
                              qc = (((c[0] + c[1]) + (c[2] + c[3])) + ((d[0] + d[1]) + (d[2] + d[3]))) * (1.f / 512.f) + RMS_EPS;
                  rf[t_] = (f32x4){sqrtf(qb / qa), sqrtf(qc / qb), rsqrtf(qc), 0.f}; } }
            __syncthreads();
            pg8::EpiYGn E{P_Y, DM, rf, u0.pm}; pg8::GnHook KH{rf};
            pg8::gemm_phase<pg8::EpiYGn, pg8::StaticOrder, true, true, pg8::GnHook>(lds_raw, g, S, E, wv, KH);
            GRID_BAR();
        }
        if (IN(PH_NORM2)) for (int rep = 0; rep <= ((KINT(7) >> PH_NORM2) & 1); ++rep) { FRAME(); norm_phase(F, KIN(0), P_Y, KIN(6) + l * DM, P_MOD(l), 2, nullptr, nullptr, 0, nullptr, KIN(7) + l * DM, P_MOD(l), 4, 3, P_H, l == 0 ? (const bf16*)nullptr : (const bf16*)KOUT); GRID_BAR(); }
        if (IN(PH_GU)) for (int rep = 0; rep <= ((KINT(7) >> PH_GU) & 1); ++rep) {
            GBX(); pg8::Gemm g{P_H, P_WL(l, WL_GU), M, 2 * FFN, DM}; pg8::StaticOrder S; S.init(M, 2 * FFN, G, bx);
            pg8::EpiSwiglu E{P_U};
            pg8::gemm_phase<pg8::EpiSwiglu, pg8::StaticOrder, true, true>(lds_raw, g, S, E, wv);
            GRID_BAR();
        }
        if (IN(PH_DOWN)) for (int rep = 0; rep <= ((KINT(7) >> PH_DOWN) & 1); ++rep) {
            GBX(); pg8::Gemm g{P_U, P_WL(l, WL_DOWN), M, DM, FFN}; pg8::StaticOrder S; S.init(M, DM, G, bx);
            pg8::EpiY E{P_Y2, DM};
            pg8::gemm_phase<pg8::EpiY, pg8::StaticOrder, true, true>(lds_raw, g, S, E, wv);
            GRID_BAR();
        }
        if (IN(PH_NORM3)) {
            const bool last = (l == DEPTH - 1); FRAME();
            norm_phase(F, KIN(0), P_Y, KIN(6) + l * DM, P_MOD(l), 2, P_Y2, KIN(8) + l * DM, 5, KOUT, KIN(5) + (last ? l : l + 1) * DM, P_MOD(last ? l : l + 1), 1, 0, last ? (bf16*)nullptr : P_H,
                       l == 0 ? (const bf16*)nullptr : (const bf16*)KOUT, last ? (bf16*)nullptr : (bf16*)KOUT);
            if (!last) GRID_BAR();
        }
}
__global__ void __launch_bounds__(NTHR, 2) __attribute__((target("no-packed-fp32-ops"))) mega(MArgs a) {
    extern __shared__ __attribute__((aligned(16))) unsigned char lds_dyn[];
    LAS unsigned char* lds_raw = (LAS unsigned char*)lds_dyn;
    const int G0 = gridDim.x, bx0 = blockIdx.x;
    const int wv = __builtin_amdgcn_readfirstlane((int)(threadIdx.x >> 6));
    { FRAME();
    for (int u = F.tid; u < (LDS_BYTES - LDSCTL_OFF) / 4; u += NTHR) ((LAS unsigned*)(F.lds + LDSCTL_OFF))[u] = 0u;
    __syncthreads(); }
    XcdBarrier bar; bar.bar = (unsigned*)KWS + CW_BAR; bar.x = 0; bar.st = nullptr; bar.wv = wv;
    if (KINT(5)) bar = xcd_barrier_post((unsigned*)KWS + CW_BAR, (volatile LAS unsigned*)(lds_raw + LDSCTL_OFF + 32), wv);
    if (KINT(4) & 1) for (int rep = 0; rep <= ((KINT(7) >> 9) & 1); ++rep) { FRAME(); pro_a(F); GRID_BAR(); }
    if (KINT(4) & 2) { FRAME(); cb1_finish(F); norm_phase(F, KIN(0), nullptr, nullptr, nullptr, 0, nullptr, nullptr, 0, nullptr, KIN(5), P_MOD(0), 1, 0, P_H); GRID_BAR(); }
    layer_body<0>(lds_raw, wv, bar, G0, bx0);
    layer_body<1>(lds_raw, wv, bar, G0, bx0);
    layer_body<2>(lds_raw, wv, bar, G0, bx0);
    layer_body<3>(lds_raw, wv, bar, G0, bx0);
}
#ifndef DUP_MASK
#define DUP_MASK 0
#endif
extern "C" void kernel_launch(void* const* d_in, const int* in_sizes, int n_in, void* d_out, int out_size, void* d_ws, size_t ws_size, hipStream_t stream) {
    if (n_in != 20 || out_size != M * DM || ws_size < WS_END) { fprintf(stderr, "kernel_launch: unexpected sizes n_in %d out %d ws %zu\n", n_in, out_size, ws_size); return; }
    static int grid = 0;
    if (grid == 0) {
        int dev = 0, cus = 0;
        if (hipGetDevice(&dev) != hipSuccess || hipDeviceGetAttribute(&cus, hipDeviceAttributeMultiprocessorCount, dev) != hipSuccess) { grid = -1; return; }
        if (hipFuncSetAttribute((const void*)mega, hipFuncAttributeMaxDynamicSharedMemorySize, LDS_BYTES) != hipSuccess) { fprintf(stderr, "hipFuncSetAttribute failed\n"); grid = -1; return; }
        int per_cu = 0;
        if (hipOccupancyMaxActiveBlocksPerMultiprocessor(&per_cu, (const void*)mega, NTHR, LDS_BYTES) != hipSuccess || per_cu < 1) { fprintf(stderr, "occupancy query reports %d workgroups per CU\n", per_cu); (void)hipGetLastError(); grid = -1; return; }
        grid = cus;
        if (grid != 256) { fprintf(stderr, "kernel_launch: this kernel is laid out for a 256-CU device (one workgroup per CU); found %d CUs\n", cus); grid = -1; return; }
    }
    if (grid < 0) return;
    (void)hipMemsetAsync(d_ws, 0, 1 * MiB, stream);
    MArgs a{};
    for (int i = 0; i < 20; ++i) a.in[i] = (const float*)d_in[i];
    a.out = (float*)d_out; a.ws = (unsigned char*)d_ws;
    a.lay_lo = 0; a.lay_hi = DEPTH; a.ph_lo = 0; a.ph_hi = NPH; a.do_pro = 3; a.use_bar = 1; a.att_mask = 7; a.pad = DUP_MASK;
    hipLaunchKernelGGL(mega, dim3(grid), dim3(NTHR), LDS_BYTES, stream, a);
}
```

```cpp
#include <hip/hip_runtime.h>
#include <cstdio>
#include <cstdint>
#include <type_traits>

#ifndef F32_MODE
#define F32_MODE 0
#endif

constexpr int DM = 1024, NB = 8, SEQ = 4096, DEPTH = 4, HD = 64;
constexpr int M = NB * SEQ;
constexpr int NIN = 2588, NPROJ = 2816, FFN = 2816;
constexpr float RMS_EPS = 1e-6f;
constexpr float LOG2E = 1.4426950408889634f;
constexpr float QSCALE = 0.125f * LOG2E;
constexpr int C_QA = 0, C_KA = 256, C_VA = 384, C_QB = 512, C_KB = 768, C_VB = 1024, C_QC = 1280, C_KC = 1792, C_VC = 1920,
              C_KS = 2048, C_VS = 2176, C_KW = 2304, C_VW = 2432, C_FB = 2560, C_GC = 2564;

#if F32_MODE
typedef float act_t;
__device__ __forceinline__ float ldA(const act_t* p) { return *p; }
__device__ __forceinline__ void stA(act_t* p, float v) { *p = v; }
#else
typedef unsigned short act_t;
__device__ __forceinline__ float ldA(const act_t* p) { return __uint_as_float(((unsigned)*p) << 16); }
__device__ __forceinline__ void stA(act_t* p, float v) { unsigned u = __float_as_uint(v); *p = (act_t)((u + 0x7fffu + ((u >> 16) & 1u)) >> 16); }
#endif

constexpr size_t MiB = 1u << 20;
constexpr size_t WS_MOD = 1 * MiB, WS_LOGF = 2 * MiB, WS_CUM = 2 * MiB + 512 * 1024, WS_GATES = 3 * MiB, WS_KCMP = 6 * MiB, WS_VCMP = 7 * MiB,
                 WS_SEL = 8 * MiB, WS_IMP = 9 * MiB, WS_STATS = 25 * MiB;
#if F32_MODE
constexpr size_t WS_RH = 32 * MiB, WS_R1 = 160 * MiB, WS_Y = WS_R1, WS_Y2 = WS_RH, WS_END = 512 * MiB;
#else
constexpr size_t WS_RH = 32 * MiB, WS_Y = 96 * MiB, WS_Y2 = WS_Y, WS_R1 = 224 * MiB, WS_W = 400 * MiB, WS_END = 512 * MiB;
#endif

__device__ __forceinline__ int t5_bucket(int dist) {
    if (dist < 16) return dist < 0 ? 0 : dist;
    int b = 16;
    b += dist >= 21; b += dist >= 27; b += dist >= 35; b += dist >= 46; b += dist >= 59; b += dist >= 77; b += dist >= 99; b += dist >= 128;
    b += dist >= 166; b += dist >= 216; b += dist >= 280; b += dist >= 363; b += dist >= 470; b += dist >= 609; b += dist >= 790;
    return b;
}
__device__ __forceinline__ float wave_sum(float v) {
#pragma unroll
    for (int o = 1; o < 64; o <<= 1) v += __shfl_xor(v, o);
    return v;
}

__device__ __forceinline__ int lane_id_fresh() { int x; asm volatile("v_mbcnt_lo_u32_b32 %0, -1, 0\n\tv_mbcnt_hi_u32_b32 %0, -1, %0" : "=v"(x)); return x; }
namespace pg8 {
#define PG8_LAS __attribute__((address_space(3)))
typedef unsigned short bf16_t;
typedef short bf16x8 __attribute__((ext_vector_type(8)));
typedef float f32x4 __attribute__((ext_vector_type(4)));
typedef unsigned u32x4 __attribute__((ext_vector_type(4)));
constexpr int BM = 256, BK = 64, HALF = 128, HTB = HALF * BK * 2  , STAGE_BYTES = 8 * HTB, NXCD = 8, WGM = 8;

__host__ __device__ __forceinline__ int lds_byte(int r, int c) { const int st = (r >> 4) * 2 + (c >> 5), rr = r & 15, cc = c & 31, ob = rr * 64 + cc * 2; return st * 1024 + (ob ^ (((ob >> 9) & 1) << 5)); }
__host__ __device__ __forceinline__ void stage_rc(int b, int& R, int& C) { const int st = b / 1024, sb = b % 1024, swz = sb ^ (((sb >> 9) & 1) << 5); R = (st >> 1) * 16 + swz / 64; C = (st & 1) * 32 + (swz % 64) / 2; }
__host__ __device__ __forceinline__ int perm32(int rho) { const int n = rho >> 4, i = rho & 15; return 8 * (i >> 2) + 4 * n + (i & 3); }

struct Unit { int pm, pn; };
struct Gemm { const bf16_t* A; const bf16_t* Bt; int M, N, K; };

struct StaticOrder {
    int nM, nN, nwg, G, c;
    __host__ __device__ __forceinline__ void init(int M, int N, int G_, int c_) { nM = M / BM; nN = N / BM; nwg = nM * nN; G = G_; c = c_; }
    __host__ __device__ __forceinline__ bool next(int i, Unit& u) const {
        const long L = (long)i * G + c; if (L >= nwg) return false;
        int wgid = (int)L; { const int q = nwg / NXCD, r = nwg % NXCD, xcd = wgid % NXCD, off = wgid / NXCD; wgid = (xcd < r ? xcd * (q + 1) : r * (q + 1) + (xcd - r) * q) + off; }
        const int nig = WGM * nN, gid = wgid / nig, fm = gid * WGM, gsz = (nM - fm) < WGM ? (nM - fm) : WGM;
        u.pm = fm + ((wgid % nig) % gsz); u.pn = (wgid % nig) / gsz; return true;
    }
    __device__ __forceinline__ void a_ready(const Unit&) const {}
    __device__ __forceinline__ void done(const Unit&) const {}
};

__device__ __forceinline__ unsigned cvt_pk_bf16(float lo, float hi) { unsigned r; asm volatile("v_cvt_pk_bf16_f32 %0, %1, %2" : "=v"(r) : "v"(lo), "v"(hi)); return r; }
struct NoKHook { static constexpr bool ACTIVE = false; };
template <class Epi, class Sched, bool ALIGN_EPI = false, bool SP2 = false, class KH = NoKHook>
__device__ __forceinline__ void gemm_phase(PG8_LAS unsigned char* lds, const Gemm g, const Sched& S, const Epi& E, int wv, const KH& kh = KH()) {
    int tid_l = wv * 64 + lane_id_fresh(); asm volatile("" : "+v"(tid_l));
    const int tid = tid_l, wid = __builtin_amdgcn_readfirstlane(tid >> 6), lane = tid & 63, wr = wid >> 2, wc = wid & 3, fr = lane & 15, fq = lane >> 4;
    const int K = g.K, nt = K / BK;
    unsigned voffA[2], voffB[2];
#pragma unroll
    for (int i = 0; i < 2; ++i) { int R, C; stage_rc(tid * 16 + i * 8192, R, C); const int Rb = Epi::PERM ? ((R & ~31) + perm32(R & 31)) : R;
        voffA[i] = (unsigned)(R * K + C) * 2u; voffB[i] = (unsigned)(Rb * K + C) * 2u; }
    const size_t kstep = (size_t)(BK * 2);
    const size_t hstep = (size_t)HALF * K * 2;
    const size_t tstep = 2 * hstep;
    const unsigned ldsw = (unsigned)wid * 1024u;
    const int aoff = lds_byte(wr * 64 + fr, fq * 8), boff = lds_byte(wc * 32 + fr, fq * 8);
#define PG8_SA(b, h) (((b) * 2 + (h)) * HTB)
#define PG8_SB(b, h) ((4 + (b) * 2 + (h)) * HTB)
#define PG8_STAGE(bufoff, gbase, voff) do { _Pragma("unroll") for (int _i = 0; _i < 2; ++_i) \
        __builtin_amdgcn_global_load_lds((const unsigned*)((const char*)(gbase) + (voff)[_i]), (PG8_LAS unsigned*)(lds + (bufoff) + ldsw + _i * 8192), 16, 0, 0); } while (0)
#define PG8_LDA(dst, b, h) do { _Pragma("unroll") for (int m = 0; m < 4; ++m) _Pragma("unroll") for (int k = 0; k < 2; ++k) dst[m][k] = *(const PG8_LAS bf16x8*)(lds + PG8_SA(b, h) + aoff + m * 2048 + k * 1024); } while (0)
#define PG8_LDB(dst, b, h) do { _Pragma("unroll") for (int n = 0; n < 2; ++n) _Pragma("unroll") for (int k = 0; k < 2; ++k) dst[n][k] = *(const PG8_LAS bf16x8*)(lds + PG8_SB(b, h) + boff + n * 2048 + k * 1024); } while (0)
#define PG8_MMA(ai, bj, At, Bt) do { __builtin_amdgcn_s_setprio(1); _Pragma("unroll") for (int m = 0; m < 4; ++m) _Pragma("unroll") for (int n = 0; n < 2; ++n) _Pragma("unroll") for (int k = 0; k < 2; ++k) \
        acc[ai][bj][m][n] = __builtin_amdgcn_mfma_f32_16x16x32_bf16(Bt[n][k], At[m][k], acc[ai][bj][m][n], 0, 0, 0); __builtin_amdgcn_s_setprio(0); } while (0)
#define PG8_WAIT_V(n) asm volatile("s_waitcnt vmcnt(" #n ")" ::: "memory")
#define PG8_WAIT_L(n) asm volatile("s_waitcnt lgkmcnt(" #n ")" ::: "memory")
#define PG8_BAR __builtin_amdgcn_s_barrier()
#define PG8_SCHED __builtin_amdgcn_sched_barrier(0)
    Unit cur, nxt; int ui = 0;
    if (!S.next(0, cur)) return;
    f32x4 acc[2][2][4][2];
#pragma unroll
    for (int a = 0; a < 2; ++a)
#pragma unroll
        for (int b = 0; b < 2; ++b)
#pragma unroll
            for (int m = 0; m < 4; ++m)
#pragma unroll
                for (int n = 0; n < 2; ++n) acc[a][b][m][n] = (f32x4){0.f, 0.f, 0.f, 0.f};
    bf16x8 At[4][2], B0[2][2], B1[2][2];
    const char* cA = (const char*)g.A + (size_t)cur.pm * tstep; const char* cB = (const char*)g.Bt + (size_t)cur.pn * tstep;
    S.a_ready(cur);
    if constexpr (SP2) {
        PG8_STAGE(PG8_SB(0, 0), cB, voffB); PG8_STAGE(PG8_SB(0, 1), cB + hstep, voffB); PG8_STAGE(PG8_SA(0, 0), cA, voffA); PG8_STAGE(PG8_SA(0, 1), cA + hstep, voffA);
        if (wr == 1) PG8_BAR;
        PG8_WAIT_V(2); PG8_BAR;
        PG8_STAGE(PG8_SB(1, 0), cB + kstep, voffB); PG8_STAGE(PG8_SA(1, 0), cA + kstep, voffA); PG8_STAGE(PG8_SB(1, 1), cB + hstep + kstep, voffB);
        PG8_WAIT_V(6); PG8_BAR;
    } else {
        PG8_STAGE(PG8_SB(0, 0), cB, voffB); PG8_STAGE(PG8_SA(0, 0), cA, voffA); PG8_STAGE(PG8_SB(0, 1), cB + hstep, voffB); PG8_STAGE(PG8_SA(0, 1), cA + hstep, voffA);
        if (wr == 1) PG8_BAR;
        PG8_WAIT_V(4); PG8_BAR;
        PG8_STAGE(PG8_SB(1, 0), cB + kstep, voffB); PG8_STAGE(PG8_SA(1, 0), cA + kstep, voffA); PG8_STAGE(PG8_SB(1, 1), cB + hstep + kstep, voffB);
        PG8_WAIT_V(6); PG8_BAR;
    }
    for (;;) {
        const bool has_next = S.next(ui + 1, nxt);
        const char* nA = has_next ? (const char*)g.A + (size_t)nxt.pm * tstep : cA; const char* nB = has_next ? (const char*)g.Bt + (size_t)nxt.pn * tstep : cB;
        for (int t = 0; t < nt; t += 2) {
            if constexpr (KH::ACTIVE) { if (t == KH::T1 || t == KH::T2) kh.apply(acc, t, ui, wr, fr); }
            const bool last = (t == nt - 2);
            const char* a1 = cA + (size_t)(t + 1) * kstep;
            const char* a2 = last ? nA : cA + (size_t)(t + 2) * kstep; const char* b2 = last ? nB : cB + (size_t)(t + 2) * kstep;
            const char* a3 = a2 + kstep; const char* b3 = b2 + kstep;
            if (last && has_next) S.a_ready(nxt);
            if constexpr (SP2) {
            PG8_LDB(B0, 0, 0); PG8_LDB(B1, 0, 1); PG8_SCHED; PG8_LDA(At, 0, 0); PG8_STAGE(PG8_SA(1, 1), a1 + hstep, voffA);
            PG8_WAIT_V(8); PG8_WAIT_L(0); PG8_BAR; PG8_MMA(0, 0, At, B0); PG8_MMA(0, 1, At, B1); PG8_BAR; PG8_SCHED;
            PG8_LDA(At, 0, 1); PG8_STAGE(PG8_SB(0, 0), b2, voffB); PG8_STAGE(PG8_SB(0, 1), b2 + hstep, voffB); PG8_STAGE(PG8_SA(0, 0), a2, voffA);
            PG8_WAIT_V(8); PG8_WAIT_L(0); PG8_BAR; PG8_MMA(1, 0, At, B0); PG8_MMA(1, 1, At, B1); PG8_BAR; PG8_SCHED;
            PG8_LDB(B0, 1, 0); PG8_LDB(B1, 1, 1); PG8_SCHED; PG8_LDA(At, 1, 0); PG8_STAGE(PG8_SA(0, 1), a2 + hstep, voffA);
            PG8_WAIT_V(8); PG8_WAIT_L(0); PG8_BAR; PG8_MMA(0, 0, At, B0); PG8_MMA(0, 1, At, B1); PG8_BAR; PG8_SCHED;
            PG8_LDA(At, 1, 1); PG8_STAGE(PG8_SB(1, 0), b3, voffB); PG8_STAGE(PG8_SB(1, 1), b3 + hstep, voffB); PG8_STAGE(PG8_SA(1, 0), a3, voffA);
            PG8_WAIT_V(8); PG8_WAIT_L(0); PG8_BAR; PG8_MMA(1, 0, At, B0); PG8_MMA(1, 1, At, B1); PG8_BAR; PG8_SCHED;
            } else {
            PG8_LDB(B0, 0, 0); PG8_SCHED; PG8_LDA(At, 0, 0); PG8_STAGE(PG8_SA(1, 1), a1 + hstep, voffA);
            PG8_WAIT_L(8); PG8_BAR; PG8_WAIT_L(0); PG8_MMA(0, 0, At, B0); PG8_BAR; PG8_SCHED;
            PG8_LDB(B1, 0, 1); PG8_STAGE(PG8_SB(0, 0), b2, voffB);
            PG8_BAR; PG8_WAIT_L(0); PG8_MMA(0, 1, At, B1); PG8_BAR;
            PG8_LDA(At, 0, 1); PG8_STAGE(PG8_SA(0, 0), a2, voffA);
            PG8_BAR; PG8_WAIT_L(0); PG8_MMA(1, 0, At, B0); PG8_BAR; PG8_SCHED;
            PG8_STAGE(PG8_SB(0, 1), b2 + hstep, voffB);
            PG8_WAIT_V(6); PG8_BAR; PG8_MMA(1, 1, At, B1); PG8_BAR;
            PG8_LDB(B0, 1, 0); PG8_SCHED; PG8_LDA(At, 1, 0); PG8_STAGE(PG8_SA(0, 1), a2 + hstep, voffA);
            PG8_WAIT_L(8); PG8_BAR; PG8_WAIT_L(0); PG8_MMA(0, 0, At, B0); PG8_BAR; PG8_SCHED;
            PG8_LDB(B1, 1, 1); PG8_STAGE(PG8_SB(1, 0), b3, voffB);
            PG8_BAR; PG8_WAIT_L(0); PG8_MMA(0, 1, At, B1); PG8_BAR;
            PG8_LDA(At, 1, 1); PG8_STAGE(PG8_SA(1, 0), a3, voffA);
            PG8_BAR; PG8_WAIT_L(0); PG8_MMA(1, 0, At, B0); PG8_BAR; PG8_SCHED;
            PG8_STAGE(PG8_SB(1, 1), b3 + hstep, voffB);
            PG8_WAIT_V(6); PG8_BAR; PG8_MMA(1, 1, At, B1); PG8_BAR;
            }
        }
        if constexpr (ALIGN_EPI) { if (wr == 0) PG8_BAR; }
        if constexpr (!Epi::AFTER_DRAIN) { E(acc, cur, wr, wc, fr, fq); S.done(cur); }
        if (!has_next) break;
#pragma unroll
        for (int a = 0; a < 2; ++a)
#pragma unroll
            for (int b = 0; b < 2; ++b)
#pragma unroll
                for (int m = 0; m < 4; ++m)
#pragma unroll
                    for (int n = 0; n < 2; ++n) acc[a][b][m][n] = (f32x4){0.f, 0.f, 0.f, 0.f};
        cur = nxt; cA = nA; cB = nB; ++ui;
        if constexpr (ALIGN_EPI) { if (wr == 1) PG8_BAR; }
    }
    PG8_WAIT_V(0);
    if constexpr (!ALIGN_EPI) { if (wr == 0) PG8_BAR; }
    PG8_BAR;
    if constexpr (Epi::AFTER_DRAIN) { E.fused(acc, cur, wr, wc, fr, fq, lds, wid, lane); S.done(cur); }
#undef PG8_SA
#undef PG8_SB
#undef PG8_STAGE
#undef PG8_LDA
#undef PG8_LDB
#undef PG8_MMA
#undef PG8_WAIT_V
#undef PG8_WAIT_L
#undef PG8_BAR
#undef PG8_SCHED
}
}
#define LAS __attribute__((address_space(3)))
#define XB_TMO      128
#define XB_XCNT(j)  (256  + 64 * (j))
#define XB_XSUB(j)  (1280 + 64 * (j))
#define XB_XGEN(j)  (2304 + 64 * (j))
#define XB_TOP      3328
#define XB_TOPGEN   3392
#define XCD_BAR_WORDS 3456
#define XB_SPIN_CAP (1u << 18)

__device__ __forceinline__ unsigned xb_ld(unsigned* p)              { return __hip_atomic_load(p, __ATOMIC_RELAXED, __HIP_MEMORY_SCOPE_AGENT); }
__device__ __forceinline__ unsigned xb_add(unsigned* p, unsigned v) { return __hip_atomic_fetch_add(p, v, __ATOMIC_RELAXED, __HIP_MEMORY_SCOPE_AGENT); }
__device__ __forceinline__ unsigned xb_xcc_id() { return (unsigned)__builtin_amdgcn_s_getreg((3 << 11) | 20) & 0xFu; }
#define XB_SPIN(cond, bar) do { unsigned _sp = 0; while (cond) { __builtin_amdgcn_s_sleep(1); \
    if ((++_sp & 255u) == 0u) { if (xb_ld(&(bar)[XB_TMO])) break; if (_sp > XB_SPIN_CAP) { atomicAdd(&(bar)[XB_TMO], 1u); break; } } } } while (0)

struct XcdBarrier {
    unsigned* bar; unsigned x; int wv;
    volatile LAS unsigned* st;
};

__device__ __forceinline__ bool xb_thread0(int wv) { return wv == 0 && lane_id_fresh() == 0; }
__device__ __forceinline__ XcdBarrier xcd_barrier_post(unsigned* bar, volatile LAS unsigned* st, int wv) {
    XcdBarrier b; b.bar = bar; b.x = xb_xcc_id(); b.st = st; b.wv = wv;
    if (xb_thread0(wv)) (void)xb_add(&bar[XB_XCNT(b.x)], 1u);
    return b;
}
__device__ __forceinline__ void xcd_barrier_complete(unsigned* bar, unsigned x, unsigned& nloc, unsigned& nx) {
    const unsigned G = gridDim.x * gridDim.y * gridDim.z;
    unsigned sum, cnt, mine, sp = 0u;
    for (;;) {
        sum = 0u; cnt = 0u; mine = 0u;
#pragma unroll
        for (unsigned j = 0; j < 16; ++j) { const unsigned c = xb_ld(&bar[XB_XCNT(j)]); sum += c; cnt += (c > 0u) ? 1u : 0u; mine = (j == x) ? c : mine; }
        if (sum == G) break;
        __builtin_amdgcn_s_sleep(1);
        if ((++sp & 255u) == 0u) { if (xb_ld(&bar[XB_TMO])) break; if (sp > XB_SPIN_CAP) { atomicAdd(&bar[XB_TMO], 1u); break; } }
    }
    nloc = mine > 0u ? mine : 1u; nx = cnt > 0u ? cnt : 1u;
}

__device__ __forceinline__ void xcd_barrier(const XcdBarrier& b) {
    asm volatile("s_waitcnt vmcnt(0)" ::: "memory");
    __syncthreads();
    if (xb_thread0(b.wv)) {
        unsigned* bar = b.bar;
        __builtin_amdgcn_s_waitcnt(0);
        unsigned nloc = b.st[0], nx = b.st[1];
        if (nloc == 0u) { xcd_barrier_complete(bar, b.x, nloc, nx); b.st[0] = nloc; b.st[1] = nx; }
        const unsigned old = xb_add(&bar[XB_XSUB(b.x)], 1u);
        const unsigned gen = old / nloc;
        if (old + 1u == (gen + 1u) * nloc) {
            __builtin_amdgcn_fence(__ATOMIC_RELEASE, "agent");
            asm volatile("s_waitcnt vmcnt(0)" ::: "memory");
            const unsigned og = xb_add(&bar[XB_TOP], 1u);
            const unsigned tg = og / nx;
            if (og + 1u == (tg + 1u) * nx) xb_add(&bar[XB_TOPGEN], 1u);
            else XB_SPIN(xb_ld(&bar[XB_TOPGEN]) == tg, bar);
            __builtin_amdgcn_fence(__ATOMIC_ACQUIRE, "agent");
            xb_add(&bar[XB_XGEN(b.x)], 1u);
            asm volatile("s_waitcnt vmcnt(0)" ::: "memory");
        } else {
            XB_SPIN(xb_ld(&bar[XB_XGEN(b.x)]) == gen, bar);
            __builtin_amdgcn_fence(__ATOMIC_ACQUIRE, "agent");
            asm volatile("s_waitcnt vmcnt(0)" ::: "memory");
        }
    }
    __syncthreads();
}

#undef LAS
#define GAS __attribute__((address_space(1)))
#define LAS __attribute__((address_space(3)))
typedef unsigned short bf16;
typedef unsigned v4u __attribute__((ext_vector_type(4)));
typedef unsigned v2u __attribute__((ext_vector_type(2)));
typedef float f32x4 __attribute__((ext_vector_type(4)));
#define LDS_WAIT() asm volatile("s_waitcnt lgkmcnt(0)" ::: "memory")
#define VM_WAIT() asm volatile("s_waitcnt vmcnt(0)" ::: "memory")
__device__ __forceinline__ unsigned f2bf(float f) { unsigned u = __builtin_bit_cast(unsigned, f); return (u + 0x7fffu + ((u >> 16) & 1u)) >> 16; }
__device__ __forceinline__ unsigned pk2(float lo, float hi) { return f2bf(lo) | (f2bf(hi) << 16); }
__device__ __forceinline__ float bf_lo(unsigned w) { return __uint_as_float(w << 16); }
__device__ __forceinline__ float bf_hi(unsigned w) { return __uint_as_float(w & 0xffff0000u); }

constexpr int NWAVES = 8, NTHR = 512;
constexpr int RING_BYTES = 131072, LDSCTL_OFF = RING_BYTES, LDS_BYTES = 147456;
constexpr size_t WL_STRIDE = 26 * MiB, WL_IN = 0, WL_OUT = 6 * MiB, WL_GU = 8 * MiB, WL_DOWN = 19 * MiB, WL_CW2 = 24 * MiB + 512 * 1024, WL_CW1 = 25 * MiB;
constexpr size_t WS_SS = 9 * MiB;
constexpr int L_RF = LDSCTL_OFF + 2048;
constexpr size_t WS_B2 = 600 * 1024;
constexpr size_t WS_CB1P = 704 * 1024;
constexpr size_t WS_CB1 = 512 * 1024;
constexpr int CW_BAR = 1024, CW_Q = 8192;
static_assert(WS_W + 4 * WL_STRIDE <= WS_END, "weights fit");

enum { PH_PROJ = 0, PH_PREP = 1, PH_ATT = 2, PH_GN = 3, PH_WOUT = 4, PH_NORM2 = 5, PH_GU = 6, PH_DOWN = 7, PH_NORM3 = 8, NPH = 9 };
struct MArgs { const float* in[20]; float* out; unsigned char* ws; int lay_lo, lay_hi, ph_lo, ph_hi; int do_pro, use_bar, att_mask, pad; };

struct Frame { LAS unsigned char* lds; int tid, lane, wave, gw, NGW; };
typedef const __attribute__((address_space(4))) unsigned char* kargp_t;
__device__ __forceinline__ kargp_t kargp() { kargp_t p = (kargp_t)__builtin_amdgcn_kernarg_segment_ptr(); asm volatile("" : "+s"(p)); return p; }
#define KIN(i) (*(const float* const __attribute__((address_space(4)))*)(kargp() + 8 * (i)))
#define KOUT (*(float* const __attribute__((address_space(4)))*)(kargp() + 160))
#define KWS (*(unsigned char* const __attribute__((address_space(4)))*)(kargp() + 168))
#define KINT(k) (*(const int __attribute__((address_space(4)))*)(kargp() + 176 + 4 * (k)))
static_assert(sizeof(MArgs) == 208, "MArgs layout");

__device__ __forceinline__ int maprow(int code, int n) {
    switch (code) {
        case 1: return n < 1280 ? n : n < 1284 ? n + 1280 : n < 2564 ? n - 4 : n;
        case 2: return (n >> 7) * 256 + (n & 127);
        case 3: return (n >> 7) * 256 + 128 + (n & 127);
        default: return n;
    }
}
struct TrDesc { const float* W; int K, N; bf16* WT; int code; const float* ks; int item; };
__device__ __forceinline__ void tr_load(const TrDesc& d, f32x4 (&v)[8], int lane) {
    const int nblk = (d.N + 31) / 32, kb = d.item / nblk, nb = d.item % nblk, k0 = 64 * kb, n0 = 32 * nb;
    const int n4 = (lane & 7) * 4, nn = n0 + n4;
#pragma unroll
    for (int i = 0; i < 8; ++i) { const int kk = 8 * i + (lane >> 3);
        v[i] = nn < d.N ? *(const GAS f32x4*)(d.W + (size_t)(k0 + kk) * d.N + nn) : (f32x4){0.f, 0.f, 0.f, 0.f};
        if (d.ks) v[i] = v[i] * d.ks[k0 + kk]; }
}
__device__ __forceinline__ void tr_finish(const TrDesc& d, const f32x4 (&v)[8], LAS float* scr, int lane) {
    const int nblk = (d.N + 31) / 32, kb = d.item / nblk, nb = d.item % nblk, k0 = 64 * kb, n0 = 32 * nb;
    const int n4 = (lane & 7) * 4;
#pragma unroll
    for (int i = 0; i < 8; ++i) { const int kk = 8 * i + (lane >> 3);
        scr[kk * 33 + n4] = v[i].x; scr[kk * 33 + n4 + 1] = v[i].y; scr[kk * 33 + n4 + 2] = v[i].z; scr[kk * 33 + n4 + 3] = v[i].w; }
    LDS_WAIT(); asm volatile("" ::: "memory");
    const int c = lane & 7;
#pragma unroll
    for (int j = 0; j < 4; ++j) { const int n = (lane >> 3) + 8 * j; const LAS float* s = scr + (8 * c) * 33 + n;
        v4u o; o.x = pk2(s[0 * 33], s[1 * 33]); o.y = pk2(s[2 * 33], s[3 * 33]); o.z = pk2(s[4 * 33], s[5 * 33]); o.w = pk2(s[6 * 33], s[7 * 33]);
        if (n0 + n < d.N) *(GAS v4u*)(d.WT + (size_t)maprow(d.code, n0 + n) * d.K + k0 + 8 * c) = o; }
    LDS_WAIT(); asm volatile("" ::: "memory");
}

__device__ __forceinline__ void pro_a(const Frame& F) {
    unsigned char* ws = KWS;
    {
        LAS float* ca = (LAS float*)F.lds;
        LAS float* red = (LAS float*)(F.lds + 32768);
        const float* c = KIN(1);
        for (int i = F.tid; i < 8192; i += NTHR) { const float v = c[i]; ca[i] = v / (1.f + __expf(-v)); }
        __syncthreads();
        float* mod = (float*)(ws + WS_MOD);
        for (int task = blockIdx.x; task < DEPTH * 96; task += gridDim.x) {
            const int l = task / 96, n0 = (task % 96) * 64;
            const int cg = F.lane & 15, kq = F.lane >> 4;
            const float* w = KIN(3) + (size_t)l * 1024 * 6144 + n0 + 4 * cg;
            f32x4 acc[8];
#pragma unroll
            for (int b = 0; b < 8; ++b) acc[b] = (f32x4){0.f, 0.f, 0.f, 0.f};
            const int kb = F.wave * 128 + kq;
#pragma unroll 8
            for (int i = 0; i < 32; ++i) { const int k = kb + 4 * i; const f32x4 wv = *(const GAS f32x4*)(w + (size_t)k * 6144);
#pragma unroll
                for (int b = 0; b < 8; ++b) acc[b] += wv * ca[b * 1024 + k]; }
#pragma unroll
            for (int b = 0; b < 8; ++b)
#pragma unroll
                for (int e = 0; e < 4; ++e) { float v = acc[b][e]; v += __shfl_xor(v, 16); v += __shfl_xor(v, 32); if (kq == 0) red[(F.wave * 8 + b) * 64 + 4 * cg + e] = v; }
            __syncthreads();
            { const int b = F.tid >> 6, n = F.tid & 63; float s = 0.f;
#pragma unroll
              for (int wv = 0; wv < 8; ++wv) s += red[(wv * 8 + b) * 64 + n];
              mod[(size_t)(l * 8 + b) * 6144 + n0 + n] = s + KIN(4)[l * 6144 + n0 + n]; }
            __syncthreads();
        }
    }
    {
        LAS float* scr = (LAS float*)(F.lds + F.wave * 16384);
        constexpr int I_IN = 16 * 81, I_OUT = 16 * 32, I_G = 16 * 88, I_D = 44 * 32, I_C1 = 32 * 4, I_C2 = 2 * 2;
        constexpr int PER_L = I_IN + I_OUT + 2 * I_G + I_D + 2 * I_C1 + 2 * I_C2;
        auto decode = [&](int it, TrDesc& d) {
            const int l = it / PER_L; int r = it % PER_L;
            unsigned char* wl = ws + WS_W + (size_t)l * WL_STRIDE;
            if (r < I_IN) { d = TrDesc{KIN(9) + (size_t)l * DM * NIN, DM, NIN, (bf16*)(wl + WL_IN), 1, nullptr, r}; return; } r -= I_IN;
            if (r < I_OUT) { d = TrDesc{KIN(16) + (size_t)l * DM * DM, DM, DM, (bf16*)(wl + WL_OUT), 0, KIN(15) + l * DM, r}; return; } r -= I_OUT;
            if (r < I_G) { d = TrDesc{KIN(17) + (size_t)l * DM * FFN, DM, FFN, (bf16*)(wl + WL_GU), 2, nullptr, r}; return; } r -= I_G;
            if (r < I_G) { d = TrDesc{KIN(18) + (size_t)l * DM * FFN, DM, FFN, (bf16*)(wl + WL_GU), 3, nullptr, r}; return; } r -= I_G;
            if (r < I_D) { d = TrDesc{KIN(19) + (size_t)l * FFN * DM, FFN, DM, (bf16*)(wl + WL_DOWN), 0, nullptr, r}; return; } r -= I_D;
            if (r < 2 * I_C1) { const int kv = r / I_C1; d = TrDesc{KIN(13) + (size_t)(l * 2 + kv) * 2048 * 128, 2048, 128, (bf16*)(wl + WL_CW1) + (size_t)kv * 128 * 2048, 0, nullptr, r % I_C1}; return; } r -= 2 * I_C1;
            { const int kv = r / I_C2; d = TrDesc{KIN(14) + (size_t)(l * 2 + kv) * 128 * 64, 128, 64, (bf16*)(wl + WL_CW2) + (size_t)kv * 64 * 128, 0, nullptr, r % I_C2}; }
        };
        for (int it = F.gw; it < DEPTH * PER_L; it += 4 * F.NGW) {
            const int tot = DEPTH * PER_L; const bool h1 = it + F.NGW < tot, h2 = it + 2 * F.NGW < tot, h3 = it + 3 * F.NGW < tot;
            TrDesc d0, d1, d2, d3; decode(it, d0); decode(h1 ? it + F.NGW : it, d1); decode(h2 ? it + 2 * F.NGW : it, d2); decode(h3 ? it + 3 * F.NGW : it, d3);
            f32x4 v0[8], v1[8], v2[8], v3[8];
            tr_load(d0, v0, F.lane); if (h1) tr_load(d1, v1, F.lane); if (h2) tr_load(d2, v2, F.lane); if (h3) tr_load(d3, v3, F.lane);
            tr_finish(d0, v0, scr, F.lane); if (h1) tr_finish(d1, v1, scr, F.lane); if (h2) tr_finish(d2, v2, scr, F.lane); if (h3) tr_finish(d3, v3, scr, F.lane);
        }
        for (int it = F.gw; it < DEPTH * 228; it += F.NGW) { const int l = it / 228, row = NIN + it % 228;
            GAS v4u* p = (GAS v4u*)(ws + WS_W + (size_t)l * WL_STRIDE + WL_IN + (size_t)row * DM * 2);
            p[F.lane] = (v4u){0u, 0u, 0u, 0u}; p[64 + F.lane] = (v4u){0u, 0u, 0u, 0u}; }
        { const int gt = blockIdx.x * NTHR + F.tid;
          if (gt < 12 * 1152) { const int hd = gt / 1152, dist = gt % 1152; ((float*)(ws + WS_B2))[gt] = KIN(2)[t5_bucket(dist) * 12 + hd] * LOG2E; } }
        { LAS float* red = (LAS float*)(F.lds + 12288);
          for (int task = blockIdx.x; task < DEPTH * 2 * 32; task += gridDim.x) {
              const int lk = task >> 5, i0 = (task & 31) * 64 + (F.tid >> 7) * 16, j = F.tid & 127;
              const float* pe = KIN(12) + (size_t)lk * 2048 + i0; const float* w1 = KIN(13) + ((size_t)lk * 2048 + i0) * 128 + j; float s = 0.f;
#pragma unroll
              for (int i = 0; i < 16; ++i) s += pe[i] * w1[(size_t)i * 128];
              __syncthreads(); red[F.tid] = s; __syncthreads();
              if (F.tid < 128) ((float*)(ws + WS_CB1P))[(size_t)task * 128 + F.tid] = (red[F.tid] + red[128 + F.tid]) + (red[256 + F.tid] + red[384 + F.tid]); } }
    }
}
__device__ __forceinline__ void cb1_finish(const Frame& F) {
    unsigned char* ws = KWS;
    const int gt = blockIdx.x * NTHR + F.tid;
    if (gt < DEPTH * 2 * 128) { const int j = gt & 127, lk = gt >> 7; const float* pp = (const float*)(ws + WS_CB1P) + (size_t)lk * 32 * 128 + j; float s = 0.f;
#pragma unroll
        for (int c = 0; c < 32; ++c) s += pp[c * 128];
        ((float*)(ws + WS_CB1))[gt] = s; }
}

__device__ __forceinline__ void norm_phase(const Frame& F, const float* xin, const bf16* y, const float* g_post, const float* mod_post, int gate_chunk,
                                           const bf16* y2, const float* g_post2, int gate_chunk2, float* xout,
                                           const float* g_pre, const float* mod_pre, int scale_chunk, int shift_chunk, bf16* h, const bf16* xin16 = nullptr, bf16* xout16 = nullptr) {
    const size_t x16 = (size_t)F.gw * 32768 + 16384;
    const int row0 = F.gw * 16, b = row0 / SEQ;
    const f32x4 z4 = {0.f, 0.f, 0.f, 0.f};
    f32x4 gg[4], gg2[4], gqs[4], sh[4];
#pragma unroll
    for (int j = 0; j < 4; ++j) { const int col = j * 256 + F.lane * 4;
        gg[j] = y ? *(const GAS f32x4*)(mod_post + (size_t)b * 6144 + gate_chunk * 1024 + col) * *(const GAS f32x4*)(g_post + col) : z4;
        gg2[j] = y2 ? *(const GAS f32x4*)(mod_post + (size_t)b * 6144 + gate_chunk2 * 1024 + col) * *(const GAS f32x4*)(g_post2 + col) : z4;
        gqs[j] = h ? *(const GAS f32x4*)(g_pre + col) * (*(const GAS f32x4*)(mod_pre + (size_t)b * 6144 + scale_chunk * 1024 + col) + 1.f) : z4;
        sh[j] = h ? *(const GAS f32x4*)(mod_pre + (size_t)b * 6144 + shift_chunk * 1024 + col) : z4; }
    struct Raw { v2u ya[4], yb[4], y2a[4], y2b[4], xa[4], xb[4]; };
    auto fetch = [&](int i, Raw& r) {
        const size_t oa = (size_t)(row0 + i) * DM + F.lane * 4, ob = oa + DM;
#pragma unroll
        for (int j = 0; j < 4; ++j) {
            if (y) { r.ya[j] = *(const GAS v2u*)(y + oa + j * 256); r.yb[j] = *(const GAS v2u*)(y + ob + j * 256); }
            if (y2) { r.y2a[j] = *(const GAS v2u*)(y2 + oa + j * 256); r.y2b[j] = *(const GAS v2u*)(y2 + ob + j * 256); }
            if (xin16) { r.xa[j] = *(const GAS v2u*)(xin16 + x16 + (size_t)i * DM + j * 256 + F.lane * 4); r.xb[j] = *(const GAS v2u*)(xin16 + x16 + (size_t)(i + 1) * DM + j * 256 + F.lane * 4); } }
    };
    auto unpk = [](const v2u& w) { return (f32x4){bf_lo(w.x), bf_hi(w.x), bf_lo(w.y), bf_hi(w.y)}; };
    auto process = [&](int i, const Raw& r) {
        const int rowa = row0 + i, rowb = rowa + 1;
        f32x4 va[4], vb[4], ua[4], ub[4];
#pragma unroll
        for (int j = 0; j < 4; ++j) {
            if (xin16) { va[j] = unpk(r.xa[j]); vb[j] = unpk(r.xb[j]); }
            else { va[j] = *(const GAS f32x4*)(xin + (size_t)rowa * DM + j * 256 + F.lane * 4); vb[j] = *(const GAS f32x4*)(xin + (size_t)rowb * DM + j * 256 + F.lane * 4); } }
        auto add_branch = [&](const v2u (&wa)[4], const v2u (&wb)[4], const f32x4 (&g)[4]) {
            float ssa = 0.f, ssb = 0.f;
#pragma unroll
            for (int j = 0; j < 4; ++j) { ua[j] = unpk(wa[j]); ssa += (ua[j].x * ua[j].x + ua[j].y * ua[j].y) + (ua[j].z * ua[j].z + ua[j].w * ua[j].w);
                ub[j] = unpk(wb[j]); ssb += (ub[j].x * ub[j].x + ub[j].y * ub[j].y) + (ub[j].z * ub[j].z + ub[j].w * ub[j].w); }
            const float ra = rsqrtf(wave_sum(ssa) * (1.f / DM) + RMS_EPS), rb = rsqrtf(wave_sum(ssb) * (1.f / DM) + RMS_EPS);
#pragma unroll
            for (int j = 0; j < 4; ++j) { va[j] += g[j] * (ua[j] * ra); vb[j] += g[j] * (ub[j] * rb); }
        };
        if (y) add_branch(r.ya, r.yb, gg);
        if (y2) add_branch(r.y2a, r.y2b, gg2);
        if (xout16) {
#pragma unroll
            for (int j = 0; j < 4; ++j) { v2u wa, wb; wa.x = pk2(va[j].x, va[j].y); wa.y = pk2(va[j].z, va[j].w); wb.x = pk2(vb[j].x, vb[j].y); wb.y = pk2(vb[j].z, vb[j].w);
                *(GAS v2u*)(xout16 + x16 + (size_t)i * DM + j * 256 + F.lane * 4) = wa; *(GAS v2u*)(xout16 + x16 + (size_t)(i + 1) * DM + j * 256 + F.lane * 4) = wb;
                va[j] = unpk(wa); vb[j] = unpk(wb); }
        } else if (xout) {
#pragma unroll
            for (int j = 0; j < 4; ++j) { *(GAS f32x4*)(xout + (size_t)rowa * DM + j * 256 + F.lane * 4) = va[j]; *(GAS f32x4*)(xout + (size_t)rowb * DM + j * 256 + F.lane * 4) = vb[j]; }
        }
        if (h) {
            float ssa = 0.f, ssb = 0.f;
#pragma unroll
            for (int j = 0; j < 4; ++j) { ssa += (va[j].x * va[j].x + va[j].y * va[j].y) + (va[j].z * va[j].z + va[j].w * va[j].w); ssb += (vb[j].x * vb[j].x + vb[j].y * vb[j].y) + (vb[j].z * vb[j].z + vb[j].w * vb[j].w); }
            const float ra = rsqrtf(wave_sum(ssa) * (1.f / DM) + RMS_EPS), rb = rsqrtf(wave_sum(ssb) * (1.f / DM) + RMS_EPS);
#pragma unroll
            for (int j = 0; j < 4; ++j) { const int col = j * 256 + F.lane * 4;
                const f32x4 oa = va[j] * ra * gqs[j] + sh[j]; v2u w; w.x = pk2(oa.x, oa.y); w.y = pk2(oa.z, oa.w); *(GAS v2u*)(h + (size_t)rowa * DM + col) = w;
                const f32x4 ob = vb[j] * rb * gqs[j] + sh[j]; v2u w2; w2.x = pk2(ob.x, ob.y); w2.y = pk2(ob.z, ob.w); *(GAS v2u*)(h + (size_t)rowb * DM + col) = w2; }
        }
    };
    Raw ra0, ra1; fetch(0, ra0);
    for (int i = 0; i < 16; i += 4) {
        fetch(i + 2, ra1); process(i, ra0);
        if (i + 4 < 16) fetch(i + 4, ra0);
        process(i + 2, ra1);
    }
}
__device__ __forceinline__ void groupnorm_phase(const Frame& F, bf16* O, const float* gn) {
    for (int row = F.gw; row < M; row += F.NGW) {
        f32x4 v[4]; float ss[4];
#pragma unroll
        for (int j = 0; j < 4; ++j) { const v2u w = *(const GAS v2u*)(O + (size_t)row * DM + j * 256 + F.lane * 4);
            v[j] = (f32x4){bf_lo(w.x), bf_hi(w.x), bf_lo(w.y), bf_hi(w.y)}; ss[j] = (v[j].x * v[j].x + v[j].y * v[j].y) + (v[j].z * v[j].z + v[j].w * v[j].w); }
        const float r0 = rsqrtf(wave_sum(ss[0]) * (1.f / 256.f) + RMS_EPS), r1 = rsqrtf(wave_sum(ss[1]) * (1.f / 256.f) + RMS_EPS), r2 = rsqrtf(wave_sum(ss[2] + ss[3]) * (1.f / 512.f) + RMS_EPS);
#pragma unroll
        for (int j = 0; j < 4; ++j) { const float r = j == 0 ? r0 : j == 1 ? r1 : r2; const int col = j * 256 + F.lane * 4;
            const f32x4 o = v[j] * r * *(const GAS f32x4*)(gn + col);
            v2u w; w.x = pk2(o.x, o.y); w.y = pk2(o.z, o.w);
            *(GAS v2u*)(O + (size_t)row * DM + col) = w; }
    }
}

namespace pg8 {
__device__ __forceinline__ f32x4 smul(const f32x4& a, float s) {
    float z = 0.f; asm("" : "+v"(z));
    return (f32x4){a[0] * s, __builtin_fmaf(a[1], s, z), a[2] * s, __builtin_fmaf(a[3], s, z)}; }
struct EpiProj {
    static constexpr bool PERM = true, AFTER_DRAIN = false;
    bf16_t* proj; float* logf; float* gates; const float* fbias;
    __device__ __forceinline__ void operator()(const f32x4 (&acc)[2][2][4][2], const Unit& u, int wr, int wc, int fr, int fq) const {
        const int row0 = u.pm * BM + wr * 64 + fr;
        {
            const float sc = (u.pn == 0 || u.pn == 2 || u.pn == 5 || u.pn == 6) ? QSCALE : 1.f;
            const int col0 = u.pn * BM + wc * 32 + 8 * fq;
#pragma unroll
            for (int ai = 0; ai < 2; ++ai)
#pragma unroll
                for (int m = 0; m < 4; ++m) { bf16_t* rowp = proj + (size_t)(row0 + ai * HALF + m * 16) * NPROJ + col0;
#pragma unroll
                    for (int bj = 0; bj < 2; ++bj) { const f32x4 v0 = smul(acc[ai][bj][m][0], sc), v1 = smul(acc[ai][bj][m][1], sc);
                        u32x4 w; w.x = cvt_pk_bf16(v0[0], v0[1]); w.y = cvt_pk_bf16(v0[2], v0[3]); w.z = cvt_pk_bf16(v1[0], v1[1]); w.w = cvt_pk_bf16(v1[2], v1[3]);
                        *(u32x4*)(rowp + bj * HALF) = w; } }
        }
    }
};
struct EpiY {
    static constexpr bool PERM = true, AFTER_DRAIN = false;
    bf16_t* out; int ldc;
    __device__ __forceinline__ void operator()(const f32x4 (&acc)[2][2][4][2], const Unit& u, int wr, int wc, int fr, int fq) const {
        const int row0 = u.pm * BM + wr * 64 + fr, col0 = u.pn * BM + wc * 32 + 8 * fq;
#pragma unroll
        for (int ai = 0; ai < 2; ++ai)
#pragma unroll
            for (int m = 0; m < 4; ++m) { bf16_t* rowp = out + (size_t)(row0 + ai * HALF + m * 16) * ldc + col0;
#pragma unroll
                for (int bj = 0; bj < 2; ++bj) { const f32x4 v0 = acc[ai][bj][m][0], v1 = acc[ai][bj][m][1];
                    u32x4 w; w.x = cvt_pk_bf16(v0[0], v0[1]); w.y = cvt_pk_bf16(v0[2], v0[3]); w.z = cvt_pk_bf16(v1[0], v1[1]); w.w = cvt_pk_bf16(v1[2], v1[3]);
                    *(u32x4*)(rowp + bj * HALF) = w; } }
    }
};
struct GnHook { static constexpr bool ACTIVE = true; static constexpr int T1 = 4, T2 = 8;
    const PG8_LAS f32x4* rf;
    __device__ __forceinline__ void apply(f32x4 (&acc)[2][2][4][2], int t, int ui, int wr, int fr) const {
#pragma unroll
        for (int ai = 0; ai < 2; ++ai)
#pragma unroll
            for (int m = 0; m < 4; ++m) { const f32x4 f = rf[(ui & 1) * 256 + ai * HALF + wr * 64 + m * 16 + fr]; const float sc = (t == T1) ? f[0] : f[1];
#pragma unroll
                for (int bj = 0; bj < 2; ++bj)
#pragma unroll
                    for (int n = 0; n < 2; ++n) acc[ai][bj][m][n] = smul(acc[ai][bj][m][n], sc); }
    }
};
struct EpiYGn {
    static constexpr bool PERM = true, AFTER_DRAIN = false;
    bf16_t* out; int ldc; const PG8_LAS f32x4* rf; int pm0;
    __device__ __forceinline__ void operator()(const f32x4 (&acc)[2][2][4][2], const Unit& u, int wr, int wc, int fr, int fq) const {
        const int row0 = u.pm * BM + wr * 64 + fr, col0 = u.pn * BM + wc * 32 + 8 * fq; const int slot = (u.pm == pm0) ? 0 : 256;
#pragma unroll
        for (int ai = 0; ai < 2; ++ai)
#pragma unroll
            for (int m = 0; m < 4; ++m) { bf16_t* rowp = out + (size_t)(row0 + ai * HALF + m * 16) * ldc + col0; const float sc = rf[slot + ai * HALF + wr * 64 + m * 16 + fr][2];
#pragma unroll
                for (int bj = 0; bj < 2; ++bj) { const f32x4 v0 = smul(acc[ai][bj][m][0], sc), v1 = smul(acc[ai][bj][m][1], sc);
                    u32x4 w; w.x = cvt_pk_bf16(v0[0], v0[1]); w.y = cvt_pk_bf16(v0[2], v0[3]); w.z = cvt_pk_bf16(v1[0], v1[1]); w.w = cvt_pk_bf16(v1[2], v1[3]);
                    *(u32x4*)(rowp + bj * HALF) = w; } }
    }
};
struct EpiSwiglu {
    static constexpr bool PERM = true, AFTER_DRAIN = false;
    bf16_t* out;
    __device__ __forceinline__ void operator()(const f32x4 (&acc)[2][2][4][2], const Unit& u, int wr, int wc, int fr, int fq) const {
        const int row0 = u.pm * BM + wr * 64 + fr, col0 = u.pn * HALF + wc * 32 + 8 * fq;
#pragma unroll
        for (int ai = 0; ai < 2; ++ai)
#pragma unroll
            for (int m = 0; m < 4; ++m) { float o[8];
#pragma unroll
                for (int n = 0; n < 2; ++n)
#pragma unroll
                    for (int e = 0; e < 4; ++e) { const float g = acc[ai][0][m][n][e], up = acc[ai][1][m][n][e]; o[4 * n + e] = g * __builtin_amdgcn_rcpf(1.f + __expf(-g)) * up; }
                u32x4 w; w.x = cvt_pk_bf16(o[0], o[1]); w.y = cvt_pk_bf16(o[2], o[3]); w.z = cvt_pk_bf16(o[4], o[5]); w.w = cvt_pk_bf16(o[6], o[7]);
                *(u32x4*)(out + (size_t)(row0 + ai * HALF + m * 16) * FFN + col0) = w; }
    }
};
}
namespace att {
typedef short bf16x8 __attribute__((ext_vector_type(8)));
typedef short s16x4 __attribute__((ext_vector_type(4)));
typedef short v4i16_t __attribute__((ext_vector_type(4)));
typedef float f32x16 __attribute__((ext_vector_type(16)));
typedef float f32x2_t __attribute__((ext_vector_type(2)));
typedef __bf16 bf16x2_t __attribute__((ext_vector_type(2)));
typedef LAS const char* lcp;
constexpr int L_K = 0, L_V = 16384, L_AUX = 32768;
constexpr float NEG_INF = -__builtin_inff();
constexpr float SM_THR = 8.f;
struct St { float m, l; f32x16 o0, o1; };

__device__ __forceinline__ unsigned cvtpk(float lo, float hi) { f32x2_t v = {lo, hi}; bf16x2_t b = __builtin_convertvector(v, bf16x2_t); return __builtin_bit_cast(unsigned, b); }
__device__ __forceinline__ float ex2(float x) { return __builtin_amdgcn_exp2f(x); }
__device__ __forceinline__ float xhalf_max(float m) { auto rr = __builtin_amdgcn_permlane32_swap(__float_as_uint(m), __float_as_uint(m), false, false); return fmaxf(__uint_as_float(rr[0]), __uint_as_float(rr[1])); }
__device__ __forceinline__ float xhalf_sum(float m) { auto rr = __builtin_amdgcn_permlane32_swap(__float_as_uint(m), __float_as_uint(m), false, false); return __uint_as_float(rr[0]) + __uint_as_float(rr[1]); }
#define ATT_WAIT_BAR(N) asm volatile("s_waitcnt vmcnt(" #N ") lgkmcnt(0)\n\ts_barrier" ::: "memory")
#define ATT_BAR() asm volatile("s_waitcnt lgkmcnt(0)\n\ts_barrier" ::: "memory")

__device__ __forceinline__ void glds16(const void* gsrc, unsigned lds_dst) { unsigned keep;
    asm volatile("s_mov_b32 %0, m0\n\ts_mov_b32 m0, %2\n\ts_nop 0\n\tglobal_load_lds_dwordx4 %1, off\n\ts_mov_b32 m0, %0" : "=&s"(keep) : "v"(gsrc), "s"(lds_dst) : "memory"); }
__device__ __forceinline__ void dma_k(const bf16* Krow0, int pitch, LAS unsigned char* kbuf, int wid, int lane) {
    const bf16* src = Krow0 + (size_t)lane * pitch + 8 * wid;
    glds16(src, (unsigned)__builtin_amdgcn_readfirstlane((int)(unsigned)(uintptr_t)(kbuf + wid * 1024)));
}
__device__ __forceinline__ void dma_v(const bf16* Vrow0, int pitch, LAS unsigned char* vbuf, int wid, int lane) {
    const bf16* src = Vrow0 + (size_t)(16 * (wid & 3) + (lane >> 2)) * pitch + 32 * (wid >> 2) + 8 * (lane & 3);
    glds16(src, (unsigned)__builtin_amdgcn_readfirstlane((int)(unsigned)(uintptr_t)(vbuf + wid * 1024)));
}
__device__ __forceinline__ s16x4 vtr(lcp p) { return __builtin_bit_cast(s16x4, __builtin_amdgcn_ds_read_tr16_b64_v4i16((LAS v4i16_t*)p)); }


struct Pf { bf16x8 f[4]; };
__device__ __forceinline__ void load_kf(bf16x8 (&kf)[8], lcp kb, int r32, int hi) {
    lcp k0 = kb + hi * 1024 + r32 * 16;
#pragma unroll
    for (int d0 = 0; d0 < 4; ++d0) { kf[2 * d0] = *(const LAS bf16x8*)(k0 + d0 * 2048); kf[2 * d0 + 1] = *(const LAS bf16x8*)(k0 + d0 * 2048 + 512); }
}
__device__ __forceinline__ void load_vf(bf16x8 (&vf)[8], lcp vb, int lane, int hi) {
    lcp vp = vb + ((lane >> 4) & 1) * 32 + (lane & 3) * 8 + (4 * hi + ((lane & 15) >> 2)) * 64;
#pragma unroll
    for (int k = 0; k < 4; ++k) {
        const s16x4 a0 = vtr(vp + k * 1024), a1 = vtr(vp + k * 1024 + 512), b0 = vtr(vp + 4096 + k * 1024), b1 = vtr(vp + 4096 + k * 1024 + 512);
        vf[2 * k] = (bf16x8){a0[0], a0[1], a0[2], a0[3], a1[0], a1[1], a1[2], a1[3]}; vf[2 * k + 1] = (bf16x8){b0[0], b0[1], b0[2], b0[3], b1[0], b1[1], b1[2], b1[3]};
    }
}
__device__ __forceinline__ void qk_mfma(f32x16& p0, f32x16& p1, const bf16x8 (&kf)[8], const bf16x8 (&qf)[4]) {
#pragma unroll
    for (int d0 = 0; d0 < 4; ++d0) { p0 = __builtin_amdgcn_mfma_f32_32x32x16_bf16(kf[2 * d0], qf[d0], p0, 0, 0, 0); p1 = __builtin_amdgcn_mfma_f32_32x32x16_bf16(kf[2 * d0 + 1], qf[d0], p1, 0, 0, 0); }
}
__device__ __forceinline__ void pv_mfma(St& st, const bf16x8 (&vf)[8], const Pf& pf) {
#pragma unroll
    for (int k = 0; k < 4; ++k) { st.o0 = __builtin_amdgcn_mfma_f32_32x32x16_bf16(vf[2 * k], pf.f[k], st.o0, 0, 0, 0); st.o1 = __builtin_amdgcn_mfma_f32_32x32x16_bf16(vf[2 * k + 1], pf.f[k], st.o1, 0, 0, 0); }
}
__device__ __forceinline__ void pack_p(Pf& pf, const f32x16& p0, const f32x16& p1) {
    unsigned w[16];
#pragma unroll
    for (int i = 0; i < 8; ++i) { w[i] = cvtpk(p0[2 * i], p0[2 * i + 1]); w[8 + i] = cvtpk(p1[2 * i], p1[2 * i + 1]); }
#pragma unroll
    for (int k = 0; k < 4; ++k) { v4u t = {w[4 * k], w[4 * k + 1], w[4 * k + 2], w[4 * k + 3]}; pf.f[k] = __builtin_bit_cast(bf16x8, t); }
}
__device__ __forceinline__ void softmax(St& st, f32x16& p0, f32x16& p1, Pf& pf, bool live = true, float cadd = 0.f) {
    float mxa = fmaxf(p0[0], p1[0]), mxb = fmaxf(p0[1], p1[1]);
#pragma unroll
    for (int r = 2; r < 16; r += 2) { mxa = fmaxf(fmaxf(mxa, p0[r]), p1[r]); mxb = fmaxf(fmaxf(mxb, p0[r + 1]), p1[r + 1]); }
    float mx = xhalf_max(fmaxf(mxa, mxb)) + cadd;
    if (!live) mx = NEG_INF;
    const float mn = fmaxf(st.m, mx);
    if (__any(mn > st.m)) { const float f = ex2(st.m - mn); st.l *= f;
#pragma unroll
        for (int r = 0; r < 16; ++r) { st.o0[r] *= f; st.o1[r] *= f; }
        st.m = mn; }
    const float ms = live ? mn - cadd : -NEG_INF;
    float s = 0.f;
#pragma unroll
    for (int r = 0; r < 16; ++r) { p0[r] = ex2(p0[r] - ms); p1[r] = ex2(p1[r] - ms); s += p0[r] + p1[r]; }
    st.l += s;
    pack_p(pf, p0, p1);
}
__device__ __forceinline__ void st_init(St& st, float m0, float l0) { st.m = m0; st.l = l0;
#pragma unroll
    for (int r = 0; r < 16; ++r) { st.o0[r] = 0.f; st.o1[r] = 0.f; } }
__device__ __forceinline__ void store_o(bf16* obase, const f32x16& o0, const f32x16& o1, float sc, int lane, float* ssp, LAS unsigned char* stg) {
    const int r32 = lane & 31, hi = lane >> 5;
    float ss = 0.f;
#pragma unroll
    for (int a = 0; a < 4; ++a) {
        float v[8];
#pragma unroll
        for (int e = 0; e < 4; ++e) { v[e] = o0[4 * a + e] * sc; v[4 + e] = o1[4 * a + e] * sc; }
#pragma unroll
        for (int e = 0; e < 8; ++e) ss += v[e] * v[e];
        v2u w0, w1; w0.x = cvtpk(v[0], v[1]); w0.y = cvtpk(v[2], v[3]); w1.x = cvtpk(v[4], v[5]); w1.y = cvtpk(v[6], v[7]);
        *(LAS v2u*)(stg + r32 * 144 + (8 * a + 4 * hi) * 2) = w0; *(LAS v2u*)(stg + r32 * 144 + 64 + (8 * a + 4 * hi) * 2) = w1; }
    ss = xhalf_sum(ss);
    if (hi == 0) *ssp = ss;
    asm volatile("s_waitcnt lgkmcnt(0)" ::: "memory");
#pragma unroll
    for (int i = 0; i < 4; ++i) { const int row = 8 * i + (lane >> 3), ch = lane & 7; const v4u v = *(const LAS v4u*)(stg + row * 144 + ch * 16); *(GAS v4u*)(obase + (size_t)row * DM + ch * 8) = v; }
}
__device__ __forceinline__ int unit_fetch_issue(unsigned* ctr, int wv) {
    int v = 0;
    if (wv == 0 && lane_id_fresh() == 0) v = (int)__hip_atomic_fetch_add(ctr, 1u, __ATOMIC_RELAXED, __HIP_MEMORY_SCOPE_AGENT);
    return v;
}
__device__ __forceinline__ int unit_fetch_commit(int v, volatile LAS int* slot, int wv) {
    if (wv == 0 && lane_id_fresh() == 0) *slot = v;
    __syncthreads();
    const int r = *slot;
    __syncthreads();
    return r;
}
__device__ __forceinline__ int next_unit(unsigned* ctr, volatile LAS int* slot, int wv) {
    if (wv == 0 && lane_id_fresh() == 0) *slot = (int)__hip_atomic_fetch_add(ctr, 1u, __ATOMIC_RELAXED, __HIP_MEMORY_SCOPE_AGENT);
    __syncthreads();
    const int v = *slot;
    __syncthreads();
    return v;
}

template <int N> struct TabVals { float v[(N + NTHR - 1) / NTHR]; };
template <int N> __device__ __forceinline__ void tab_load(TabVals<N>& tv, int dmax, const float* b2, int col, int tid) {
#pragma unroll
    for (int it = 0; it < (N + NTHR - 1) / NTHR; ++it) { const int dist = dmax - (tid + it * NTHR); const int dc = dist < 0 ? 0 : dist > 1151 ? 1151 : dist; tv.v[it] = b2[col * 1152 + dc]; }
}
template <int N> __device__ __forceinline__ void tab_store(const TabVals<N>& tv, LAS float* T, int dmax, int lo, int hi, int tid) {
#pragma unroll
    for (int it = 0; it < (N + NTHR - 1) / NTHR; ++it) { const int i = tid + it * NTHR, dist = dmax - i; if (i < N) T[i] = (dist >= lo && dist < hi) ? tv.v[it] : NEG_INF; }
}
__device__ __forceinline__ void init_tab(f32x16& p0, f32x16& p1, const LAS float* tl) {
    asm volatile("" : "+v"(tl));
#pragma unroll
    for (int r = 0; r < 16; ++r) { p0[r] = tl[(r & 3) + 8 * (r >> 2)]; p1[r] = tl[32 + (r & 3) + 8 * (r >> 2)]; }
}
#define ATT_SCHED() __builtin_amdgcn_sched_barrier(0)
#ifndef HOIST_FOX
#define HOIST_FOX 1
#define HOIST_SWA 1
#define HOIST_CMP 0
#define HOIST_SLC 1
#endif
#ifndef STAG_FROM
#define STAG_FROM 4
#endif
#ifndef DMA_LATE
#define DMA_LATE 1
#endif
#ifndef SLC_ZC
#define SLC_ZC 1
#endif
#ifndef SLC_WINDOW
#define SLC_WINDOW 1
#endif
#ifndef STAG_FOX
#define STAG_FOX 1
#define STAG_SWA 1
#define STAG_CMP 1
#define STAG_SLC 1
#define STAG_WIN 1
#endif
__device__ __forceinline__ void load_k2(bf16x8 (&k2)[2], lcp kb, int d0, int r32, int hi) { lcp k0 = kb + hi * 1024 + r32 * 16 + d0 * 2048; k2[0] = *(const LAS bf16x8*)k0; k2[1] = *(const LAS bf16x8*)(k0 + 512); }
__device__ __forceinline__ void load_v2(bf16x8 (&v2)[2], lcp vb, int k, int lane, int hi) {
    lcp vp = vb + ((lane >> 4) & 1) * 32 + (lane & 3) * 8 + (4 * hi + ((lane & 15) >> 2)) * 64 + k * 1024;
    const s16x4 a0 = vtr(vp), a1 = vtr(vp + 512), b0 = vtr(vp + 4096), b1 = vtr(vp + 4096 + 512);
    v2[0] = (bf16x8){a0[0], a0[1], a0[2], a0[3], a1[0], a1[1], a1[2], a1[3]}; v2[1] = (bf16x8){b0[0], b0[1], b0[2], b0[3], b1[0], b1[1], b1[2], b1[3]};
}
template <int BASE, class Hook> __device__ __forceinline__ bf16x8 exp_chunk(const f32x16& c, float ms, float& s, Hook&& hook, int t, int k) {
    float e[8];
#pragma unroll
    for (int j = 0; j < 8; ++j) { e[j] = c[BASE + j] - ms; }
    float t0, t1, t2, t3;
    asm("v_exp_f32 %0, %0\n\tv_exp_f32 %1, %1\n\tv_exp_f32 %2, %2\n\tv_exp_f32 %3, %3\n\tv_exp_f32 %4, %4\n\tv_exp_f32 %5, %5\n\tv_exp_f32 %6, %6\n\tv_exp_f32 %7, %7\n\t"
        "v_add_f32 %8, %0, %1\n\tv_add_f32 %9, %2, %3\n\tv_add_f32 %10, %4, %5\n\tv_add_f32 %11, %6, %7\n\t"
        "v_add_f32 %8, %8, %9\n\tv_add_f32 %10, %10, %11\n\tv_add_f32 %8, %8, %10\n\tv_add_f32 %12, %12, %8"
        : "+v"(e[0]), "+v"(e[1]), "+v"(e[2]), "+v"(e[3]), "+v"(e[4]), "+v"(e[5]), "+v"(e[6]), "+v"(e[7]), "=&v"(t0), "=&v"(t1), "=&v"(t2), "=&v"(t3), "+v"(s));
    hook(t, k, e, ms);
    v4u w = {cvtpk(e[0], e[1]), cvtpk(e[2], e[3]), cvtpk(e[4], e[5]), cvtpk(e[6], e[7])};
    return __builtin_bit_cast(bf16x8, w);
}
__device__ __forceinline__ float softmax_head(St& st, const f32x16& p0, const f32x16& p1, bool live, float cadd, float& tmax) {
    float mxa = fmaxf(p0[0], p1[0]), mxb = fmaxf(p0[1], p1[1]);
#pragma unroll
    for (int r = 2; r < 16; r += 2) { mxa = fmaxf(fmaxf(mxa, p0[r]), p1[r]); mxb = fmaxf(fmaxf(mxb, p0[r + 1]), p1[r + 1]); }
    float mx = xhalf_max(fmaxf(mxa, mxb)) + cadd;
    if (!live) mx = NEG_INF;
    tmax = mx;
    if (__any(mx > st.m + SM_THR)) { const float mn = fmaxf(st.m, mx); const float f = ex2(st.m - mn); st.l *= f;
#pragma unroll
        for (int r = 0; r < 16; ++r) { st.o0[r] *= f; st.o1[r] *= f; }
        st.m = mn; }
    return live ? st.m - cadd : -NEG_INF;
}
#define MFMA32 __builtin_amdgcn_mfma_f32_32x32x16_bf16
template <int REL, class F, class... A> __device__ __forceinline__ decltype(auto) call_r(F& f, int t, A&... a) {
    if constexpr (std::is_invocable_v<F&, std::integral_constant<int, REL>, int, A&...>) return f(std::integral_constant<int, REL>{}, t, a...);
    else return f(t, a...);
}
template <int REL, class Init> __device__ __forceinline__ bool init_z(Init& init, int t, f32x16& p0, f32x16& p1) {
    if constexpr (std::is_same_v<decltype(call_r<REL>(init, t, p0, p1)), bool>) return call_r<REL>(init, t, p0, p1); else { call_r<REL>(init, t, p0, p1); return false; }
}
template <int REL, class Init> __device__ __forceinline__ void init_full(Init& init, int t, f32x16& p0, f32x16& p1) {
    if (init_z<REL>(init, t, p0, p1)) {
#pragma unroll
        for (int r = 0; r < 16; ++r) { p0[r] = 0.f; p1[r] = 0.f; } }
}
#define ZERO16 ((f32x16){0.f, 0.f, 0.f, 0.f, 0.f, 0.f, 0.f, 0.f, 0.f, 0.f, 0.f, 0.f, 0.f, 0.f, 0.f, 0.f})
#define QK0(KF) do { if (zi) { n0 = MFMA32(KF[0], qf[0], ZERO16, 0, 0, 0); n1 = MFMA32(KF[1], qf[0], ZERO16, 0, 0, 0); } else { n0 = MFMA32(KF[0], qf[0], n0, 0, 0, 0); n1 = MFMA32(KF[1], qf[0], n1, 0, 0, 0); } } while (0)
template <bool FAST = false, bool HOOKED = false, int STAG = 0, int PRE = 0, class Src, class Act, class Init, class Post, class Valu, class Pv, class Sargs, class Hook>
__device__ __forceinline__ void tile_loop_x(LAS unsigned char* lds, int nt, int pitch, const bf16x8 (&qf)[4], St* fst, Src src, Act act, Init init, Post post, Valu valu, Pv pv, Sargs sargs, Hook hook, int wid, int lane) {
    if (nt <= 0) return;
    const int r32 = lane & 31, hi = lane >> 5;
    if constexpr (PRE == 0) { const bf16 *kp, *vp; call_r<0>(src, 0, kp, vp); dma_k(kp, pitch, lds + L_K, wid, lane); dma_v(vp, pitch, lds + L_V, wid, lane); }
    if constexpr (PRE != 1) { if (nt > 1) { const bf16 *kp, *vp; call_r<1>(src, 1, kp, vp); dma_k(kp, pitch, lds + L_K + 8192, wid, lane); } }
    if (PRE == 2 && nt > 1) ATT_WAIT_BAR(1);
    else ATT_WAIT_BAR(0);
    f32x16 a0, a1, b0, b1;
    if (FAST || act(0)) { bf16x8 kf[8]; load_kf(kf, (lcp)(lds + L_K), r32, hi); init_full<0>(init, 0, a0, a1); qk_mfma(a0, a1, kf, qf); post(0, a0, a1); }
    auto step = [&](int t, f32x16& c0, f32x16& c1, f32x16& n0, f32x16& n1) {
        const int cur = (t & 1) * 8192, nxt = 8192 - cur;
        ATT_WAIT_BAR(0);
        auto issue_dma = [&]() {
            if (t + 2 < nt) { const bf16 *kp, *vp; call_r<2>(src, t + 2, kp, vp); dma_k(kp, pitch, lds + L_K + cur, wid, lane); }
            { const bf16 *kp, *vp; call_r<1>(src, t + 1, kp, vp); dma_v(vp, pitch, lds + L_V + nxt, wid, lane); } };
        if (!FAST || !DMA_LATE) issue_dma();
        const bool an = FAST || act(t + 1), ac = FAST || act(t);
        if constexpr (FAST) { {
            St& st = *fst; bool live; float cadd; call_r<0>(sargs, t, live, cadd);
            lcp kn = (lcp)(lds + L_K + nxt); lcp vc = (lcp)(lds + L_V + cur);
            bf16x8 ka[2], va[2], kb[2], vb[2];
            const bool zi = init_z<1>(init, t + 1, n0, n1); load_k2(ka, kn, 0, r32, hi);
            float tmax; const float ms = softmax_head(st, c0, c1, live, cadd, tmax);
            const bool alive = HOOKED || !__all(tmax < st.m - 150.f);
            if (alive) load_v2(va, vc, 0, lane, hi);
            float sacc = 0.f;
            if (DMA_LATE) issue_dma();
            ATT_SCHED();
            if constexpr (STAG == 1) {
                bf16x8 pa = {0, 0, 0, 0, 0, 0, 0, 0}, pb = {0, 0, 0, 0, 0, 0, 0, 0};
                { load_k2(kb, kn, 1, r32, hi); if (alive) { load_v2(vb, vc, 1, lane, hi); pa = exp_chunk<0>(c0, ms, sacc, hook, t, 0); } }
                ATT_SCHED();
                { if (alive) pb = exp_chunk<8>(c0, ms, sacc, hook, t, 1);
                  QK0(ka); if (alive) { st.o0 = MFMA32(va[0], pa, st.o0, 0, 0, 0); st.o1 = MFMA32(va[1], pa, st.o1, 0, 0, 0); } }
                ATT_SCHED();
                { load_k2(ka, kn, 2, r32, hi); if (alive) { load_v2(va, vc, 2, lane, hi); pa = exp_chunk<0>(c1, ms, sacc, hook, t, 2); }
                  n0 = MFMA32(kb[0], qf[1], n0, 0, 0, 0); n1 = MFMA32(kb[1], qf[1], n1, 0, 0, 0); if (alive) { st.o0 = MFMA32(vb[0], pb, st.o0, 0, 0, 0); st.o1 = MFMA32(vb[1], pb, st.o1, 0, 0, 0); } }
                ATT_SCHED();
                { load_k2(kb, kn, 3, r32, hi); if (alive) { load_v2(vb, vc, 3, lane, hi); pb = exp_chunk<8>(c1, ms, sacc, hook, t, 3); }
                  n0 = MFMA32(ka[0], qf[2], n0, 0, 0, 0); n1 = MFMA32(ka[1], qf[2], n1, 0, 0, 0); if (alive) { st.o0 = MFMA32(va[0], pa, st.o0, 0, 0, 0); st.o1 = MFMA32(va[1], pa, st.o1, 0, 0, 0); } }
                ATT_SCHED();
                { n0 = MFMA32(kb[0], qf[3], n0, 0, 0, 0); n1 = MFMA32(kb[1], qf[3], n1, 0, 0, 0); if (alive) { st.o0 = MFMA32(vb[0], pb, st.o0, 0, 0, 0); st.o1 = MFMA32(vb[1], pb, st.o1, 0, 0, 0); } }
                ATT_SCHED();
                st.l += sacc; post(t + 1, n0, n1);
                return;
            }
            { load_k2(kb, kn, 1, r32, hi); bf16x8 pk = {0, 0, 0, 0, 0, 0, 0, 0}; if (alive) { load_v2(vb, vc, 1, lane, hi); pk = exp_chunk<0>(c0, ms, sacc, hook, t, 0); }
              QK0(ka); if (alive) { st.o0 = MFMA32(va[0], pk, st.o0, 0, 0, 0); st.o1 = MFMA32(va[1], pk, st.o1, 0, 0, 0); } }
            ATT_SCHED();
            { load_k2(ka, kn, 2, r32, hi); bf16x8 pk = {0, 0, 0, 0, 0, 0, 0, 0}; if (alive) { load_v2(va, vc, 2, lane, hi); pk = exp_chunk<8>(c0, ms, sacc, hook, t, 1); }
              n0 = MFMA32(kb[0], qf[1], n0, 0, 0, 0); n1 = MFMA32(kb[1], qf[1], n1, 0, 0, 0); if (alive) { st.o0 = MFMA32(vb[0], pk, st.o0, 0, 0, 0); st.o1 = MFMA32(vb[1], pk, st.o1, 0, 0, 0); } }
            ATT_SCHED();
            { load_k2(kb, kn, 3, r32, hi); bf16x8 pk = {0, 0, 0, 0, 0, 0, 0, 0}; if (alive) { load_v2(vb, vc, 3, lane, hi); pk = exp_chunk<0>(c1, ms, sacc, hook, t, 2); }
              n0 = MFMA32(ka[0], qf[2], n0, 0, 0, 0); n1 = MFMA32(ka[1], qf[2], n1, 0, 0, 0); if (alive) { st.o0 = MFMA32(va[0], pk, st.o0, 0, 0, 0); st.o1 = MFMA32(va[1], pk, st.o1, 0, 0, 0); } }
            ATT_SCHED();
            { bf16x8 pk = {0, 0, 0, 0, 0, 0, 0, 0}; if (alive) pk = exp_chunk<8>(c1, ms, sacc, hook, t, 3);
              n0 = MFMA32(kb[0], qf[3], n0, 0, 0, 0); n1 = MFMA32(kb[1], qf[3], n1, 0, 0, 0); if (alive) { st.o0 = MFMA32(vb[0], pk, st.o0, 0, 0, 0); st.o1 = MFMA32(vb[1], pk, st.o1, 0, 0, 0); } }
            ATT_SCHED();
            st.l += sacc; post(t + 1, n0, n1);
            return;
        } }
        bf16x8 kf[8], vf[8]; Pf pf;
        if (an) { load_kf(kf, (lcp)(lds + L_K + nxt), r32, hi); init_full<1>(init, t + 1, n0, n1); ATT_SCHED(); }
        if (ac) { valu(t, c0, c1, pf); ATT_SCHED(); load_vf(vf, (lcp)(lds + L_V + cur), lane, hi); ATT_SCHED(); }
        if (an) { qk_mfma(n0, n1, kf, qf); post(t + 1, n0, n1); }
        if (ac) pv(t, vf, pf);
    };
    auto last = [&](int t, f32x16& c0, f32x16& c1) { ATT_WAIT_BAR(0);
        if constexpr (FAST) {
            St& st = *fst; bool live; float cadd; call_r<0>(sargs, t, live, cadd); lcp vc = (lcp)(lds + L_V + (t & 1) * 8192);
            bf16x8 vf[8]; load_vf(vf, vc, lane, hi);
            float tmax; const float ms = softmax_head(st, c0, c1, live, cadd, tmax); float sacc = 0.f; Pf pf;
            pf.f[0] = exp_chunk<0>(c0, ms, sacc, hook, t, 0); pf.f[1] = exp_chunk<8>(c0, ms, sacc, hook, t, 1); pf.f[2] = exp_chunk<0>(c1, ms, sacc, hook, t, 2); pf.f[3] = exp_chunk<8>(c1, ms, sacc, hook, t, 3);
            st.l += sacc; pv_mfma(st, vf, pf);
        } else {
        if (act(t)) { bf16x8 vf[8]; Pf pf; load_vf(vf, (lcp)(lds + L_V + (t & 1) * 8192), lane, hi); valu(t, c0, c1, pf); pv(t, vf, pf); } } };
    int t = 0;
    for (; t + 2 < nt; t += 2) { step(t, a0, a1, b0, b1); step(t + 1, b0, b1, a0, a1); }
    if (t + 1 < nt) { step(t, a0, a1, b0, b1); last(t + 1, b0, b1); } else last(t, a0, a1);
    ATT_BAR();
}
__device__ __forceinline__ void prologue_dma(LAS unsigned char* lds, int nt, int pitch, const bf16* k0, const bf16* v0, const bf16* k1, int wid, int lane) {
    dma_k(k0, pitch, lds + L_K, wid, lane); dma_v(v0, pitch, lds + L_V, wid, lane);
    if (nt > 1) dma_k(k1, pitch, lds + L_K + 8192, wid, lane);
}
template <class Src, class Act, class Init, class Post, class Valu, class Pv>
__device__ __forceinline__ void tile_loop(LAS unsigned char* lds, int nt, int pitch, const bf16x8 (&qf)[4], Src src, Act act, Init init, Post post, Valu valu, Pv pv, int wid, int lane) {
    tile_loop_x<false, false, 0>(lds, nt, pitch, qf, (St*)nullptr, src, act, init, post, valu, pv, [](int, bool&, float&) {}, [](int, int, const float (&)[8], float) {}, wid, lane);
}
template <int STAG = 0, int PRE = 0, class Src, class Act, class Init, class Post, class Sargs>
__device__ __forceinline__ void tile_loop_std(LAS unsigned char* lds, int nt, int pitch, const bf16x8 (&qf)[4], St& st, Src src, Act act, Init init, Post post, Sargs sargs, int wid, int lane) {
    auto valu = [&](int t, f32x16& p0, f32x16& p1, Pf& pf) { bool live; float cadd; call_r<0>(sargs, t, live, cadd); softmax(st, p0, p1, pf, live, cadd); };
    auto pv = [&](int t, const bf16x8 (&vf)[8], const Pf& pf) { pv_mfma(st, vf, pf); };
    auto nohook = [](int, int, const float (&)[8], float) {};
    if (STAG && wid >= STAG_FROM) tile_loop_x<true, false, 1, PRE>(lds, nt, pitch, qf, &st, src, act, init, post, valu, pv, sargs, nohook, wid, lane);
    else tile_loop_x<true, false, 0, PRE>(lds, nt, pitch, qf, &st, src, act, init, post, valu, pv, sargs, nohook, wid, lane);
}
template <int STAG = 0, int PRE = 0, class Src, class Init, class Post, class Sargs, class Hook>
__device__ __forceinline__ void tile_loop_hooked(LAS unsigned char* lds, int nt, int pitch, const bf16x8 (&qf)[4], St& st, Src src, Init init, Post post, Sargs sargs, Hook hook, int wid, int lane) {
    auto act = [](int) { return true; }; auto valu = [&](int t, f32x16& p0, f32x16& p1, Pf& pf) {}; auto pv = [&](int t, const bf16x8 (&vf)[8], const Pf& pf) {};
    if (STAG && wid >= STAG_FROM) tile_loop_x<true, true, 1, PRE>(lds, nt, pitch, qf, &st, src, act, init, post, valu, pv, sargs, hook, wid, lane);
    else tile_loop_x<true, true, 0, PRE>(lds, nt, pitch, qf, &st, src, act, init, post, valu, pv, sargs, hook, wid, lane);
}
#define SARGS_STD [](int, bool& live, float& cadd) { live = true; cadd = 0.f; }
#define ACT_ALL [](int) { return true; }
#define POST_NONE [](int, f32x16&, f32x16&) {}

__device__ __forceinline__ void fox_unit(LAS unsigned char* lds, int wv, const bf16* proj, const float* cum, bf16* O, float* ssq, int b, int h, int qb) {
    int tid_l = wv * 64 + lane_id_fresh(); asm volatile("" : "+v"(tid_l));
    const int tid = tid_l, lane = tid & 63, r32 = lane & 31, hi = lane >> 5, wid = __builtin_amdgcn_readfirstlane(tid >> 6);
    const int t0 = qb * 256, tw0 = t0 + 32 * wid, tq = tw0 + r32;
    bf16x8 qf[4];
    { const bf16* qp = proj + (size_t)(b * SEQ + tq) * NPROJ + C_QB + h * 64 + 8 * hi;
#pragma unroll
      for (int d0 = 0; d0 < 4; ++d0) qf[d0] = *(const GAS bf16x8*)(qp + 16 * d0); }
    const bf16* Kb = proj + (size_t)(b * SEQ) * NPROJ + C_KB + h * 64; const bf16* Vb = proj + (size_t)(b * SEQ) * NPROJ + C_VB + h * 64;
    const int NT = 4 * (qb + 1);
    if (HOIST_FOX) prologue_dma(lds, NT, NPROJ, Kb + (size_t)(64 * (NT - 1)) * NPROJ, Vb + (size_t)(64 * (NT - 1)) * NPROJ, Kb + (size_t)(64 * (NT - 2)) * NPROJ, wid, lane);
    LAS float* cs = (LAS float*)(lds + L_AUX);
    { LAS float* wt = (LAS float*)(lds + L_AUX + 16384);
      const float* src = cum + (size_t)(b * 4 + h) * SEQ + tid * 8;
      f32x4 v0 = {0.f, 0.f, 0.f, 0.f}, v1 = v0;
      if (tid * 8 < t0 + 256) { v0 = *(const GAS f32x4*)src; v1 = *(const GAS f32x4*)(src + 4); }
      const float sm = ((v0.x + v0.y) + (v0.z + v0.w)) + ((v1.x + v1.y) + (v1.z + v1.w));
      float x = sm;
#pragma unroll
      for (int o = 1; o < 64; o <<= 1) { const float tt = __shfl_up(x, o); if (lane >= o) x += tt; }
      if (lane == 63) wt[wid] = x;
      ATT_BAR();
      float run = x - sm;
      for (int w = 0; w < wid; ++w) run += wt[w];
      f32x4 o0, o1; run += v0.x; o0.x = run; run += v0.y; o0.y = run; run += v0.z; o0.z = run; run += v0.w; o0.w = run;
      run += v1.x; o1.x = run; run += v1.y; o1.y = run; run += v1.z; o1.z = run; run += v1.w; o1.w = run;
      *(LAS f32x4*)(cs + tid * 8) = o0 * (-LOG2E); *(LAS f32x4*)(cs + tid * 8 + 4) = o1 * (-LOG2E); }
    St st; st_init(st, -1e30f, 0.f);
    tile_loop_std<STAG_FOX, HOIST_FOX>(lds, NT, NPROJ, qf, st,
        [&](int i, const bf16*& kp, const bf16*& vp) { const int s0 = 64 * (NT - 1 - i); kp = Kb + (size_t)s0 * NPROJ; vp = Vb + (size_t)s0 * NPROJ; },
        [&](int i) { return 64 * (NT - 1 - i) <= tw0 + 31; },
        [&](int i, f32x16& p0, f32x16& p1) { const int s0 = 64 * (NT - 1 - i);
#pragma unroll
            for (int a = 0; a < 4; ++a) { const f32x4 c0 = *(const LAS f32x4*)(cs + s0 + 8 * a + 4 * hi), c1 = *(const LAS f32x4*)(cs + s0 + 32 + 8 * a + 4 * hi);
#pragma unroll
                for (int e = 0; e < 4; ++e) { p0[4 * a + e] = c0[e]; p1[4 * a + e] = c1[e]; } } },
        [&](int i, f32x16& p0, f32x16& p1) { const int s0 = 64 * (NT - 1 - i);
            if (s0 + 63 > tw0) { asm volatile("" ::: "memory");
#pragma unroll
                for (int r = 0; r < 16; ++r) { const int kv = s0 + (r & 3) + 8 * (r >> 2) + 4 * hi; if (kv > tq) p0[r] = NEG_INF; if (kv + 32 > tq) p1[r] = NEG_INF; } } },
        SARGS_STD, wid, lane);
    const float inv = 1.f / xhalf_sum(st.l);
    store_o(O + (size_t)(b * SEQ + tw0) * DM + 256 + h * 64, st.o0, st.o1, inv, lane, ssq + (size_t)(b * SEQ + tq) * 16 + 4 + h, lds + wid * 4608);
}
__device__ __forceinline__ void fox_phase(LAS unsigned char* lds, int wv, const bf16* proj, const float* cum, bf16* O, float* ssq, unsigned* ctr) {
    volatile LAS int* slot = (volatile LAS int*)(lds + LDSCTL_OFF + 64);
    for (int idx = (int)blockIdx.x; idx < 512; idx = (int)gridDim.x + next_unit(ctr, slot, wv)) {
        fox_unit(lds, wv, proj, cum, O, ssq, (idx & 31) >> 2, idx & 3, 15 - (idx >> 5));
    }
}

__device__ __forceinline__ void swa_unit(LAS unsigned char* lds, int wv, const bf16* proj, const float* rel_bias, const float* sinks, bf16* O, float* ssq, int b, int hkv, int qblk) {
    int tid_l = wv * 64 + lane_id_fresh(); asm volatile("" : "+v"(tid_l));
    const int tid = tid_l, lane = tid & 63, r32 = lane & 31, hi = lane >> 5, wid = __builtin_amdgcn_readfirstlane(tid >> 6);
    const int hq = 2 * hkv + (wid >> 2), t0 = qblk * 128, tq = t0 + 32 * (wid & 3) + r32;
    bf16x8 qf[4];
    { const bf16* qp = proj + (size_t)(b * SEQ + tq) * NPROJ + C_QA + hq * 64 + 8 * hi;
#pragma unroll
      for (int d0 = 0; d0 < 4; ++d0) qf[d0] = *(const GAS bf16x8*)(qp + 16 * d0); }
    const int k0 = (t0 == 0) ? 2 : 0;
    const bf16* Kb = proj + (size_t)(b * SEQ) * NPROJ + C_KA + hkv * 64; const bf16* Vb = proj + (size_t)(b * SEQ) * NPROJ + C_VA + hkv * 64;
    if (HOIST_SWA) { const int s00 = t0 - 128 + 64 * k0; prologue_dma(lds, 4 - k0, NPROJ, Kb + (size_t)s00 * NPROJ, Vb + (size_t)s00 * NPROJ, Kb + (size_t)(s00 + 64) * NPROJ, wid, lane); }
    LAS float* T = (LAS float*)(lds + L_AUX);
    { TabVals<384> ta, tb; tab_load(ta, 255, rel_bias, 2 * hkv, tid); tab_load(tb, 255, rel_bias, 2 * hkv + 1, tid);
      ATT_SCHED();
      tab_store(ta, T, 255, 0, 128, tid); tab_store(tb, T + 384, 255, 0, 128, tid); }
    const LAS float* Tw = T + (wid >> 2) * 384;
    St st; st_init(st, sinks[hq] * LOG2E, hi == 0 ? 1.f : 0.f);
    tile_loop_std<STAG_SWA, HOIST_SWA>(lds, 4 - k0, NPROJ, qf, st,
        [&](int t, const bf16*& kp, const bf16*& vp) { const int s0 = t0 - 128 + 64 * (k0 + t); kp = Kb + (size_t)s0 * NPROJ; vp = Vb + (size_t)s0 * NPROJ; },
        ACT_ALL,
        [&](int t, f32x16& p0, f32x16& p1) { const int s0 = t0 - 128 + 64 * (k0 + t); init_tab(p0, p1, Tw + (255 - (tq - s0) + 4 * hi)); },
        POST_NONE,
        SARGS_STD, wid, lane);
    const float inv = 1.f / xhalf_sum(st.l);
    store_o(O + (size_t)(b * SEQ + t0 + 32 * (wid & 3)) * DM + hq * 64, st.o0, st.o1, inv, lane, ssq + (size_t)(b * SEQ + tq) * 16 + hq, lds + wid * 4608);
}
__device__ __forceinline__ void swa_phase(LAS unsigned char* lds, int wv, const bf16* proj, const float* rel_bias, const float* sinks, bf16* O, float* ssq, unsigned* ctr) {
    volatile LAS int* slot = (volatile LAS int*)(lds + LDSCTL_OFF + 64);
    for (int idx = (int)blockIdx.x; idx < 512; idx = (int)gridDim.x + next_unit(ctr, slot, wv)) {
        swa_unit(lds, wv, proj, rel_bias, sinks, O, ssq, idx >> 6, (idx >> 5) & 1, idx & 31);
    }
}

constexpr int L_TSLC = L_AUX, N_TSLC = 1216, L_TWIN = L_TSLC + 4 * N_TSLC * 4, N_TWIN = 704, L_IMPB = L_TWIN + 4 * N_TWIN * 4, IMP_LD = 65;
static_assert(L_IMPB + 4 * 64 * IMP_LD * 4 <= RING_BYTES, "NSA LDS map");
constexpr int L_SELM = LDSCTL_OFF + 256, L_TLIST = LDSCTL_OFF + 1024, L_MREF = LDSCTL_OFF + 2048, L_MFIN = L_MREF + 4096;
__device__ __forceinline__ void nsa_unit(LAS unsigned char* lds, int wv, const bf16* proj, const bf16* kcmp, const bf16* vcmp, const float* rel_bias, const float* gates, bf16* O, float* ssq, int b, int hkv, int qb) {
    int tid_l = wv * 64 + lane_id_fresh(); asm volatile("" : "+v"(tid_l));
    const int tid = tid_l, lane = tid & 63, r32 = lane & 31, hi = lane >> 5, wid = __builtin_amdgcn_readfirstlane(tid >> 6);
    const int g = wid >> 1, h8 = 4 * hkv + g, t0 = qb * 64, qrow = 32 * (wid & 1) + r32, tw0 = t0 + 32 * (wid & 1), tq = t0 + qrow;
    bf16x8 qf[4];
    { const bf16* qp = proj + (size_t)(b * SEQ + tq) * NPROJ + C_QC + h8 * 64 + 8 * hi;
#pragma unroll
      for (int d0 = 0; d0 < 4; ++d0) qf[d0] = *(const GAS bf16x8*)(qp + 16 * d0); }
    const float* gp = gates + (size_t)(b * SEQ + tq) * 24 + h8 * 3;
    const float g_cmp = gp[0], g_slc = gp[1], g_win = gp[2];
    const bf16* Kc = kcmp + (size_t)((b * 2 + hkv) * 256) * 64; const bf16* Vc = vcmp + (size_t)((b * 2 + hkv) * 256) * 64;
    const int NTC = (4 * qb + 2) / 64 + 1;
    if (HOIST_CMP) prologue_dma(lds, NTC, 64, Kc, Vc, Kc + 64 * 64, wid, lane);
    LAS float* TS = (LAS float*)(lds + L_TSLC); LAS float* TW = (LAS float*)(lds + L_TWIN);
    { TabVals<N_TSLC> vs[4]; TabVals<N_TWIN> vw[4];
#pragma unroll
      for (int gg = 0; gg < 4; ++gg) { tab_load(vs[gg], 1151, rel_bias, 4 + 4 * hkv + gg, tid); tab_load(vw[gg], 639, rel_bias, 4 + 4 * hkv + gg, tid); }
      ATT_SCHED();
#pragma unroll
      for (int gg = 0; gg < 4; ++gg) { tab_store(vs[gg], TS + gg * N_TSLC, 1151, 0, 1 << 30, tid); tab_store(vw[gg], TW + gg * N_TWIN, 639, 0, 512, tid); } }
    const LAS float* Ts = TS + g * N_TSLC; const LAS float* Tw = TW + g * N_TWIN;
    LAS float* impb = (LAS float*)(lds + L_IMPB);
    volatile LAS unsigned long long* selm = (volatile LAS unsigned long long*)(lds + L_SELM);
    volatile LAS int* tlist = (volatile LAS int*)(lds + L_TLIST);
    f32x16 os0, os1;
    auto cmp_src = [&](int t, const bf16*& kp, const bf16*& vp) { kp = Kc + (size_t)t * 64 * 64; vp = Vc + (size_t)t * 64 * 64; };
    auto cmp_init = [&](int t, f32x16& p0, f32x16& p1) {
        const int dbase = tq - 31 - 16 * (64 * t + 4 * hi);
#pragma unroll
        for (int r = 0; r < 16; ++r) { const int kr = (r & 3) + 8 * (r >> 2);
            int d0 = dbase - 16 * kr, d1 = d0 - 512; d0 = d0 < -1 ? -1 : d0 > 1151 ? 1151 : d0; d1 = d1 < -1 ? -1 : d1 > 1151 ? 1151 : d1;
            p0[r] = Ts[1151 - d0]; p1[r] = Ts[1151 - d1]; }
    };
    LAS float* mref = (LAS float*)(lds + L_MREF);
    LAS float* mfin = (LAS float*)(lds + L_MFIN);
    { St st; st_init(st, -1e30f, 0.f); float carry = 0.f, ms_prev = 0.f;
      LAS float* ip = impb + (g * 64 + qrow) * IMP_LD + hi;
      tile_loop_hooked<STAG_CMP, HOIST_CMP>(lds, NTC, 64, qf, st, cmp_src, cmp_init, POST_NONE, SARGS_STD,
        [&](int t, int k, const float (&e)[8], float ms) {
            if (k == 0) { if (t > 0) carry *= ex2(ms_prev - ms); ms_prev = ms; if (hi == 0) mref[(g * 64 + qrow) * 4 + t] = ms; }
            const float own0 = (e[0] + e[1]) + (e[2] + 0.5f * e[3]), own1 = (e[4] + e[5]) + (e[6] + 0.5f * e[7]);
            const float pl0 = __shfl_xor(e[3], 32), pl1 = __shfl_xor(e[7], 32);
            const int j0 = 16 * t + 4 * k;
            ip[j0] = own0 + 0.5f * (hi ? pl0 : carry); ip[j0 + 2] = own1 + 0.5f * (hi ? pl1 : pl0);
            carry = pl1; },
        wid, lane);
      const float lt = xhalf_sum(st.l); const float inv_l = lt > 0.f ? 1.f / lt : 0.f;
      if (hi == 0) { mfin[g * 64 + qrow] = st.m; mfin[256 + g * 64 + qrow] = inv_l; }
      const float sc = g_cmp * inv_l;
      os0 = st.o0 * sc; os1 = st.o1 * sc; }
    ATT_BAR();
    if (HOIST_SLC) { const bf16* Kb0 = proj + (size_t)(b * SEQ) * NPROJ + C_KS + hkv * 64; const bf16* Vb0 = proj + (size_t)(b * SEQ) * NPROJ + C_VS + hkv * 64;
      dma_k(Kb0, NPROJ, lds + L_K, wid, lane); dma_v(Vb0, NPROJ, lds + L_V, wid, lane); }
    if (qb >= 16) {
        const int q = tid >> 3, part = tid & 7;
        LAS float* v = impb + q * IMP_LD;
        float fac[4];
#pragma unroll
        for (int gg = 0; gg < 4; ++gg) fac[gg] = ex2(mref[(gg * 64 + q) * 4 + (part >> 1)] - mfin[gg * 64 + q]) * mfin[256 + gg * 64 + q];
#pragma unroll
        for (int jj = 0; jj < 8; ++jj) { const int j = 8 * part + jj; v[j] = (v[j] * fac[0] + v[64 * IMP_LD + j] * fac[1]) + (v[2 * 64 * IMP_LD + j] * fac[2] + v[3 * 64 * IMP_LD + j] * fac[3]); }
        ATT_BAR();
        unsigned long long mk = part == 0 ? (1ull | (1ull << qb) | (1ull << (qb - 1))) : 0ull;
        unsigned long long kj[8]; int rank[8];
#pragma unroll
        for (int jj = 0; jj < 8; ++jj) { kj[jj] = ((unsigned long long)__float_as_uint(v[8 * part + jj]) << 6) | (unsigned)(63 - (8 * part + jj)); rank[jj] = 3; }
        for (int k = 1; k <= qb - 2; ++k) { const unsigned long long kk = ((unsigned long long)__float_as_uint(v[k]) << 6) | (unsigned)(63 - k);
#pragma unroll
            for (int jj = 0; jj < 8; ++jj) rank[jj] += kk > kj[jj] ? 1 : 0; }
#pragma unroll
        for (int jj = 0; jj < 8; ++jj) { const int j = 8 * part + jj; if (j >= 1 && j <= qb - 2 && rank[jj] < 16) mk |= 1ull << j; }
        unsigned lo = (unsigned)mk, hh = (unsigned)(mk >> 32);
#pragma unroll
        for (int o = 1; o < 8; o <<= 1) { lo |= __shfl_xor(lo, o); hh |= __shfl_xor(hh, o); }
        if (part == 0) selm[q] = ((unsigned long long)hh << 32) | lo;
    } else {
        if (tid < 64) selm[tid] = (2ull << qb) - 1ull;
    }
    ATT_BAR();
    if (wid == 0) {
        const unsigned long long mine = selm[lane]; unsigned lo = (unsigned)mine, hh = (unsigned)(mine >> 32);
#pragma unroll
        for (int o = 1; o < 64; o <<= 1) { lo |= __shfl_xor(lo, o); hh |= __shfl_xor(hh, o); }
        if (lane == 0) { tlist[0] = __builtin_popcount(lo) + __builtin_popcount(hh); tlist[65] = (int)lo; tlist[66] = (int)hh; }
    }
    ATT_BAR();
    const unsigned long long mysel = selm[qrow];
    const int ntl = tlist[0];
    LAS float* osl = (LAS float*)(lds + L_IMPB) + wid * 2048 + lane;
#pragma unroll
    for (int r = 0; r < 16; ++r) { osl[r * 64] = os0[r]; osl[(16 + r) * 64] = os1[r]; }
    { St st; st_init(st, -1e30f, 0.f);
      const bf16* Kb = proj + (size_t)(b * SEQ) * NPROJ + C_KS + hkv * 64; const bf16* Vb = proj + (size_t)(b * SEQ) * NPROJ + C_VS + hkv * 64;
      const float cfar = Ts[1151 - 1100];
      unsigned long long rem = ((unsigned long long)(unsigned)__builtin_amdgcn_readfirstlane(tlist[66]) << 32) | (unsigned)__builtin_amdgcn_readfirstlane(tlist[65]);
      auto pop = [&]() { const int j = rem ? __builtin_ctzll(rem) : 0; rem &= rem - 1ull; return j; };
      int tc = 0, w0 = pop(), w1 = pop(), w2 = pop();
      auto tile = [&](auto rel) { constexpr int R = decltype(rel)::value; return R == 0 ? w0 : R == 1 ? w1 : w2; };
      tile_loop_std<STAG_SLC, 2 * HOIST_SLC>(lds, ntl, NPROJ, qf, st,
        [&](auto rel, int t, const bf16*& kp, const bf16*& vp) { const int s0 = 64 * tile(rel); kp = Kb + (size_t)s0 * NPROJ; vp = Vb + (size_t)s0 * NPROJ; },
        ACT_ALL,
        [&](auto rel, int t, f32x16& p0, f32x16& p1) -> bool { const int s0 = 64 * tile(rel);
            if (tw0 - s0 <= 852) { init_tab(p0, p1, Ts + (1151 - (tq - s0) + 4 * hi)); return false; }
            return true; },
        [&](int t, f32x16&, f32x16&) { if (t > tc) { tc = t; w0 = w1; w1 = w2; w2 = pop(); } },
        [&](auto rel, int t, bool& live, float& cadd) { const int j = tile(rel); live = (mysel >> j) & 1ull; cadd = (tw0 - 64 * j <= 852) ? 0.f : cfar; },
        wid, lane);
      const float sc = g_slc / xhalf_sum(st.l);
#pragma unroll
      for (int r = 0; r < 16; ++r) { osl[r * 64] += st.o0[r] * sc; osl[(16 + r) * 64] += st.o1[r] * sc; } }
    { St st; st_init(st, -1e30f, 0.f);
      const bf16* Kb = proj + (size_t)(b * SEQ) * NPROJ + C_KW + hkv * 64; const bf16* Vb = proj + (size_t)(b * SEQ) * NPROJ + C_VW + hkv * 64;
      const int j0 = qb >= 8 ? qb - 8 : 0;
      tile_loop_std<STAG_WIN>(lds, qb - j0 + 1, NPROJ, qf, st,
        [&](int t, const bf16*& kp, const bf16*& vp) { const int s0 = 64 * (j0 + t); kp = Kb + (size_t)s0 * NPROJ; vp = Vb + (size_t)s0 * NPROJ; },
        ACT_ALL,
        [&](int t, f32x16& p0, f32x16& p1) { const int s0 = 64 * (j0 + t); init_tab(p0, p1, Tw + (639 - (tq - s0) + 4 * hi)); },
        POST_NONE,
        SARGS_STD, wid, lane);
      const float sc = g_win / xhalf_sum(st.l);
#pragma unroll
      for (int r = 0; r < 16; ++r) { os0[r] = osl[r * 64] + st.o0[r] * sc; os1[r] = osl[(16 + r) * 64] + st.o1[r] * sc; } }
    { int tq2 = tq; asm volatile("" : "+v"(tq2));
      store_o(O + (size_t)(b * SEQ + tw0) * DM + 512 + h8 * 64, os0, os1, 1.f, lane, ssq + (size_t)(b * SEQ + tq2) * 16 + 8 + h8, lds + wid * 4608); }
}
__device__ __forceinline__ void nsa_phase(LAS unsigned char* lds, int wv, const bf16* proj, const bf16* kcmp, const bf16* vcmp, const float* rel_bias, const float* gates, bf16* O, float* ssq, unsigned* ctr) {
    volatile LAS int* slot = (volatile LAS int*)(lds + LDSCTL_OFF + 64);
    for (int idx = (int)blockIdx.x; idx < 1024; idx = (int)gridDim.x + next_unit(ctr, slot, wv)) {
        nsa_unit(lds, wv, proj, kcmp, vcmp, rel_bias, gates, O, ssq, (idx & 15) >> 1, idx & 1, 63 - (idx >> 4));
    }
}

constexpr int L_RED = 0, L_HID = 16384, HID_LD = 136, L_HID2 = LDSCTL_OFF + 2048;
__device__ __forceinline__ void compress_unit(LAS unsigned char* lds, int wv, const bf16* proj, const bf16* w1t, const bf16* w2t, const float* cb1, bf16* kcmp, bf16* vcmp, int u) {
    int tid_l = wv * 64 + lane_id_fresh(); asm volatile("" : "+v"(tid_l));
    const int tid = tid_l, lane = tid & 63, r32 = lane & 31, hi = lane >> 5, wid = __builtin_amdgcn_readfirstlane(tid >> 6);
    const int i16 = lane & 15, kg = lane >> 4;
    const int mt = u & 7, kv = (u >> 3) & 1, hk = (u >> 4) & 1, b = u >> 5, n0 = 32 * mt;
    const int col0 = (kv ? C_VC : C_KC) + hk * 64;
    typedef float f32x4v __attribute__((ext_vector_type(4)));
    f32x4v acc[2][8];
#pragma unroll
    for (int rb = 0; rb < 2; ++rb)
#pragma unroll
        for (int cb = 0; cb < 8; ++cb) acc[rb][cb] = (f32x4v){0.f, 0.f, 0.f, 0.f};
    const bf16x8 zero8 = {0, 0, 0, 0, 0, 0, 0, 0};
    const int na = n0 + i16, nb = n0 + 16 + i16;
    const bf16* ar0 = proj + (size_t)(b * SEQ + 16 * (na < 255 ? na : 0)) * NPROJ + col0 + 8 * kg;
    const bf16* ar1 = proj + (size_t)(b * SEQ + 16 * (nb < 255 ? nb : 0)) * NPROJ + col0 + 8 * kg;
    const bf16* br = w1t + ((size_t)kv * 128 + i16) * 2048 + 8 * kg;
#pragma unroll 2
    for (int s8 = 0; s8 < 8; ++s8) { const int k = 256 * wid + 32 * s8;
        const size_t ao = (size_t)(k >> 6) * NPROJ + (k & 63);
        bf16x8 a0 = *(const GAS bf16x8*)(ar0 + ao), a1 = *(const GAS bf16x8*)(ar1 + ao);
        if (na >= 255) a0 = zero8; if (nb >= 255) a1 = zero8;
        bf16x8 bf[8];
#pragma unroll
        for (int cb = 0; cb < 8; ++cb) bf[cb] = *(const GAS bf16x8*)(br + (size_t)cb * 16 * 2048 + k);
#pragma unroll
        for (int cb = 0; cb < 8; ++cb) { acc[0][cb] = __builtin_amdgcn_mfma_f32_16x16x32_bf16(a0, bf[cb], acc[0][cb], 0, 0, 0); acc[1][cb] = __builtin_amdgcn_mfma_f32_16x16x32_bf16(a1, bf[cb], acc[1][cb], 0, 0, 0); } }
    LAS float* part = (LAS float*)lds;
#pragma unroll
    for (int rb = 0; rb < 2; ++rb)
#pragma unroll
        for (int cb = 0; cb < 8; ++cb)
#pragma unroll
            for (int e = 0; e < 4; ++e) part[(wid * 64 + (rb * 8 + cb) * 4 + e) * 64 + lane] = acc[rb][cb][e];
    ATT_BAR();
    LAS bf16* hid = (LAS bf16*)(lds + L_HID2);
#pragma unroll
    for (int q = 0; q < 8; ++q) { const int rr = 8 * wid + q; float x = 0.f;
#pragma unroll
        for (int w8 = 0; w8 < 8; ++w8) x += part[(w8 * 64 + rr) * 64 + lane];
        const int rb = rr >> 5, cb = (rr >> 2) & 7, e = rr & 3, row = 16 * rb + 4 * kg + e, col = 16 * cb + i16;
        x += cb1[kv * 128 + col];
        const float z = 0.7978845608028654f * (x + 0.044715f * x * x * x); const float th = 1.f - 2.f / (1.f + __expf(2.f * z));
        hid[row * HID_LD + col] = (bf16)f2bf(0.5f * x * (1.f + th)); }
    ATT_BAR();
    if (wid < 2) {
        f32x16 a2;
#pragma unroll
        for (int r = 0; r < 16; ++r) a2[r] = 0.f;
        const bf16* b2 = w2t + ((size_t)kv * 64 + 32 * wid + r32) * 128 + 8 * hi;
#pragma unroll
        for (int ks = 0; ks < 8; ++ks) { const bf16x8 a = *(const LAS bf16x8*)(hid + r32 * HID_LD + 16 * ks + 8 * hi); const bf16x8 bb = *(const GAS bf16x8*)(b2 + 16 * ks);
            a2 = __builtin_amdgcn_mfma_f32_32x32x16_bf16(a, bb, a2, 0, 0, 0); }
        bf16* out = (kv ? vcmp : kcmp) + (size_t)((b * 2 + hk) * 256 + n0) * 64 + 32 * wid + r32;
#pragma unroll
        for (int r = 0; r < 16; ++r) { const int row = (r & 3) + 8 * (r >> 2) + 4 * hi; out[(size_t)row * 64] = (n0 + row < 255) ? (bf16)f2bf(a2[r]) : (bf16)0; }
    }
    ATT_BAR();
}
__device__ __forceinline__ void thin_block(LAS unsigned char* lds, int wv, const bf16* hbuf, const bf16* wt, const float* fbias, float* logf, float* gates, int tb) {
    int tid_l = wv * 64 + lane_id_fresh(); asm volatile("" : "+v"(tid_l));
    const int tid = tid_l, lane = tid & 63, wid = __builtin_amdgcn_readfirstlane(tid >> 6), i16 = lane & 15, kg = lane >> 4, r0 = 128 * tb;
    typedef float f32x4v __attribute__((ext_vector_type(4)));
    f32x4v acc[8][2];
#pragma unroll
    for (int rb = 0; rb < 8; ++rb) { acc[rb][0] = (f32x4v){0.f, 0.f, 0.f, 0.f}; acc[rb][1] = (f32x4v){0.f, 0.f, 0.f, 0.f}; }
    const bf16* ar = hbuf + (size_t)(r0 + i16) * DM + 128 * wid + 8 * kg;
    const bf16* br = wt + (size_t)(C_FB + i16) * DM + 128 * wid + 8 * kg;
#pragma unroll 2
    for (int s4 = 0; s4 < 4; ++s4) {
        bf16x8 af[8];
#pragma unroll
        for (int rb = 0; rb < 8; ++rb) af[rb] = *(const GAS bf16x8*)(ar + (size_t)rb * 16 * DM + 32 * s4);
        const bf16x8 b0 = *(const GAS bf16x8*)(br + 32 * s4), b1 = *(const GAS bf16x8*)(br + (size_t)16 * DM + 32 * s4);
#pragma unroll
        for (int rb = 0; rb < 8; ++rb) { acc[rb][0] = __builtin_amdgcn_mfma_f32_16x16x32_bf16(af[rb], b0, acc[rb][0], 0, 0, 0); acc[rb][1] = __builtin_amdgcn_mfma_f32_16x16x32_bf16(af[rb], b1, acc[rb][1], 0, 0, 0); } }
    LAS float* part = (LAS float*)lds;
#pragma unroll
    for (int rb = 0; rb < 8; ++rb)
#pragma unroll
        for (int cb = 0; cb < 2; ++cb)
#pragma unroll
            for (int e = 0; e < 4; ++e) part[(wid * 64 + (rb * 2 + cb) * 4 + e) * 64 + lane] = acc[rb][cb][e];
    ATT_BAR();
#pragma unroll
    for (int q = 0; q < 8; ++q) { const int rr = 8 * wid + q; float v = 0.f;
#pragma unroll
        for (int w8 = 0; w8 < 8; ++w8) v += part[(w8 * 64 + rr) * 64 + lane];
        const int rb = rr >> 3, cb = (rr >> 2) & 1, e = rr & 3, row = r0 + 16 * rb + 4 * kg + e, c = 16 * cb + i16;
        if (c < 4) { const float z = v + fbias[c]; logf[(size_t)((row / SEQ) * 4 + c) * SEQ + (row % SEQ)] = fminf(z, 0.f) - log1pf(__expf(-fabsf(z))); }
        else if (c < 28) gates[(size_t)row * 24 + (c - 4)] = 1.f / (1.f + __expf(-v)); }
    ATT_BAR();
}
__device__ __forceinline__ void prep_phase(LAS unsigned char* lds, int wv, const bf16* proj, const bf16* w1t, const bf16* w2t, const float* cb1, bf16* kcmp, bf16* vcmp,
                                           const bf16* hbuf, const bf16* wint, const float* fbias, float* logf, float* gates) {
    int G = gridDim.x, bx = blockIdx.x; asm volatile("" : "+s"(G), "+s"(bx));
    for (int tb = bx; tb < M / 128; tb += G) thin_block(lds, wv, hbuf, wint, fbias, logf, gates, tb);
    for (int u = bx; u < 256; u += G) compress_unit(lds, wv, proj, w1t, w2t, cb1, kcmp, vcmp, u);
}
}
#define GBX() int G = G0, bx = bx0; asm volatile("" : "+s"(G), "+s"(bx))
#define FRAME() GBX(); Frame F; { int t_ = wv * 64 + lane_id_fresh(); asm volatile("" : "+v"(t_)); F.lds = lds_raw; F.tid = t_; F.lane = t_ & 63; F.wave = __builtin_amdgcn_readfirstlane(t_ >> 6); \
        const int vcu_ = (G % 8 == 0) ? (bx % 8) * (G / 8) + bx / 8 : bx; F.gw = vcu_ * NWAVES + F.wave; F.NGW = G * NWAVES; }
#define GRID_BAR() do { if (KINT(5)) xcd_barrier(bar); } while (0)
#define WSB(off) (KWS + (off))
#define P_H ((bf16*)WSB(WS_RH))
#define P_O ((bf16*)WSB(WS_RH))
#define P_PROJ ((bf16*)WSB(WS_R1))
#define P_U ((bf16*)WSB(WS_R1))
#define P_Y ((bf16*)WSB(WS_Y))
#define P_Y2 ((bf16*)WSB(WS_Y + 64 * MiB))
#define P_MOD(l) ((const float*)WSB(WS_MOD) + (size_t)(l) * 8 * 6144)
#define P_WL(l, off) ((const bf16*)(WSB(WS_W) + (size_t)(l) * WL_STRIDE + (off)))
#define IN(p) (KINT(2) <= (p) && (p) < KINT(3))
template <int l>
__device__ __forceinline__ void layer_body(LAS unsigned char* lds_raw, int wv, const XcdBarrier& bar, int G0, int bx0) {
    if (!(l >= KINT(0) && l < KINT(1))) return;
        if (IN(PH_PROJ)) for (int rep = 0; rep <= ((KINT(7) >> PH_PROJ) & 1); ++rep) {
            GBX(); pg8::Gemm g{P_H, P_WL(l, WL_IN), M, C_FB, DM}; pg8::StaticOrder S; S.init(M, C_FB, G, bx);
            pg8::EpiProj E{P_PROJ, (float*)WSB(WS_LOGF), (float*)WSB(WS_GATES), KIN(10) + l * 4};
            pg8::gemm_phase<pg8::EpiProj, pg8::StaticOrder, true, true>(lds_raw, g, S, E, wv);
            GRID_BAR();
        }
        if (IN(PH_PREP)) for (int rep = 0; rep <= ((KINT(7) >> PH_PREP) & 1); ++rep) {
            att::prep_phase(lds_raw, wv, P_PROJ, P_WL(l, WL_CW1), P_WL(l, WL_CW2), (const float*)WSB(WS_CB1) + l * 256, (bf16*)WSB(WS_KCMP), (bf16*)WSB(WS_VCMP),
                            P_H, P_WL(l, WL_IN), KIN(10) + l * 4, (float*)WSB(WS_LOGF), (float*)WSB(WS_GATES));
            GRID_BAR();
        }
        if (IN(PH_ATT)) for (int rep = 0; rep <= ((KINT(7) >> PH_ATT) & 1); ++rep) {
            if ((rep ? KINT(7) >> 16 : KINT(6)) & 4) att::nsa_phase(lds_raw, wv, P_PROJ, (const bf16*)WSB(WS_KCMP), (const bf16*)WSB(WS_VCMP), (const float*)WSB(WS_B2), (const float*)WSB(WS_GATES), P_O, (float*)WSB(WS_SS), (unsigned*)KWS + CW_Q + 64 * (16 * rep + 4 * l + 1));
            if ((rep ? KINT(7) >> 16 : KINT(6)) & 1) att::fox_phase(lds_raw, wv, P_PROJ, (const float*)WSB(WS_LOGF), P_O, (float*)WSB(WS_SS), (unsigned*)KWS + CW_Q + 64 * (16 * rep + 4 * l + 0));
            if ((rep ? KINT(7) >> 16 : KINT(6)) & 2) att::swa_phase(lds_raw, wv, P_PROJ, (const float*)WSB(WS_B2), KIN(11) + l * 4, P_O, (float*)WSB(WS_SS), (unsigned*)KWS + CW_Q + 64 * (16 * rep + 4 * l + 2));
            GRID_BAR();
        }
        if (IN(PH_WOUT)) for (int rep = 0; rep <= ((KINT(7) >> PH_WOUT) & 1); ++rep) {
            GBX(); pg8::Gemm g{P_O, P_WL(l, WL_OUT), M, DM, DM}; pg8::StaticOrder S; S.init(M, DM, G, bx);
            LAS f32x4* rf = (LAS f32x4*)(lds_raw + L_RF);
            pg8::Unit u0, u1; const bool h0 = S.next(0, u0), h1 = S.next(1, u1);
            { int t_ = wv * 64 + lane_id_fresh(); asm volatile("" : "+v"(t_));
              const bool hv = t_ < 256 ? h0 : h1; const int row = (t_ < 256 ? u0.pm : u1.pm) * 256 + (t_ & 255);
              if (hv) { const GAS f32x4* sp = (const GAS f32x4*)((const float*)WSB(WS_SS) + (size_t)row * 16); const f32x4 a = sp[0], b = sp[1], c = sp[2], d = sp[3];
                  const float qa = ((a[0] + a[1]) + (a[2] + a[3])) * (1.f / 256.f) + RMS_EPS, qb = ((b[0] + b[1]) + (b[2] + b[3])) * (1.f / 256.f) + RMS_EPS,
                              qc = (((c[0] + c[1]) + (c[2] + c[3])) + ((d[0] + d[1]) + (d[2] + d[3]))) * (1.f / 512.f) + RMS_EPS;
                  rf[t_] = (f32x4){sqrtf(qb / qa), sqrtf(qc / qb), rsqrtf(qc), 0.f}; } }
            __syncthreads();
            pg8::EpiYGn E{P_Y, DM, rf, u0.pm}; pg8::GnHook KH{rf};
            pg8::gemm_phase<pg8::EpiYGn, pg8::StaticOrder, true, true, pg8::GnHook>(lds_raw, g, S, E, wv, KH);
            GRID_BAR();
        }
        if (IN(PH_NORM2)) for (int rep = 0; rep <= ((KINT(7) >> PH_NORM2) & 1); ++rep) { FRAME(); norm_phase(F, KIN(0), P_Y, KIN(6) + l * DM, P_MOD(l), 2, nullptr, nullptr, 0, nullptr, KIN(7) + l * DM, P_MOD(l), 4, 3, P_H, l == 0 ? (const bf16*)nullptr : (const bf16*)KOUT); GRID_BAR(); }
        if (IN(PH_GU)) for (int rep = 0; rep <= ((KINT(7) >> PH_GU) & 1); ++rep) {
            GBX(); pg8::Gemm g{P_H, P_WL(l, WL_GU), M, 2 * FFN, DM}; pg8::StaticOrder S; S.init(M, 2 * FFN, G, bx);
            pg8::EpiSwiglu E{P_U};
            pg8::gemm_phase<pg8::EpiSwiglu, pg8::StaticOrder, true, true>(lds_raw, g, S, E, wv);
            GRID_BAR();
        }
        if (IN(PH_DOWN)) for (int rep = 0; rep <= ((KINT(7) >> PH_DOWN) & 1); ++rep) {
            GBX(); pg8::Gemm g{P_U, P_WL(l, WL_DOWN), M, DM, FFN}; pg8::StaticOrder S; S.init(M, DM, G, bx);
            pg8::EpiY E{P_Y2, DM};
            pg8::gemm_phase<pg8::EpiY, pg8::StaticOrder, true, true>(lds_raw, g, S, E, wv);
            GRID_BAR();
        }
        if (IN(PH_NORM3)) {
            const bool last = (l == DEPTH - 1); FRAME();
            norm_phase(F, KIN(0), P_Y, KIN(6) + l * DM, P_MOD(l), 2, P_Y2, KIN(8) + l * DM, 5, KOUT, KIN(5) + (last ? l : l + 1) * DM, P_MOD(last ? l : l + 1), 1, 0, last ? (bf16*)nullptr : P_H,
                       l == 0 ? (const bf16*)nullptr : (const bf16*)KOUT, last ? (bf16*)nullptr : (bf16*)KOUT);
            if (!last) GRID_BAR();
        }
}
__global__ void __launch_bounds__(NTHR, 2) __attribute__((target("no-packed-fp32-ops"))) mega(MArgs a) {
    extern __shared__ __attribute__((aligned(16))) unsigned char lds_dyn[];
    LAS unsigned char* lds_raw = (LAS unsigned char*)lds_dyn;
    const int G0 = gridDim.x, bx0 = blockIdx.x;
    const int wv = __builtin_amdgcn_readfirstlane((int)(threadIdx.x >> 6));
    { FRAME();
    for (int u = F.tid; u < (LDS_BYTES - LDSCTL_OFF) / 4; u += NTHR) ((LAS unsigned*)(F.lds + LDSCTL_OFF))[u] = 0u;
    __syncthreads(); }
    XcdBarrier bar; bar.bar = (unsigned*)KWS + CW_BAR; bar.x = 0; bar.st = nullptr; bar.wv = wv;
    if (KINT(5)) bar = xcd_barrier_post((unsigned*)KWS + CW_BAR, (volatile LAS unsigned*)(lds_raw + LDSCTL_OFF + 32), wv);
    if (KINT(4) & 1) for (int rep = 0; rep <= ((KINT(7) >> 9) & 1); ++rep) { FRAME(); pro_a(F); GRID_BAR(); }
    if (KINT(4) & 2) { FRAME(); cb1_finish(F); norm_phase(F, KIN(0), nullptr, nullptr, nullptr, 0, nullptr, nullptr, 0, nullptr, KIN(5), P_MOD(0), 1, 0, P_H); GRID_BAR(); }
    layer_body<0>(lds_raw, wv, bar, G0, bx0);
    layer_body<1>(lds_raw, wv, bar, G0, bx0);
    layer_body<2>(lds_raw, wv, bar, G0, bx0);
    layer_body<3>(lds_raw, wv, bar, G0, bx0);
}
#ifndef DUP_MASK
#define DUP_MASK 0
#endif
extern "C" void kernel_launch(void* const* d_in, const int* in_sizes, int n_in, void* d_out, int out_size, void* d_ws, size_t ws_size, hipStream_t stream) {
    if (n_in != 20 || out_size != M * DM || ws_size < WS_END) { fprintf(stderr, "kernel_launch: unexpected sizes n_in %d out %d ws %zu\n", n_in, out_size, ws_size); return; }
    static int grid = 0;
    if (grid == 0) {
        int dev = 0, cus = 0;
        if (hipGetDevice(&dev) != hipSuccess || hipDeviceGetAttribute(&cus, hipDeviceAttributeMultiprocessorCount, dev) != hipSuccess) { grid = -1; return; }
        if (hipFuncSetAttribute((const void*)mega, hipFuncAttributeMaxDynamicSharedMemorySize, LDS_BYTES) != hipSuccess) { fprintf(stderr, "hipFuncSetAttribute failed\n"); grid = -1; return; }
        int per_cu = 0;
        if (hipOccupancyMaxActiveBlocksPerMultiprocessor(&per_cu, (const void*)mega, NTHR, LDS_BYTES) != hipSuccess || per_cu < 1) { fprintf(stderr, "occupancy query reports %d workgroups per CU\n", per_cu); (void)hipGetLastError(); grid = -1; return; }
        grid = cus;
        if (grid != 256) { fprintf(stderr, "kernel_launch: this kernel is laid out for a 256-CU device (one workgroup per CU); found %d CUs\n", cus); grid = -1; return; }
    }
    if (grid < 0) return;
    (void)hipMemsetAsync(d_ws, 0, 1 * MiB, stream);
    MArgs a{};
    for (int i = 0; i < 20; ++i) a.in[i] = (const float*)d_in[i];
    a.out = (float*)d_out; a.ws = (unsigned char*)d_ws;
    a.lay_lo = 0; a.lay_hi = DEPTH; a.ph_lo = 0; a.ph_hi = NPH; a.do_pro = 3; a.use_bar = 1; a.att_mask = 7; a.pad = DUP_MASK;
    hipLaunchKernelGGL(mega, dim3(grid), dim3(NTHR), LDS_BYTES, stream, a);
}
```

```cpp
#include <hip/hip_runtime.h>
#include <cstdio>
#include <cstdint>
#include <type_traits>

#ifndef F32_MODE
#define F32_MODE 0
#endif

constexpr int DM = 1024, NB = 8, SEQ = 4096, DEPTH = 4, HD = 64;
constexpr int M = NB * SEQ;
constexpr int NIN = 2588, NPROJ = 2816, FFN = 2816;
constexpr float RMS_EPS = 1e-6f;
constexpr float LOG2E = 1.4426950408889634f;
constexpr float QSCALE = 0.125f * LOG2E;
constexpr int C_QA = 0, C_KA = 256, C_VA = 384, C_QB = 512, C_KB = 768, C_VB = 1024, C_QC = 1280, C_KC = 1792, C_VC = 1920,
              C_KS = 2048, C_VS = 2176, C_KW = 2304, C_VW = 2432, C_FB = 2560, C_GC = 2564;

#if F32_MODE
typedef float act_t;
__device__ __forceinline__ float ldA(const act_t* p) { return *p; }
__device__ __forceinline__ void stA(act_t* p, float v) { *p = v; }
#else
typedef unsigned short act_t;
__device__ __forceinline__ float ldA(const act_t* p) { return __uint_as_float(((unsigned)*p) << 16); }
__device__ __forceinline__ void stA(act_t* p, float v) { unsigned u = __float_as_uint(v); *p = (act_t)((u + 0x7fffu + ((u >> 16) & 1u)) >> 16); }
#endif

constexpr size_t MiB = 1u << 20;
constexpr size_t WS_MOD = 1 * MiB, WS_LOGF = 2 * MiB, WS_CUM = 2 * MiB + 512 * 1024, WS_GATES = 3 * MiB, WS_KCMP = 6 * MiB, WS_VCMP = 7 * MiB,
                 WS_SEL = 8 * MiB, WS_IMP = 9 * MiB, WS_STATS = 25 * MiB;
#if F32_MODE
constexpr size_t WS_RH = 32 * MiB, WS_R1 = 160 * MiB, WS_Y = WS_R1, WS_Y2 = WS_RH, WS_END = 512 * MiB;
#else
constexpr size_t WS_RH = 32 * MiB, WS_Y = 96 * MiB, WS_Y2 = WS_Y, WS_R1 = 224 * MiB, WS_W = 400 * MiB, WS_END = 512 * MiB;
#endif

__device__ __forceinline__ int t5_bucket(int dist) {
    if (dist < 16) return dist < 0 ? 0 : dist;
    int b = 16;
    b += dist >= 21; b += dist >= 27; b += dist >= 35; b += dist >= 46; b += dist >= 59; b += dist >= 77; b += dist >= 99; b += dist >= 128;
    b += dist >= 166; b += dist >= 216; b += dist >= 280; b += dist >= 363; b += dist >= 470; b += dist >= 609; b += dist >= 790;
    return b;
}
__device__ __forceinline__ float wave_sum(float v) {
#pragma unroll
    for (int o = 1; o < 64; o <<= 1) v += __shfl_xor(v, o);
    return v;
}

__device__ __forceinline__ int lane_id_fresh() { int x; asm volatile("v_mbcnt_lo_u32_b32 %0, -1, 0\n\tv_mbcnt_hi_u32_b32 %0, -1, %0" : "=v"(x)); return x; }
namespace pg8 {
#define PG8_LAS __attribute__((address_space(3)))
typedef unsigned short bf16_t;
typedef short bf16x8 __attribute__((ext_vector_type(8)));
typedef float f32x4 __attribute__((ext_vector_type(4)));
typedef unsigned u32x4 __attribute__((ext_vector_type(4)));
constexpr int BM = 256, BK = 64, HALF = 128, HTB = HALF * BK * 2  , STAGE_BYTES = 8 * HTB, NXCD = 8, WGM = 8;

__host__ __device__ __forceinline__ int lds_byte(int r, int c) { const int st = (r >> 4) * 2 + (c >> 5), rr = r & 15, cc = c & 31, ob = rr * 64 + cc * 2; return st * 1024 + (ob ^ (((ob >> 9) & 1) << 5)); }
__host__ __device__ __forceinline__ void stage_rc(int b, int& R, int& C) { const int st = b / 1024, sb = b % 1024, swz = sb ^ (((sb >> 9) & 1) << 5); R = (st >> 1) * 16 + swz / 64; C = (st & 1) * 32 + (swz % 64) / 2; }
__host__ __device__ __forceinline__ int perm32(int rho) { const int n = rho >> 4, i = rho & 15; return 8 * (i >> 2) + 4 * n + (i & 3); }

struct Unit { int pm, pn; };
struct Gemm { const bf16_t* A; const bf16_t* Bt; int M, N, K; };

struct StaticOrder {
    int nM, nN, nwg, G, c;
    __host__ __device__ __forceinline__ void init(int M, int N, int G_, int c_) { nM = M / BM; nN = N / BM; nwg = nM * nN; G = G_; c = c_; }
    __host__ __device__ __forceinline__ bool next(int i, Unit& u) const {
        const long L = (long)i * G + c; if (L >= nwg) return false;
        int wgid = (int)L; { const int q = nwg / NXCD, r = nwg % NXCD, xcd = wgid % NXCD, off = wgid / NXCD; wgid = (xcd < r ? xcd * (q + 1) : r * (q + 1) + (xcd - r) * q) + off; }
        const int nig = WGM * nN, gid = wgid / nig, fm = gid * WGM, gsz = (nM - fm) < WGM ? (nM - fm) : WGM;
        u.pm = fm + ((wgid % nig) % gsz); u.pn = (wgid % nig) / gsz; return true;
    }
    __device__ __forceinline__ void a_ready(const Unit&) const {}
    __device__ __forceinline__ void done(const Unit&) const {}
};

__device__ __forceinline__ unsigned cvt_pk_bf16(float lo, float hi) { unsigned r; asm volatile("v_cvt_pk_bf16_f32 %0, %1, %2" : "=v"(r) : "v"(lo), "v"(hi)); return r; }
struct NoKHook { static constexpr bool ACTIVE = false; };
template <class Epi, class Sched, bool ALIGN_EPI = false, bool SP2 = false, class KH = NoKHook>
__device__ __forceinline__ void gemm_phase(PG8_LAS unsigned char* lds, const Gemm g, const Sched& S, const Epi& E, int wv, const KH& kh = KH()) {
    int tid_l = wv * 64 + lane_id_fresh(); asm volatile("" : "+v"(tid_l));
    const int tid = tid_l, wid = __builtin_amdgcn_readfirstlane(tid >> 6), lane = tid & 63, wr = wid >> 2, wc = wid & 3, fr = lane & 15, fq = lane >> 4;
    const int K = g.K, nt = K / BK;
    unsigned voffA[2], voffB[2];
#pragma unroll
    for (int i = 0; i < 2; ++i) { int R, C; stage_rc(tid * 16 + i * 8192, R, C); const int Rb = Epi::PERM ? ((R & ~31) + perm32(R & 31)) : R;
        voffA[i] = (unsigned)(R * K + C) * 2u; voffB[i] = (unsigned)(Rb * K + C) * 2u; }
    const size_t kstep = (size_t)(BK * 2);
    const size_t hstep = (size_t)HALF * K * 2;
    const size_t tstep = 2 * hstep;
    const unsigned ldsw = (unsigned)wid * 1024u;
    const int aoff = lds_byte(wr * 64 + fr, fq * 8), boff = lds_byte(wc * 32 + fr, fq * 8);
#define PG8_SA(b, h) (((b) * 2 + (h)) * HTB)
#define PG8_SB(b, h) ((4 + (b) * 2 + (h)) * HTB)
#define PG8_STAGE(bufoff, gbase, voff) do { _Pragma("unroll") for (int _i = 0; _i < 2; ++_i) \
        __builtin_amdgcn_global_load_lds((const unsigned*)((const char*)(gbase) + (voff)[_i]), (PG8_LAS unsigned*)(lds + (bufoff) + ldsw + _i * 8192), 16, 0, 0); } while (0)
#define PG8_LDA(dst, b, h) do { _Pragma("unroll") for (int m = 0; m < 4; ++m) _Pragma("unroll") for (int k = 0; k < 2; ++k) dst[m][k] = *(const PG8_LAS bf16x8*)(lds + PG8_SA(b, h) + aoff + m * 2048 + k * 1024); } while (0)
#define PG8_LDB(dst, b, h) do { _Pragma("unroll") for (int n = 0; n < 2; ++n) _Pragma("unroll") for (int k = 0; k < 2; ++k) dst[n][k] = *(const PG8_LAS bf16x8*)(lds + PG8_SB(b, h) + boff + n * 2048 + k * 1024); } while (0)
#define PG8_MMA(ai, bj, At, Bt) do { __builtin_amdgcn_s_setprio(1); _Pragma("unroll") for (int m = 0; m < 4; ++m) _Pragma("unroll") for (int n = 0; n < 2; ++n) _Pragma("unroll") for (int k = 0; k < 2; ++k) \
        acc[ai][bj][m][n] = __builtin_amdgcn_mfma_f32_16x16x32_bf16(Bt[n][k], At[m][k], acc[ai][bj][m][n], 0, 0, 0); __builtin_amdgcn_s_setprio(0); } while (0)
#define PG8_WAIT_V(n) asm volatile("s_waitcnt vmcnt(" #n ")" ::: "memory")
#define PG8_WAIT_L(n) asm volatile("s_waitcnt lgkmcnt(" #n ")" ::: "memory")
#define PG8_BAR __builtin_amdgcn_s_barrier()
#define PG8_SCHED __builtin_amdgcn_sched_barrier(0)
    Unit cur, nxt; int ui = 0;
    if (!S.next(0, cur)) return;
    f32x4 acc[2][2][4][2];
#pragma unroll
    for (int a = 0; a < 2; ++a)
#pragma unroll
        for (int b = 0; b < 2; ++b)
#pragma unroll
            for (int m = 0; m < 4; ++m)
#pragma unroll
                for (int n = 0; n < 2; ++n) acc[a][b][m][n] = (f32x4){0.f, 0.f, 0.f, 0.f};
    bf16x8 At[4][2], B0[2][2], B1[2][2];
    const char* cA = (const char*)g.A + (size_t)cur.pm * tstep; const char* cB = (const char*)g.Bt + (size_t)cur.pn * tstep;
    S.a_ready(cur);
    if constexpr (SP2) {
        PG8_STAGE(PG8_SB(0, 0), cB, voffB); PG8_STAGE(PG8_SB(0, 1), cB + hstep, voffB); PG8_STAGE(PG8_SA(0, 0), cA, voffA); PG8_STAGE(PG8_SA(0, 1), cA + hstep, voffA);
        if (wr == 1) PG8_BAR;
        PG8_WAIT_V(2); PG8_BAR;
        PG8_STAGE(PG8_SB(1, 0), cB + kstep, voffB); PG8_STAGE(PG8_SA(1, 0), cA + kstep, voffA); PG8_STAGE(PG8_SB(1, 1), cB + hstep + kstep, voffB);
        PG8_WAIT_V(6); PG8_BAR;
    } else {
        PG8_STAGE(PG8_SB(0, 0), cB, voffB); PG8_STAGE(PG8_SA(0, 0), cA, voffA); PG8_STAGE(PG8_SB(0, 1), cB + hstep, voffB); PG8_STAGE(PG8_SA(0, 1), cA + hstep, voffA);
        if (wr == 1) PG8_BAR;
        PG8_WAIT_V(4); PG8_BAR;
        PG8_STAGE(PG8_SB(1, 0), cB + kstep, voffB); PG8_STAGE(PG8_SA(1, 0), cA + kstep, voffA); PG8_STAGE(PG8_SB(1, 1), cB + hstep + kstep, voffB);
        PG8_WAIT_V(6); PG8_BAR;
    }
    for (;;) {
        const bool has_next = S.next(ui + 1, nxt);
        const char* nA = has_next ? (const char*)g.A + (size_t)nxt.pm * tstep : cA; const char* nB = has_next ? (const char*)g.Bt + (size_t)nxt.pn * tstep : cB;
        for (int t = 0; t < nt; t += 2) {
            if constexpr (KH::ACTIVE) { if (t == KH::T1 || t == KH::T2) kh.apply(acc, t, ui, wr, fr); }
            const bool last = (t == nt - 2);
            const char* a1 = cA + (size_t)(t + 1) * kstep;
            const char* a2 = last ? nA : cA + (size_t)(t + 2) * kstep; const char* b2 = last ? nB : cB + (size_t)(t + 2) * kstep;
            const char* a3 = a2 + kstep; const char* b3 = b2 + kstep;
            if (last && has_next) S.a_ready(nxt);
            if constexpr (SP2) {
            PG8_LDB(B0, 0, 0); PG8_LDB(B1, 0, 1); PG8_SCHED; PG8_LDA(At, 0, 0); PG8_STAGE(PG8_SA(1, 1), a1 + hstep, voffA);
            PG8_WAIT_V(8); PG8_WAIT_L(0); PG8_BAR; PG8_MMA(0, 0, At, B0); PG8_MMA(0, 1, At, B1); PG8_BAR; PG8_SCHED;
            PG8_LDA(At, 0, 1); PG8_STAGE(PG8_SB(0, 0), b2, voffB); PG8_STAGE(PG8_SB(0, 1), b2 + hstep, voffB); PG8_STAGE(PG8_SA(0, 0), a2, voffA);
            PG8_WAIT_V(8); PG8_WAIT_L(0); PG8_BAR; PG8_MMA(1, 0, At, B0); PG8_MMA(1, 1, At, B1); PG8_BAR; PG8_SCHED;
            PG8_LDB(B0, 1, 0); PG8_LDB(B1, 1, 1); PG8_SCHED; PG8_LDA(At, 1, 0); PG8_STAGE(PG8_SA(0, 1), a2 + hstep, voffA);
            PG8_WAIT_V(8); PG8_WAIT_L(0); PG8_BAR; PG8_MMA(0, 0, At, B0); PG8_MMA(0, 1, At, B1); PG8_BAR; PG8_SCHED;
            PG8_LDA(At, 1, 1); PG8_STAGE(PG8_SB(1, 0), b3, voffB); PG8_STAGE(PG8_SB(1, 1), b3 + hstep, voffB); PG8_STAGE(PG8_SA(1, 0), a3, voffA);
            PG8_WAIT_V(8); PG8_WAIT_L(0); PG8_BAR; PG8_MMA(1, 0, At, B0); PG8_MMA(1, 1, At, B1); PG8_BAR; PG8_SCHED;
            } else {
            PG8_LDB(B0, 0, 0); PG8_SCHED; PG8_LDA(At, 0, 0); PG8_STAGE(PG8_SA(1, 1), a1 + hstep, voffA);
            PG8_WAIT_L(8); PG8_BAR; PG8_WAIT_L(0); PG8_MMA(0, 0, At, B0); PG8_BAR; PG8_SCHED;
            PG8_LDB(B1, 0, 1); PG8_STAGE(PG8_SB(0, 0), b2, voffB);
            PG8_BAR; PG8_WAIT_L(0); PG8_MMA(0, 1, At, B1); PG8_BAR;
            PG8_LDA(At, 0, 1); PG8_STAGE(PG8_SA(0, 0), a2, voffA);
            PG8_BAR; PG8_WAIT_L(0); PG8_MMA(1, 0, At, B0); PG8_BAR; PG8_SCHED;
            PG8_STAGE(PG8_SB(0, 1), b2 + hstep, voffB);
            PG8_WAIT_V(6); PG8_BAR; PG8_MMA(1, 1, At, B1); PG8_BAR;
            PG8_LDB(B0, 1, 0); PG8_SCHED; PG8_LDA(At, 1, 0); PG8_STAGE(PG8_SA(0, 1), a2 + hstep, voffA);
            PG8_WAIT_L(8); PG8_BAR; PG8_WAIT_L(0); PG8_MMA(0, 0, At, B0); PG8_BAR; PG8_SCHED;
            PG8_LDB(B1, 1, 1); PG8_STAGE(PG8_SB(1, 0), b3, voffB);
            PG8_BAR; PG8_WAIT_L(0); PG8_MMA(0, 1, At, B1); PG8_BAR;
            PG8_LDA(At, 1, 1); PG8_STAGE(PG8_SA(1, 0), a3, voffA);
            PG8_BAR; PG8_WAIT_L(0); PG8_MMA(1, 0, At, B0); PG8_BAR; PG8_SCHED;
            PG8_STAGE(PG8_SB(1, 1), b3 + hstep, voffB);
            PG8_WAIT_V(6); PG8_BAR; PG8_MMA(1, 1, At, B1); PG8_BAR;
            }
        }
        if constexpr (ALIGN_EPI) { if (wr == 0) PG8_BAR; }
        if constexpr (!Epi::AFTER_DRAIN) { E(acc, cur, wr, wc, fr, fq); S.done(cur); }
        if (!has_next) break;
#pragma unroll
        for (int a = 0; a < 2; ++a)
#pragma unroll
            for (int b = 0; b < 2; ++b)
#pragma unroll
                for (int m = 0; m < 4; ++m)
#pragma unroll
                    for (int n = 0; n < 2; ++n) acc[a][b][m][n] = (f32x4){0.f, 0.f, 0.f, 0.f};
        cur = nxt; cA = nA; cB = nB; ++ui;
        if constexpr (ALIGN_EPI) { if (wr == 1) PG8_BAR; }
    }
    PG8_WAIT_V(0);
    if constexpr (!ALIGN_EPI) { if (wr == 0) PG8_BAR; }
    PG8_BAR;
    if constexpr (Epi::AFTER_DRAIN) { E.fused(acc, cur, wr, wc, fr, fq, lds, wid, lane); S.done(cur); }
#undef PG8_SA
#undef PG8_SB
#undef PG8_STAGE
#undef PG8_LDA
#undef PG8_LDB
#undef PG8_MMA
#undef PG8_WAIT_V
#undef PG8_WAIT_L
#undef PG8_BAR
#undef PG8_SCHED
}
}
#define LAS __attribute__((address_space(3)))
#define XB_TMO      128
#define XB_XCNT(j)  (256  + 64 * (j))
#define XB_XSUB(j)  (1280 + 64 * (j))
#define XB_XGEN(j)  (2304 + 64 * (j))
#define XB_TOP      3328
#define XB_TOPGEN   3392
#define XCD_BAR_WORDS 3456
#define XB_SPIN_CAP (1u << 18)

__device__ __forceinline__ unsigned xb_ld(unsigned* p)              { return __hip_atomic_load(p, __ATOMIC_RELAXED, __HIP_MEMORY_SCOPE_AGENT); }
__device__ __forceinline__ unsigned xb_add(unsigned* p, unsigned v) { return __hip_atomic_fetch_add(p, v, __ATOMIC_RELAXED, __HIP_MEMORY_SCOPE_AGENT); }
__device__ __forceinline__ unsigned xb_xcc_id() { return (unsigned)__builtin_amdgcn_s_getreg((3 << 11) | 20) & 0xFu; }
#define XB_SPIN(cond, bar) do { unsigned _sp = 0; while (cond) { __builtin_amdgcn_s_sleep(1); \
    if ((++_sp & 255u) == 0u) { if (xb_ld(&(bar)[XB_TMO])) break; if (_sp > XB_SPIN_CAP) { atomicAdd(&(bar)[XB_TMO], 1u); break; } } } } while (0)

struct XcdBarrier {
    unsigned* bar; unsigned x; int wv;
    volatile LAS unsigned* st;
};

__device__ __forceinline__ bool xb_thread0(int wv) { return wv == 0 && lane_id_fresh() == 0; }
__device__ __forceinline__ XcdBarrier xcd_barrier_post(unsigned* bar, volatile LAS unsigned* st, int wv) {
    XcdBarrier b; b.bar = bar; b.x = xb_xcc_id(); b.st = st; b.wv = wv;
    if (xb_thread0(wv)) (void)xb_add(&bar[XB_XCNT(b.x)], 1u);
    return b;
}
__device__ __forceinline__ void xcd_barrier_complete(unsigned* bar, unsigned x, unsigned& nloc, unsigned& nx) {
    const unsigned G = gridDim.x * gridDim.y * gridDim.z;
    unsigned sum, cnt, mine, sp = 0u;
    for (;;) {
        sum = 0u; cnt = 0u; mine = 0u;
#pragma unroll
        for (unsigned j = 0; j < 16; ++j) { const unsigned c = xb_ld(&bar[XB_XCNT(j)]); sum += c; cnt += (c > 0u) ? 1u : 0u; mine = (j == x) ? c : mine; }
        if (sum == G) break;
        __builtin_amdgcn_s_sleep(1);
        if ((++sp & 255u) == 0u) { if (xb_ld(&bar[XB_TMO])) break; if (sp > XB_SPIN_CAP) { atomicAdd(&bar[XB_TMO], 1u); break; } }
    }
    nloc = mine > 0u ? mine : 1u; nx = cnt > 0u ? cnt : 1u;
}

__device__ __forceinline__ void xcd_barrier(const XcdBarrier& b) {
    asm volatile("s_waitcnt vmcnt(0)" ::: "memory");
    __syncthreads();
    if (xb_thread0(b.wv)) {
        unsigned* bar = b.bar;
        __builtin_amdgcn_s_waitcnt(0);
        unsigned nloc = b.st[0], nx = b.st[1];
        if (nloc == 0u) { xcd_barrier_complete(bar, b.x, nloc, nx); b.st[0] = nloc; b.st[1] = nx; }
        const unsigned old = xb_add(&bar[XB_XSUB(b.x)], 1u);
        const unsigned gen = old / nloc;
        if (old + 1u == (gen + 1u) * nloc) {
            __builtin_amdgcn_fence(__ATOMIC_RELEASE, "agent");
            asm volatile("s_waitcnt vmcnt(0)" ::: "memory");
            const unsigned og = xb_add(&bar[XB_TOP], 1u);
            const unsigned tg = og / nx;
            if (og + 1u == (tg + 1u) * nx) xb_add(&bar[XB_TOPGEN], 1u);
            else XB_SPIN(xb_ld(&bar[XB_TOPGEN]) == tg, bar);
            __builtin_amdgcn_fence(__ATOMIC_ACQUIRE, "agent");
            xb_add(&bar[XB_XGEN(b.x)], 1u);
            asm volatile("s_waitcnt vmcnt(0)" ::: "memory");
        } else {
            XB_SPIN(xb_ld(&bar[XB_XGEN(b.x)]) == gen, bar);
            __builtin_amdgcn_fence(__ATOMIC_ACQUIRE, "agent");
            asm volatile("s_waitcnt vmcnt(0)" ::: "memory");
        }
    }
    __syncthreads();
}

#undef LAS
#define GAS __attribute__((address_space(1)))
#define LAS __attribute__((address_space(3)))
typedef unsigned short bf16;
typedef unsigned v4u __attribute__((ext_vector_type(4)));
typedef unsigned v2u __attribute__((ext_vector_type(2)));
typedef float f32x4 __attribute__((ext_vector_type(4)));
#define LDS_WAIT() asm volatile("s_waitcnt lgkmcnt(0)" ::: "memory")
#define VM_WAIT() asm volatile("s_waitcnt vmcnt(0)" ::: "memory")
__device__ __forceinline__ unsigned f2bf(float f) { unsigned u = __builtin_bit_cast(unsigned, f); return (u + 0x7fffu + ((u >> 16) & 1u)) >> 16; }
__device__ __forceinline__ unsigned pk2(float lo, float hi) { return f2bf(lo) | (f2bf(hi) << 16); }
__device__ __forceinline__ float bf_lo(unsigned w) { return __uint_as_float(w << 16); }
__device__ __forceinline__ float bf_hi(unsigned w) { return __uint_as_float(w & 0xffff0000u); }

constexpr int NWAVES = 8, NTHR = 512;
constexpr int RING_BYTES = 131072, LDSCTL_OFF = RING_BYTES, LDS_BYTES = 147456;
constexpr size_t WL_STRIDE = 26 * MiB, WL_IN = 0, WL_OUT = 6 * MiB, WL_GU = 8 * MiB, WL_DOWN = 19 * MiB, WL_CW2 = 24 * MiB + 512 * 1024, WL_CW1 = 25 * MiB;
constexpr size_t WS_SS = 9 * MiB;
constexpr int L_RF = LDSCTL_OFF + 2048;
constexpr size_t WS_B2 = 600 * 1024;
constexpr size_t WS_CB1P = 704 * 1024;
constexpr size_t WS_CB1 = 512 * 1024;
constexpr int CW_BAR = 1024, CW_Q = 8192;
static_assert(WS_W + 4 * WL_STRIDE <= WS_END, "weights fit");

enum { PH_PROJ = 0, PH_PREP = 1, PH_ATT = 2, PH_GN = 3, PH_WOUT = 4, PH_NORM2 = 5, PH_GU = 6, PH_DOWN = 7, PH_NORM3 = 8, NPH = 9 };
struct MArgs { const float* in[20]; float* out; unsigned char* ws; int lay_lo, lay_hi, ph_lo, ph_hi; int do_pro, use_bar, att_mask, pad; };

struct Frame { LAS unsigned char* lds; int tid, lane, wave, gw, NGW; };
typedef const __attribute__((address_space(4))) unsigned char* kargp_t;
__device__ __forceinline__ kargp_t kargp() { kargp_t p = (kargp_t)__builtin_amdgcn_kernarg_segment_ptr(); asm volatile("" : "+s"(p)); return p; }
#define KIN(i) (*(const float* const __attribute__((address_space(4)))*)(kargp() + 8 * (i)))
#define KOUT (*(float* const __attribute__((address_space(4)))*)(kargp() + 160))
#define KWS (*(unsigned char* const __attribute__((address_space(4)))*)(kargp() + 168))
#define KINT(k) (*(const int __attribute__((address_space(4)))*)(kargp() + 176 + 4 * (k)))
static_assert(sizeof(MArgs) == 208, "MArgs layout");

__device__ __forceinline__ int maprow(int code, int n) {
    switch (code) {
        case 1: return n < 1280 ? n : n < 1284 ? n + 1280 : n < 2564 ? n - 4 : n;
        case 2: return (n >> 7) * 256 + (n & 127);
        case 3: return (n >> 7) * 256 + 128 + (n & 127);
        default: return n;
    }
}
struct TrDesc { const float* W; int K, N; bf16* WT; int code; const float* ks; int item; };
__device__ __forceinline__ void tr_load(const TrDesc& d, f32x4 (&v)[8], int lane) {
    const int nblk = (d.N + 31) / 32, kb = d.item / nblk, nb = d.item % nblk, k0 = 64 * kb, n0 = 32 * nb;
    const int n4 = (lane & 7) * 4, nn = n0 + n4;
#pragma unroll
    for (int i = 0; i < 8; ++i) { const int kk = 8 * i + (lane >> 3);
        v[i] = nn < d.N ? *(const GAS f32x4*)(d.W + (size_t)(k0 + kk) * d.N + nn) : (f32x4){0.f, 0.f, 0.f, 0.f};
        if (d.ks) v[i] = v[i] * d.ks[k0 + kk]; }
}
__device__ __forceinline__ void tr_finish(const TrDesc& d, const f32x4 (&v)[8], LAS float* scr, int lane) {
    const int nblk = (d.N + 31) / 32, kb = d.item / nblk, nb = d.item % nblk, k0 = 64 * kb, n0 = 32 * nb;
    const int n4 = (lane & 7) * 4;
#pragma unroll
    for (int i = 0; i < 8; ++i) { const int kk = 8 * i + (lane >> 3);
        scr[kk * 33 + n4] = v[i].x; scr[kk * 33 + n4 + 1] = v[i].y; scr[kk * 33 + n4 + 2] = v[i].z; scr[kk * 33 + n4 + 3] = v[i].w; }
    LDS_WAIT(); asm volatile("" ::: "memory");
    const int c = lane & 7;
#pragma unroll
    for (int j = 0; j < 4; ++j) { const int n = (lane >> 3) + 8 * j; const LAS float* s = scr + (8 * c) * 33 + n;
        v4u o; o.x = pk2(s[0 * 33], s[1 * 33]); o.y = pk2(s[2 * 33], s[3 * 33]); o.z = pk2(s[4 * 33], s[5 * 33]); o.w = pk2(s[6 * 33], s[7 * 33]);
        if (n0 + n < d.N) *(GAS v4u*)(d.WT + (size_t)maprow(d.code, n0 + n) * d.K + k0 + 8 * c) = o; }
    LDS_WAIT(); asm volatile("" ::: "memory");
}

__device__ __forceinline__ void pro_a(const Frame& F) {
    unsigned char* ws = KWS;
    {
        LAS float* ca = (LAS float*)F.lds;
        LAS float* red = (LAS float*)(F.lds + 32768);
        const float* c = KIN(1);
        for (int i = F.tid; i < 8192; i += NTHR) { const float v = c[i]; ca[i] = v / (1.f + __expf(-v)); }
        __syncthreads();
        float* mod = (float*)(ws + WS_MOD);
        for (int task = blockIdx.x; task < DEPTH * 96; task += gridDim.x) {
            const int l = task / 96, n0 = (task % 96) * 64;
            const int cg = F.lane & 15, kq = F.lane >> 4;
            const float* w = KIN(3) + (size_t)l * 1024 * 6144 + n0 + 4 * cg;
            f32x4 acc[8];
#pragma unroll
            for (int b = 0; b < 8; ++b) acc[b] = (f32x4){0.f, 0.f, 0.f, 0.f};
            const int kb = F.wave * 128 + kq;
#pragma unroll 8
            for (int i = 0; i < 32; ++i) { const int k = kb + 4 * i; const f32x4 wv = *(const GAS f32x4*)(w + (size_t)k * 6144);
#pragma unroll
                for (int b = 0; b < 8; ++b) acc[b] += wv * ca[b * 1024 + k]; }
#pragma unroll
            for (int b = 0; b < 8; ++b)
#pragma unroll
                for (int e = 0; e < 4; ++e) { float v = acc[b][e]; v += __shfl_xor(v, 16); v += __shfl_xor(v, 32); if (kq == 0) red[(F.wave * 8 + b) * 64 + 4 * cg + e] = v; }
            __syncthreads();
            { const int b = F.tid >> 6, n = F.tid & 63; float s = 0.f;
#pragma unroll
              for (int wv = 0; wv < 8; ++wv) s += red[(wv * 8 + b) * 64 + n];
              mod[(size_t)(l * 8 + b) * 6144 + n0 + n] = s + KIN(4)[l * 6144 + n0 + n]; }
            __syncthreads();
        }
    }
    {
        LAS float* scr = (LAS float*)(F.lds + F.wave * 16384);
        constexpr int I_IN = 16 * 81, I_OUT = 16 * 32, I_G = 16 * 88, I_D = 44 * 32, I_C1 = 32 * 4, I_C2 = 2 * 2;
        constexpr int PER_L = I_IN + I_OUT + 2 * I_G + I_D + 2 * I_C1 + 2 * I_C2;
        auto decode = [&](int it, TrDesc& d) {
            const int l = it / PER_L; int r = it % PER_L;
            unsigned char* wl = ws + WS_W + (size_t)l * WL_STRIDE;
            if (r < I_IN) { d = TrDesc{KIN(9) + (size_t)l * DM * NIN, DM, NIN, (bf16*)(wl + WL_IN), 1, nullptr, r}; return; } r -= I_IN;
            if (r < I_OUT) { d = TrDesc{KIN(16) + (size_t)l * DM * DM, DM, DM, (bf16*)(wl + WL_OUT), 0, KIN(15) + l * DM, r}; return; } r -= I_OUT;
            if (r < I_G) { d = TrDesc{KIN(17) + (size_t)l * DM * FFN, DM, FFN, (bf16*)(wl + WL_GU), 2, nullptr, r}; return; } r -= I_G;
            if (r < I_G) { d = TrDesc{KIN(18) + (size_t)l * DM * FFN, DM, FFN, (bf16*)(wl + WL_GU), 3, nullptr, r}; return; } r -= I_G;
            if (r < I_D) { d = TrDesc{KIN(19) + (size_t)l * FFN * DM, FFN, DM, (bf16*)(wl + WL_DOWN), 0, nullptr, r}; return; } r -= I_D;
            if (r < 2 * I_C1) { const int kv = r / I_C1; d = TrDesc{KIN(13) + (size_t)(l * 2 + kv) * 2048 * 128, 2048, 128, (bf16*)(wl + WL_CW1) + (size_t)kv * 128 * 2048, 0, nullptr, r % I_C1}; return; } r -= 2 * I_C1;
            { const int kv = r / I_C2; d = TrDesc{KIN(14) + (size_t)(l * 2 + kv) * 128 * 64, 128, 64, (bf16*)(wl + WL_CW2) + (size_t)kv * 64 * 128, 0, nullptr, r % I_C2}; }
        };
        for (int it = F.gw; it < DEPTH * PER_L; it += 2 * F.NGW) {
            const bool two = it + F.NGW < DEPTH * PER_L;
            TrDesc da, db; decode(it, da); decode(two ? it + F.NGW : it, db);
            f32x4 va[8], vb[8]; tr_load(da, va, F.lane); if (two) tr_load(db, vb, F.lane);
            tr_finish(da, va, scr, F.lane); if (two) tr_finish(db, vb, scr, F.lane);
        }
        for (int it = F.gw; it < DEPTH * 228; it += F.NGW) { const int l = it / 228, row = NIN + it % 228;
            GAS v4u* p = (GAS v4u*)(ws + WS_W + (size_t)l * WL_STRIDE + WL_IN + (size_t)row * DM * 2);
            p[F.lane] = (v4u){0u, 0u, 0u, 0u}; p[64 + F.lane] = (v4u){0u, 0u, 0u, 0u}; }
        { const int gt = blockIdx.x * NTHR + F.tid;
          if (gt < 12 * 1152) { const int hd = gt / 1152, dist = gt % 1152; ((float*)(ws + WS_B2))[gt] = KIN(2)[t5_bucket(dist) * 12 + hd] * LOG2E; } }
        { LAS float* red = (LAS float*)(F.lds + 12288);
          for (int task = blockIdx.x; task < DEPTH * 2 * 32; task += gridDim.x) {
              const int lk = task >> 5, i0 = (task & 31) * 64 + (F.tid >> 7) * 16, j = F.tid & 127;
              const float* pe = KIN(12) + (size_t)lk * 2048 + i0; const float* w1 = KIN(13) + ((size_t)lk * 2048 + i0) * 128 + j; float s = 0.f;
#pragma unroll
              for (int i = 0; i < 16; ++i) s += pe[i] * w1[(size_t)i * 128];
              __syncthreads(); red[F.tid] = s; __syncthreads();
              if (F.tid < 128) ((float*)(ws + WS_CB1P))[(size_t)task * 128 + F.tid] = (red[F.tid] + red[128 + F.tid]) + (red[256 + F.tid] + red[384 + F.tid]); } }
    }
}
__device__ __forceinline__ void cb1_finish(const Frame& F) {
    unsigned char* ws = KWS;
    const int gt = blockIdx.x * NTHR + F.tid;
    if (gt < DEPTH * 2 * 128) { const int j = gt & 127, lk = gt >> 7; const float* pp = (const float*)(ws + WS_CB1P) + (size_t)lk * 32 * 128 + j; float s = 0.f;
#pragma unroll
        for (int c = 0; c < 32; ++c) s += pp[c * 128];
        ((float*)(ws + WS_CB1))[gt] = s; }
}

__device__ __forceinline__ void norm_phase(const Frame& F, const float* xin, const bf16* y, const float* g_post, const float* mod_post, int gate_chunk,
                                           const bf16* y2, const float* g_post2, int gate_chunk2, float* xout,
                                           const float* g_pre, const float* mod_pre, int scale_chunk, int shift_chunk, bf16* h, const bf16* xin16 = nullptr, bf16* xout16 = nullptr) {
    const size_t x16 = (size_t)F.gw * 32768 + 16384;
    const int row0 = F.gw * 16, b = row0 / SEQ;
    const f32x4 z4 = {0.f, 0.f, 0.f, 0.f};
    f32x4 gg[4], gg2[4], gqs[4], sh[4];
#pragma unroll
    for (int j = 0; j < 4; ++j) { const int col = j * 256 + F.lane * 4;
        gg[j] = y ? *(const GAS f32x4*)(mod_post + (size_t)b * 6144 + gate_chunk * 1024 + col) * *(const GAS f32x4*)(g_post + col) : z4;
        gg2[j] = y2 ? *(const GAS f32x4*)(mod_post + (size_t)b * 6144 + gate_chunk2 * 1024 + col) * *(const GAS f32x4*)(g_post2 + col) : z4;
        gqs[j] = h ? *(const GAS f32x4*)(g_pre + col) * (*(const GAS f32x4*)(mod_pre + (size_t)b * 6144 + scale_chunk * 1024 + col) + 1.f) : z4;
        sh[j] = h ? *(const GAS f32x4*)(mod_pre + (size_t)b * 6144 + shift_chunk * 1024 + col) : z4; }
    struct Raw { v2u ya[4], yb[4], y2a[4], y2b[4], xa[4], xb[4]; };
    auto fetch = [&](int i, Raw& r) {
        const size_t oa = (size_t)(row0 + i) * DM + F.lane * 4, ob = oa + DM;
#pragma unroll
        for (int j = 0; j < 4; ++j) {
            if (y) { r.ya[j] = *(const GAS v2u*)(y + oa + j * 256); r.yb[j] = *(const GAS v2u*)(y + ob + j * 256); }
            if (y2) { r.y2a[j] = *(const GAS v2u*)(y2 + oa + j * 256); r.y2b[j] = *(const GAS v2u*)(y2 + ob + j * 256); }
            if (xin16) { r.xa[j] = *(const GAS v2u*)(xin16 + x16 + (size_t)i * DM + j * 256 + F.lane * 4); r.xb[j] = *(const GAS v2u*)(xin16 + x16 + (size_t)(i + 1) * DM + j * 256 + F.lane * 4); } }
    };
    auto unpk = [](const v2u& w) { return (f32x4){bf_lo(w.x), bf_hi(w.x), bf_lo(w.y), bf_hi(w.y)}; };
    auto process = [&](int i, const Raw& r) {
        const int rowa = row0 + i, rowb = rowa + 1;
        f32x4 va[4], vb[4], ua[4], ub[4];
#pragma unroll
        for (int j = 0; j < 4; ++j) {
            if (xin16) { va[j] = unpk(r.xa[j]); vb[j] = unpk(r.xb[j]); }
            else { va[j] = *(const GAS f32x4*)(xin + (size_t)rowa * DM + j * 256 + F.lane * 4); vb[j] = *(const GAS f32x4*)(xin + (size_t)rowb * DM + j * 256 + F.lane * 4); } }
        auto add_branch = [&](const v2u (&wa)[4], const v2u (&wb)[4], const f32x4 (&g)[4]) {
            float ssa = 0.f, ssb = 0.f;
#pragma unroll
            for (int j = 0; j < 4; ++j) { ua[j] = unpk(wa[j]); ssa += (ua[j].x * ua[j].x + ua[j].y * ua[j].y) + (ua[j].z * ua[j].z + ua[j].w * ua[j].w);
                ub[j] = unpk(wb[j]); ssb += (ub[j].x * ub[j].x + ub[j].y * ub[j].y) + (ub[j].z * ub[j].z + ub[j].w * ub[j].w); }
            const float ra = rsqrtf(wave_sum(ssa) * (1.f / DM) + RMS_EPS), rb = rsqrtf(wave_sum(ssb) * (1.f / DM) + RMS_EPS);
#pragma unroll
            for (int j = 0; j < 4; ++j) { va[j] += g[j] * (ua[j] * ra); vb[j] += g[j] * (ub[j] * rb); }
        };
        if (y) add_branch(r.ya, r.yb, gg);
        if (y2) add_branch(r.y2a, r.y2b, gg2);
        if (xout16) {
#pragma unroll
            for (int j = 0; j < 4; ++j) { v2u wa, wb; wa.x = pk2(va[j].x, va[j].y); wa.y = pk2(va[j].z, va[j].w); wb.x = pk2(vb[j].x, vb[j].y); wb.y = pk2(vb[j].z, vb[j].w);
                *(GAS v2u*)(xout16 + x16 + (size_t)i * DM + j * 256 + F.lane * 4) = wa; *(GAS v2u*)(xout16 + x16 + (size_t)(i + 1) * DM + j * 256 + F.lane * 4) = wb;
                va[j] = unpk(wa); vb[j] = unpk(wb); }
        } else if (xout) {
#pragma unroll
            for (int j = 0; j < 4; ++j) { *(GAS f32x4*)(xout + (size_t)rowa * DM + j * 256 + F.lane * 4) = va[j]; *(GAS f32x4*)(xout + (size_t)rowb * DM + j * 256 + F.lane * 4) = vb[j]; }
        }
        if (h) {
            float ssa = 0.f, ssb = 0.f;
#pragma unroll
            for (int j = 0; j < 4; ++j) { ssa += (va[j].x * va[j].x + va[j].y * va[j].y) + (va[j].z * va[j].z + va[j].w * va[j].w); ssb += (vb[j].x * vb[j].x + vb[j].y * vb[j].y) + (vb[j].z * vb[j].z + vb[j].w * vb[j].w); }
            const float ra = rsqrtf(wave_sum(ssa) * (1.f / DM) + RMS_EPS), rb = rsqrtf(wave_sum(ssb) * (1.f / DM) + RMS_EPS);
#pragma unroll
            for (int j = 0; j < 4; ++j) { const int col = j * 256 + F.lane * 4;
                const f32x4 oa = va[j] * ra * gqs[j] + sh[j]; v2u w; w.x = pk2(oa.x, oa.y); w.y = pk2(oa.z, oa.w); *(GAS v2u*)(h + (size_t)rowa * DM + col) = w;
                const f32x4 ob = vb[j] * rb * gqs[j] + sh[j]; v2u w2; w2.x = pk2(ob.x, ob.y); w2.y = pk2(ob.z, ob.w); *(GAS v2u*)(h + (size_t)rowb * DM + col) = w2; }
        }
    };
    Raw ra0, ra1; fetch(0, ra0);
    for (int i = 0; i < 16; i += 4) {
        fetch(i + 2, ra1); process(i, ra0);
        if (i + 4 < 16) fetch(i + 4, ra0);
        process(i + 2, ra1);
    }
}
__device__ __forceinline__ void groupnorm_phase(const Frame& F, bf16* O, const float* gn) {
    for (int row = F.gw; row < M; row += F.NGW) {
        f32x4 v[4]; float ss[4];
#pragma unroll
        for (int j = 0; j < 4; ++j) { const v2u w = *(const GAS v2u*)(O + (size_t)row * DM + j * 256 + F.lane * 4);
            v[j] = (f32x4){bf_lo(w.x), bf_hi(w.x), bf_lo(w.y), bf_hi(w.y)}; ss[j] = (v[j].x * v[j].x + v[j].y * v[j].y) + (v[j].z * v[j].z + v[j].w * v[j].w); }
        const float r0 = rsqrtf(wave_sum(ss[0]) * (1.f / 256.f) + RMS_EPS), r1 = rsqrtf(wave_sum(ss[1]) * (1.f / 256.f) + RMS_EPS), r2 = rsqrtf(wave_sum(ss[2] + ss[3]) * (1.f / 512.f) + RMS_EPS);
#pragma unroll
        for (int j = 0; j < 4; ++j) { const float r = j == 0 ? r0 : j == 1 ? r1 : r2; const int col = j * 256 + F.lane * 4;
            const f32x4 o = v[j] * r * *(const GAS f32x4*)(gn + col);
            v2u w; w.x = pk2(o.x, o.y); w.y = pk2(o.z, o.w);
            *(GAS v2u*)(O + (size_t)row * DM + col) = w; }
    }
}

namespace pg8 {
__device__ __forceinline__ f32x4 smul(const f32x4& a, float s) {
    float z = 0.f; asm("" : "+v"(z));
    return (f32x4){a[0] * s, __builtin_fmaf(a[1], s, z), a[2] * s, __builtin_fmaf(a[3], s, z)}; }
struct EpiProj {
    static constexpr bool PERM = true, AFTER_DRAIN = false;
    bf16_t* proj; float* logf; float* gates; const float* fbias;
    __device__ __forceinline__ void operator()(const f32x4 (&acc)[2][2][4][2], const Unit& u, int wr, int wc, int fr, int fq) const {
        const int row0 = u.pm * BM + wr * 64 + fr;
        {
            const float sc = (u.pn == 0 || u.pn == 2 || u.pn == 5 || u.pn == 6) ? QSCALE : 1.f;
            const int col0 = u.pn * BM + wc * 32 + 8 * fq;
#pragma unroll
            for (int ai = 0; ai < 2; ++ai)
#pragma unroll
                for (int m = 0; m < 4; ++m) { bf16_t* rowp = proj + (size_t)(row0 + ai * HALF + m * 16) * NPROJ + col0;
#pragma unroll
                    for (int bj = 0; bj < 2; ++bj) { const f32x4 v0 = smul(acc[ai][bj][m][0], sc), v1 = smul(acc[ai][bj][m][1], sc);
                        u32x4 w; w.x = cvt_pk_bf16(v0[0], v0[1]); w.y = cvt_pk_bf16(v0[2], v0[3]); w.z = cvt_pk_bf16(v1[0], v1[1]); w.w = cvt_pk_bf16(v1[2], v1[3]);
                        *(u32x4*)(rowp + bj * HALF) = w; } }
        }
    }
};
struct EpiY {
    static constexpr bool PERM = true, AFTER_DRAIN = false;
    bf16_t* out; int ldc;
    __device__ __forceinline__ void operator()(const f32x4 (&acc)[2][2][4][2], const Unit& u, int wr, int wc, int fr, int fq) const {
        const int row0 = u.pm * BM + wr * 64 + fr, col0 = u.pn * BM + wc * 32 + 8 * fq;
#pragma unroll
        for (int ai = 0; ai < 2; ++ai)
#pragma unroll
            for (int m = 0; m < 4; ++m) { bf16_t* rowp = out + (size_t)(row0 + ai * HALF + m * 16) * ldc + col0;
#pragma unroll
                for (int bj = 0; bj < 2; ++bj) { const f32x4 v0 = acc[ai][bj][m][0], v1 = acc[ai][bj][m][1];
                    u32x4 w; w.x = cvt_pk_bf16(v0[0], v0[1]); w.y = cvt_pk_bf16(v0[2], v0[3]); w.z = cvt_pk_bf16(v1[0], v1[1]); w.w = cvt_pk_bf16(v1[2], v1[3]);
                    *(u32x4*)(rowp + bj * HALF) = w; } }
    }
};
struct GnHook { static constexpr bool ACTIVE = true; static constexpr int T1 = 4, T2 = 8;
    const PG8_LAS f32x4* rf;
    __device__ __forceinline__ void apply(f32x4 (&acc)[2][2][4][2], int t, int ui, int wr, int fr) const {
#pragma unroll
        for (int ai = 0; ai < 2; ++ai)
#pragma unroll
            for (int m = 0; m < 4; ++m) { const f32x4 f = rf[(ui & 1) * 256 + ai * HALF + wr * 64 + m * 16 + fr]; const float sc = (t == T1) ? f[0] : f[1];
#pragma unroll
                for (int bj = 0; bj < 2; ++bj)
#pragma unroll
                    for (int n = 0; n < 2; ++n) acc[ai][bj][m][n] = smul(acc[ai][bj][m][n], sc); }
    }
};
struct EpiYGn {
    static constexpr bool PERM = true, AFTER_DRAIN = false;
    bf16_t* out; int ldc; const PG8_LAS f32x4* rf; int pm0;
    __device__ __forceinline__ void operator()(const f32x4 (&acc)[2][2][4][2], const Unit& u, int wr, int wc, int fr, int fq) const {
        const int row0 = u.pm * BM + wr * 64 + fr, col0 = u.pn * BM + wc * 32 + 8 * fq; const int slot = (u.pm == pm0) ? 0 : 256;
#pragma unroll
        for (int ai = 0; ai < 2; ++ai)
#pragma unroll
            for (int m = 0; m < 4; ++m) { bf16_t* rowp = out + (size_t)(row0 + ai * HALF + m * 16) * ldc + col0; const float sc = rf[slot + ai * HALF + wr * 64 + m * 16 + fr][2];
#pragma unroll
                for (int bj = 0; bj < 2; ++bj) { const f32x4 v0 = smul(acc[ai][bj][m][0], sc), v1 = smul(acc[ai][bj][m][1], sc);
                    u32x4 w; w.x = cvt_pk_bf16(v0[0], v0[1]); w.y = cvt_pk_bf16(v0[2], v0[3]); w.z = cvt_pk_bf16(v1[0], v1[1]); w.w = cvt_pk_bf16(v1[2], v1[3]);
                    *(u32x4*)(rowp + bj * HALF) = w; } }
    }
};
struct EpiSwiglu {
    static constexpr bool PERM = true, AFTER_DRAIN = false;
    bf16_t* out;
    __device__ __forceinline__ void operator()(const f32x4 (&acc)[2][2][4][2], const Unit& u, int wr, int wc, int fr, int fq) const {
        const int row0 = u.pm * BM + wr * 64 + fr, col0 = u.pn * HALF + wc * 32 + 8 * fq;
#pragma unroll
        for (int ai = 0; ai < 2; ++ai)
#pragma unroll
            for (int m = 0; m < 4; ++m) { float o[8];
#pragma unroll
                for (int n = 0; n < 2; ++n)
#pragma unroll
                    for (int e = 0; e < 4; ++e) { const float g = acc[ai][0][m][n][e], up = acc[ai][1][m][n][e]; o[4 * n + e] = g * __builtin_amdgcn_rcpf(1.f + __expf(-g)) * up; }
                u32x4 w; w.x = cvt_pk_bf16(o[0], o[1]); w.y = cvt_pk_bf16(o[2], o[3]); w.z = cvt_pk_bf16(o[4], o[5]); w.w = cvt_pk_bf16(o[6], o[7]);
                *(u32x4*)(out + (size_t)(row0 + ai * HALF + m * 16) * FFN + col0) = w; }
    }
};
}
namespace att {
typedef short bf16x8 __attribute__((ext_vector_type(8)));
typedef short s16x4 __attribute__((ext_vector_type(4)));
typedef short v4i16_t __attribute__((ext_vector_type(4)));
typedef float f32x16 __attribute__((ext_vector_type(16)));
typedef float f32x2_t __attribute__((ext_vector_type(2)));
typedef __bf16 bf16x2_t __attribute__((ext_vector_type(2)));
typedef LAS const char* lcp;
constexpr int L_K = 0, L_V = 16384, L_AUX = 32768;
constexpr float NEG_INF = -__builtin_inff();
constexpr float SM_THR = 8.f;
struct St { float m, l; f32x16 o0, o1; };

__device__ __forceinline__ unsigned cvtpk(float lo, float hi) { f32x2_t v = {lo, hi}; bf16x2_t b = __builtin_convertvector(v, bf16x2_t); return __builtin_bit_cast(unsigned, b); }
__device__ __forceinline__ float ex2(float x) { return __builtin_amdgcn_exp2f(x); }
__device__ __forceinline__ float xhalf_max(float m) { auto rr = __builtin_amdgcn_permlane32_swap(__float_as_uint(m), __float_as_uint(m), false, false); return fmaxf(__uint_as_float(rr[0]), __uint_as_float(rr[1])); }
__device__ __forceinline__ float xhalf_sum(float m) { auto rr = __builtin_amdgcn_permlane32_swap(__float_as_uint(m), __float_as_uint(m), false, false); return __uint_as_float(rr[0]) + __uint_as_float(rr[1]); }
#define ATT_WAIT_BAR(N) asm volatile("s_waitcnt vmcnt(" #N ") lgkmcnt(0)\n\ts_barrier" ::: "memory")
#define ATT_BAR() asm volatile("s_waitcnt lgkmcnt(0)\n\ts_barrier" ::: "memory")

__device__ __forceinline__ void glds16(const void* gsrc, unsigned lds_dst) { unsigned keep;
    asm volatile("s_mov_b32 %0, m0\n\ts_mov_b32 m0, %2\n\ts_nop 0\n\tglobal_load_lds_dwordx4 %1, off\n\ts_mov_b32 m0, %0" : "=&s"(keep) : "v"(gsrc), "s"(lds_dst) : "memory"); }
__device__ __forceinline__ void dma_k(const bf16* Krow0, int pitch, LAS unsigned char* kbuf, int wid, int lane) {
    const bf16* src = Krow0 + (size_t)lane * pitch + 8 * wid;
    glds16(src, (unsigned)__builtin_amdgcn_readfirstlane((int)(unsigned)(uintptr_t)(kbuf + wid * 1024)));
}
__device__ __forceinline__ void dma_v(const bf16* Vrow0, int pitch, LAS unsigned char* vbuf, int wid, int lane) {
    const bf16* src = Vrow0 + (size_t)(16 * (wid & 3) + (lane >> 2)) * pitch + 32 * (wid >> 2) + 8 * (lane & 3);
    glds16(src, (unsigned)__builtin_amdgcn_readfirstlane((int)(unsigned)(uintptr_t)(vbuf + wid * 1024)));
}
__device__ __forceinline__ s16x4 vtr(lcp p) { return __builtin_bit_cast(s16x4, __builtin_amdgcn_ds_read_tr16_b64_v4i16((LAS v4i16_t*)p)); }


struct Pf { bf16x8 f[4]; };
__device__ __forceinline__ void load_kf(bf16x8 (&kf)[8], lcp kb, int r32, int hi) {
    lcp k0 = kb + hi * 1024 + r32 * 16;
#pragma unroll
    for (int d0 = 0; d0 < 4; ++d0) { kf[2 * d0] = *(const LAS bf16x8*)(k0 + d0 * 2048); kf[2 * d0 + 1] = *(const LAS bf16x8*)(k0 + d0 * 2048 + 512); }
}
__device__ __forceinline__ void load_vf(bf16x8 (&vf)[8], lcp vb, int lane, int hi) {
    lcp vp = vb + ((lane >> 4) & 1) * 32 + (lane & 3) * 8 + (4 * hi + ((lane & 15) >> 2)) * 64;
#pragma unroll
    for (int k = 0; k < 4; ++k) {
        const s16x4 a0 = vtr(vp + k * 1024), a1 = vtr(vp + k * 1024 + 512), b0 = vtr(vp + 4096 + k * 1024), b1 = vtr(vp + 4096 + k * 1024 + 512);
        vf[2 * k] = (bf16x8){a0[0], a0[1], a0[2], a0[3], a1[0], a1[1], a1[2], a1[3]}; vf[2 * k + 1] = (bf16x8){b0[0], b0[1], b0[2], b0[3], b1[0], b1[1], b1[2], b1[3]};
    }
}
__device__ __forceinline__ void qk_mfma(f32x16& p0, f32x16& p1, const bf16x8 (&kf)[8], const bf16x8 (&qf)[4]) {
#pragma unroll
    for (int d0 = 0; d0 < 4; ++d0) { p0 = __builtin_amdgcn_mfma_f32_32x32x16_bf16(kf[2 * d0], qf[d0], p0, 0, 0, 0); p1 = __builtin_amdgcn_mfma_f32_32x32x16_bf16(kf[2 * d0 + 1], qf[d0], p1, 0, 0, 0); }
}
__device__ __forceinline__ void pv_mfma(St& st, const bf16x8 (&vf)[8], const Pf& pf) {
#pragma unroll
    for (int k = 0; k < 4; ++k) { st.o0 = __builtin_amdgcn_mfma_f32_32x32x16_bf16(vf[2 * k], pf.f[k], st.o0, 0, 0, 0); st.o1 = __builtin_amdgcn_mfma_f32_32x32x16_bf16(vf[2 * k + 1], pf.f[k], st.o1, 0, 0, 0); }
}
__device__ __forceinline__ void pack_p(Pf& pf, const f32x16& p0, const f32x16& p1) {
    unsigned w[16];
#pragma unroll
    for (int i = 0; i < 8; ++i) { w[i] = cvtpk(p0[2 * i], p0[2 * i + 1]); w[8 + i] = cvtpk(p1[2 * i], p1[2 * i + 1]); }
#pragma unroll
    for (int k = 0; k < 4; ++k) { v4u t = {w[4 * k], w[4 * k + 1], w[4 * k + 2], w[4 * k + 3]}; pf.f[k] = __builtin_bit_cast(bf16x8, t); }
}
__device__ __forceinline__ void softmax(St& st, f32x16& p0, f32x16& p1, Pf& pf, bool live = true, float cadd = 0.f) {
    float mxa = fmaxf(p0[0], p1[0]), mxb = fmaxf(p0[1], p1[1]);
#pragma unroll
    for (int r = 2; r < 16; r += 2) { mxa = fmaxf(fmaxf(mxa, p0[r]), p1[r]); mxb = fmaxf(fmaxf(mxb, p0[r + 1]), p1[r + 1]); }
    float mx = xhalf_max(fmaxf(mxa, mxb)) + cadd;
    if (!live) mx = NEG_INF;
    const float mn = fmaxf(st.m, mx);
    if (__any(mn > st.m)) { const float f = ex2(st.m - mn); st.l *= f;
#pragma unroll
        for (int r = 0; r < 16; ++r) { st.o0[r] *= f; st.o1[r] *= f; }
        st.m = mn; }
    const float ms = live ? mn - cadd : -NEG_INF;
    float s = 0.f;
#pragma unroll
    for (int r = 0; r < 16; ++r) { p0[r] = ex2(p0[r] - ms); p1[r] = ex2(p1[r] - ms); s += p0[r] + p1[r]; }
    st.l += s;
    pack_p(pf, p0, p1);
}
__device__ __forceinline__ void st_init(St& st, float m0, float l0) { st.m = m0; st.l = l0;
#pragma unroll
    for (int r = 0; r < 16; ++r) { st.o0[r] = 0.f; st.o1[r] = 0.f; } }
__device__ __forceinline__ void store_o(bf16* obase, const f32x16& o0, const f32x16& o1, float sc, int lane, float* ssp, LAS unsigned char* stg) {
    const int r32 = lane & 31, hi = lane >> 5;
    float ss = 0.f;
#pragma unroll
    for (int a = 0; a < 4; ++a) {
        float v[8];
#pragma unroll
        for (int e = 0; e < 4; ++e) { v[e] = o0[4 * a + e] * sc; v[4 + e] = o1[4 * a + e] * sc; }
#pragma unroll
        for (int e = 0; e < 8; ++e) ss += v[e] * v[e];
        v2u w0, w1; w0.x = cvtpk(v[0], v[1]); w0.y = cvtpk(v[2], v[3]); w1.x = cvtpk(v[4], v[5]); w1.y = cvtpk(v[6], v[7]);
        *(LAS v2u*)(stg + r32 * 144 + (8 * a + 4 * hi) * 2) = w0; *(LAS v2u*)(stg + r32 * 144 + 64 + (8 * a + 4 * hi) * 2) = w1; }
    ss = xhalf_sum(ss);
    if (hi == 0) *ssp = ss;
    asm volatile("s_waitcnt lgkmcnt(0)" ::: "memory");
#pragma unroll
    for (int i = 0; i < 4; ++i) { const int row = 8 * i + (lane >> 3), ch = lane & 7; const v4u v = *(const LAS v4u*)(stg + row * 144 + ch * 16); *(GAS v4u*)(obase + (size_t)row * DM + ch * 8) = v; }
}
__device__ __forceinline__ int unit_fetch_issue(unsigned* ctr, int wv) {
    int v = 0;
    if (wv == 0 && lane_id_fresh() == 0) v = (int)__hip_atomic_fetch_add(ctr, 1u, __ATOMIC_RELAXED, __HIP_MEMORY_SCOPE_AGENT);
    return v;
}
__device__ __forceinline__ int unit_fetch_commit(int v, volatile LAS int* slot, int wv) {
    if (wv == 0 && lane_id_fresh() == 0) *slot = v;
    __syncthreads();
    const int r = *slot;
    __syncthreads();
    return r;
}
__device__ __forceinline__ int next_unit(unsigned* ctr, volatile LAS int* slot, int wv) {
    if (wv == 0 && lane_id_fresh() == 0) *slot = (int)__hip_atomic_fetch_add(ctr, 1u, __ATOMIC_RELAXED, __HIP_MEMORY_SCOPE_AGENT);
    __syncthreads();
    const int v = *slot;
    __syncthreads();
    return v;
}

template <int N> struct TabVals { float v[(N + NTHR - 1) / NTHR]; };
template <int N> __device__ __forceinline__ void tab_load(TabVals<N>& tv, int dmax, const float* b2, int col, int tid) {
#pragma unroll
    for (int it = 0; it < (N + NTHR - 1) / NTHR; ++it) { const int dist = dmax - (tid + it * NTHR); const int dc = dist < 0 ? 0 : dist > 1151 ? 1151 : dist; tv.v[it] = b2[col * 1152 + dc]; }
}
template <int N> __device__ __forceinline__ void tab_store(const TabVals<N>& tv, LAS float* T, int dmax, int lo, int hi, int tid) {
#pragma unroll
    for (int it = 0; it < (N + NTHR - 1) / NTHR; ++it) { const int i = tid + it * NTHR, dist = dmax - i; if (i < N) T[i] = (dist >= lo && dist < hi) ? tv.v[it] : NEG_INF; }
}
__device__ __forceinline__ void init_tab(f32x16& p0, f32x16& p1, const LAS float* tl) {
    asm volatile("" : "+v"(tl));
#pragma unroll
    for (int r = 0; r < 16; ++r) { p0[r] = tl[(r & 3) + 8 * (r >> 2)]; p1[r] = tl[32 + (r & 3) + 8 * (r >> 2)]; }
}
#define ATT_SCHED() __builtin_amdgcn_sched_barrier(0)
#ifndef HOIST_FOX
#define HOIST_FOX 1
#define HOIST_SWA 1
#define HOIST_CMP 0
#define HOIST_SLC 1
#endif
#ifndef STAG_FROM
#define STAG_FROM 4
#endif
#ifndef DMA_LATE
#define DMA_LATE 1
#endif
#ifndef SLC_ZC
#define SLC_ZC 1
#endif
#ifndef SLC_WINDOW
#define SLC_WINDOW 1
#endif
#ifndef STAG_FOX
#define STAG_FOX 1
#define STAG_SWA 1
#define STAG_CMP 1
#define STAG_SLC 1
#define STAG_WIN 1
#endif
__device__ __forceinline__ void load_k2(bf16x8 (&k2)[2], lcp kb, int d0, int r32, int hi) { lcp k0 = kb + hi * 1024 + r32 * 16 + d0 * 2048; k2[0] = *(const LAS bf16x8*)k0; k2[1] = *(const LAS bf16x8*)(k0 + 512); }
__device__ __forceinline__ void load_v2(bf16x8 (&v2)[2], lcp vb, int k, int lane, int hi) {
    lcp vp = vb + ((lane >> 4) & 1) * 32 + (lane & 3) * 8 + (4 * hi + ((lane & 15) >> 2)) * 64 + k * 1024;
    const s16x4 a0 = vtr(vp), a1 = vtr(vp + 512), b0 = vtr(vp + 4096), b1 = vtr(vp + 4096 + 512);
    v2[0] = (bf16x8){a0[0], a0[1], a0[2], a0[3], a1[0], a1[1], a1[2], a1[3]}; v2[1] = (bf16x8){b0[0], b0[1], b0[2], b0[3], b1[0], b1[1], b1[2], b1[3]};
}
template <int BASE, class Hook> __device__ __forceinline__ bf16x8 exp_chunk(const f32x16& c, float ms, float& s, Hook&& hook, int t, int k) {
    float e[8];
#pragma unroll
    for (int j = 0; j < 8; ++j) { e[j] = c[BASE + j] - ms; }
    float t0, t1, t2, t3;
    asm("v_exp_f32 %0, %0\n\tv_exp_f32 %1, %1\n\tv_exp_f32 %2, %2\n\tv_exp_f32 %3, %3\n\tv_exp_f32 %4, %4\n\tv_exp_f32 %5, %5\n\tv_exp_f32 %6, %6\n\tv_exp_f32 %7, %7\n\t"
        "v_add_f32 %8, %0, %1\n\tv_add_f32 %9, %2, %3\n\tv_add_f32 %10, %4, %5\n\tv_add_f32 %11, %6, %7\n\t"
        "v_add_f32 %8, %8, %9\n\tv_add_f32 %10, %10, %11\n\tv_add_f32 %8, %8, %10\n\tv_add_f32 %12, %12, %8"
        : "+v"(e[0]), "+v"(e[1]), "+v"(e[2]), "+v"(e[3]), "+v"(e[4]), "+v"(e[5]), "+v"(e[6]), "+v"(e[7]), "=&v"(t0), "=&v"(t1), "=&v"(t2), "=&v"(t3), "+v"(s));
    hook(t, k, e, ms);
    v4u w = {cvtpk(e[0], e[1]), cvtpk(e[2], e[3]), cvtpk(e[4], e[5]), cvtpk(e[6], e[7])};
    return __builtin_bit_cast(bf16x8, w);
}
__device__ __forceinline__ float softmax_head(St& st, const f32x16& p0, const f32x16& p1, bool live, float cadd, float& tmax) {
    float mxa = fmaxf(p0[0], p1[0]), mxb = fmaxf(p0[1], p1[1]);
#pragma unroll
    for (int r = 2; r < 16; r += 2) { mxa = fmaxf(fmaxf(mxa, p0[r]), p1[r]); mxb = fmaxf(fmaxf(mxb, p0[r + 1]), p1[r + 1]); }
    float mx = xhalf_max(fmaxf(mxa, mxb)) + cadd;
    if (!live) mx = NEG_INF;
    tmax = mx;
    if (__any(mx > st.m + SM_THR)) { const float mn = fmaxf(st.m, mx); const float f = ex2(st.m - mn); st.l *= f;
#pragma unroll
        for (int r = 0; r < 16; ++r) { st.o0[r] *= f; st.o1[r] *= f; }
        st.m = mn; }
    return live ? st.m - cadd : -NEG_INF;
}
#define MFMA32 __builtin_amdgcn_mfma_f32_32x32x16_bf16
template <int REL, class F, class... A> __device__ __forceinline__ decltype(auto) call_r(F& f, int t, A&... a) {
    if constexpr (std::is_invocable_v<F&, std::integral_constant<int, REL>, int, A&...>) return f(std::integral_constant<int, REL>{}, t, a...);
    else return f(t, a...);
}
template <int REL, class Init> __device__ __forceinline__ bool init_z(Init& init, int t, f32x16& p0, f32x16& p1) {
    if constexpr (std::is_same_v<decltype(call_r<REL>(init, t, p0, p1)), bool>) return call_r<REL>(init, t, p0, p1); else { call_r<REL>(init, t, p0, p1); return false; }
}
template <int REL, class Init> __device__ __forceinline__ void init_full(Init& init, int t, f32x16& p0, f32x16& p1) {
    if (init_z<REL>(init, t, p0, p1)) {
#pragma unroll
        for (int r = 0; r < 16; ++r) { p0[r] = 0.f; p1[r] = 0.f; } }
}
#define ZERO16 ((f32x16){0.f, 0.f, 0.f, 0.f, 0.f, 0.f, 0.f, 0.f, 0.f, 0.f, 0.f, 0.f, 0.f, 0.f, 0.f, 0.f})
#define QK0(KF) do { if (zi) { n0 = MFMA32(KF[0], qf[0], ZERO16, 0, 0, 0); n1 = MFMA32(KF[1], qf[0], ZERO16, 0, 0, 0); } else { n0 = MFMA32(KF[0], qf[0], n0, 0, 0, 0); n1 = MFMA32(KF[1], qf[0], n1, 0, 0, 0); } } while (0)
template <bool FAST = false, bool HOOKED = false, int STAG = 0, int PRE = 0, class Src, class Act, class Init, class Post, class Valu, class Pv, class Sargs, class Hook>
__device__ __forceinline__ void tile_loop_x(LAS unsigned char* lds, int nt, int pitch, const bf16x8 (&qf)[4], St* fst, Src src, Act act, Init init, Post post, Valu valu, Pv pv, Sargs sargs, Hook hook, int wid, int lane) {
    if (nt <= 0) return;
    const int r32 = lane & 31, hi = lane >> 5;
    if constexpr (PRE == 0) { const bf16 *kp, *vp; call_r<0>(src, 0, kp, vp); dma_k(kp, pitch, lds + L_K, wid, lane); dma_v(vp, pitch, lds + L_V, wid, lane); }
    if constexpr (PRE != 1) { if (nt > 1) { const bf16 *kp, *vp; call_r<1>(src, 1, kp, vp); dma_k(kp, pitch, lds + L_K + 8192, wid, lane); } }
    if (PRE == 2 && nt > 1) ATT_WAIT_BAR(1);
    else ATT_WAIT_BAR(0);
    f32x16 a0, a1, b0, b1;
    if (FAST || act(0)) { bf16x8 kf[8]; load_kf(kf, (lcp)(lds + L_K), r32, hi); init_full<0>(init, 0, a0, a1); qk_mfma(a0, a1, kf, qf); post(0, a0, a1); }
    auto step = [&](int t, f32x16& c0, f32x16& c1, f32x16& n0, f32x16& n1) {
        const int cur = (t & 1) * 8192, nxt = 8192 - cur;
        ATT_WAIT_BAR(0);
        auto issue_dma = [&]() {
            if (t + 2 < nt) { const bf16 *kp, *vp; call_r<2>(src, t + 2, kp, vp); dma_k(kp, pitch, lds + L_K + cur, wid, lane); }
            { const bf16 *kp, *vp; call_r<1>(src, t + 1, kp, vp); dma_v(vp, pitch, lds + L_V + nxt, wid, lane); } };
        if (!FAST || !DMA_LATE) issue_dma();
        const bool an = FAST || act(t + 1), ac = FAST || act(t);
        if constexpr (FAST) { {
            St& st = *fst; bool live; float cadd; call_r<0>(sargs, t, live, cadd);
            lcp kn = (lcp)(lds + L_K + nxt); lcp vc = (lcp)(lds + L_V + cur);
            bf16x8 ka[2], va[2], kb[2], vb[2];
            const bool zi = init_z<1>(init, t + 1, n0, n1); load_k2(ka, kn, 0, r32, hi);
            float tmax; const float ms = softmax_head(st, c0, c1, live, cadd, tmax);
            const bool alive = HOOKED || !__all(tmax < st.m - 150.f);
            if (alive) load_v2(va, vc, 0, lane, hi);
            float sacc = 0.f;
            if (DMA_LATE) issue_dma();
            ATT_SCHED();
            if constexpr (STAG == 1) {
                bf16x8 pa = {0, 0, 0, 0, 0, 0, 0, 0}, pb = {0, 0, 0, 0, 0, 0, 0, 0};
                { load_k2(kb, kn, 1, r32, hi); if (alive) { load_v2(vb, vc, 1, lane, hi); pa = exp_chunk<0>(c0, ms, sacc, hook, t, 0); } }
                ATT_SCHED();
                { if (alive) pb = exp_chunk<8>(c0, ms, sacc, hook, t, 1);
                  QK0(ka); if (alive) { st.o0 = MFMA32(va[0], pa, st.o0, 0, 0, 0); st.o1 = MFMA32(va[1], pa, st.o1, 0, 0, 0); } }
                ATT_SCHED();
                { load_k2(ka, kn, 2, r32, hi); if (alive) { load_v2(va, vc, 2, lane, hi); pa = exp_chunk<0>(c1, ms, sacc, hook, t, 2); }
                  n0 = MFMA32(kb[0], qf[1], n0, 0, 0, 0); n1 = MFMA32(kb[1], qf[1], n1, 0, 0, 0); if (alive) { st.o0 = MFMA32(vb[0], pb, st.o0, 0, 0, 0); st.o1 = MFMA32(vb[1], pb, st.o1, 0, 0, 0); } }
                ATT_SCHED();
                { load_k2(kb, kn, 3, r32, hi); if (alive) { load_v2(vb, vc, 3, lane, hi); pb = exp_chunk<8>(c1, ms, sacc, hook, t, 3); }
                  n0 = MFMA32(ka[0], qf[2], n0, 0, 0, 0); n1 = MFMA32(ka[1], qf[2], n1, 0, 0, 0); if (alive) { st.o0 = MFMA32(va[0], pa, st.o0, 0, 0, 0); st.o1 = MFMA32(va[1], pa, st.o1, 0, 0, 0); } }
                ATT_SCHED();
                { n0 = MFMA32(kb[0], qf[3], n0, 0, 0, 0); n1 = MFMA32(kb[1], qf[3], n1, 0, 0, 0); if (alive) { st.o0 = MFMA32(vb[0], pb, st.o0, 0, 0, 0); st.o1 = MFMA32(vb[1], pb, st.o1, 0, 0, 0); } }
                ATT_SCHED();
                st.l += sacc; post(t + 1, n0, n1);
                return;
            }
            { load_k2(kb, kn, 1, r32, hi); bf16x8 pk = {0, 0, 0, 0, 0, 0, 0, 0}; if (alive) { load_v2(vb, vc, 1, lane, hi); pk = exp_chunk<0>(c0, ms, sacc, hook, t, 0); }
              QK0(ka); if (alive) { st.o0 = MFMA32(va[0], pk, st.o0, 0, 0, 0); st.o1 = MFMA32(va[1], pk, st.o1, 0, 0, 0); } }
            ATT_SCHED();
            { load_k2(ka, kn, 2, r32, hi); bf16x8 pk = {0, 0, 0, 0, 0, 0, 0, 0}; if (alive) { load_v2(va, vc, 2, lane, hi); pk = exp_chunk<8>(c0, ms, sacc, hook, t, 1); }
              n0 = MFMA32(kb[0], qf[1], n0, 0, 0, 0); n1 = MFMA32(kb[1], qf[1], n1, 0, 0, 0); if (alive) { st.o0 = MFMA32(vb[0], pk, st.o0, 0, 0, 0); st.o1 = MFMA32(vb[1], pk, st.o1, 0, 0, 0); } }
            ATT_SCHED();
            { load_k2(kb, kn, 3, r32, hi); bf16x8 pk = {0, 0, 0, 0, 0, 0, 0, 0}; if (alive) { load_v2(vb, vc, 3, lane, hi); pk = exp_chunk<0>(c1, ms, sacc, hook, t, 2); }
              n0 = MFMA32(ka[0], qf[2], n0, 0, 0, 0); n1 = MFMA32(ka[1], qf[2], n1, 0, 0, 0); if (alive) { st.o0 = MFMA32(va[0], pk, st.o0, 0, 0, 0); st.o1 = MFMA32(va[1], pk, st.o1, 0, 0, 0); } }
            ATT_SCHED();
            { bf16x8 pk = {0, 0, 0, 0, 0, 0, 0, 0}; if (alive) pk = exp_chunk<8>(c1, ms, sacc, hook, t, 3);
              n0 = MFMA32(kb[0], qf[3], n0, 0, 0, 0); n1 = MFMA32(kb[1], qf[3], n1, 0, 0, 0); if (alive) { st.o0 = MFMA32(vb[0], pk, st.o0, 0, 0, 0); st.o1 = MFMA32(vb[1], pk, st.o1, 0, 0, 0); } }
            ATT_SCHED();
            st.l += sacc; post(t + 1, n0, n1);
            return;
        } }
        bf16x8 kf[8], vf[8]; Pf pf;
        if (an) { load_kf(kf, (lcp)(lds + L_K + nxt), r32, hi); init_full<1>(init, t + 1, n0, n1); ATT_SCHED(); }
        if (ac) { valu(t, c0, c1, pf); ATT_SCHED(); load_vf(vf, (lcp)(lds + L_V + cur), lane, hi); ATT_SCHED(); }
        if (an) { qk_mfma(n0, n1, kf, qf); post(t + 1, n0, n1); }
        if (ac) pv(t, vf, pf);
    };
    auto last = [&](int t, f32x16& c0, f32x16& c1) { ATT_WAIT_BAR(0);
        if constexpr (FAST) {
            St& st = *fst; bool live; float cadd; call_r<0>(sargs, t, live, cadd); lcp vc = (lcp)(lds + L_V + (t & 1) * 8192);
            bf16x8 vf[8]; load_vf(vf, vc, lane, hi);
            float tmax; const float ms = softmax_head(st, c0, c1, live, cadd, tmax); float sacc = 0.f; Pf pf;
            pf.f[0] = exp_chunk<0>(c0, ms, sacc, hook, t, 0); pf.f[1] = exp_chunk<8>(c0, ms, sacc, hook, t, 1); pf.f[2] = exp_chunk<0>(c1, ms, sacc, hook, t, 2); pf.f[3] = exp_chunk<8>(c1, ms, sacc, hook, t, 3);
            st.l += sacc; pv_mfma(st, vf, pf);
        } else {
        if (act(t)) { bf16x8 vf[8]; Pf pf; load_vf(vf, (lcp)(lds + L_V + (t & 1) * 8192), lane, hi); valu(t, c0, c1, pf); pv(t, vf, pf); } } };
    int t = 0;
    for (; t + 2 < nt; t += 2) { step(t, a0, a1, b0, b1); step(t + 1, b0, b1, a0, a1); }
    if (t + 1 < nt) { step(t, a0, a1, b0, b1); last(t + 1, b0, b1); } else last(t, a0, a1);
    ATT_BAR();
}
__device__ __forceinline__ void prologue_dma(LAS unsigned char* lds, int nt, int pitch, const bf16* k0, const bf16* v0, const bf16* k1, int wid, int lane) {
    dma_k(k0, pitch, lds + L_K, wid, lane); dma_v(v0, pitch, lds + L_V, wid, lane);
    if (nt > 1) dma_k(k1, pitch, lds + L_K + 8192, wid, lane);
}
template <class Src, class Act, class Init, class Post, class Valu, class Pv>
__device__ __forceinline__ void tile_loop(LAS unsigned char* lds, int nt, int pitch, const bf16x8 (&qf)[4], Src src, Act act, Init init, Post post, Valu valu, Pv pv, int wid, int lane) {
    tile_loop_x<false, false, 0>(lds, nt, pitch, qf, (St*)nullptr, src, act, init, post, valu, pv, [](int, bool&, float&) {}, [](int, int, const float (&)[8], float) {}, wid, lane);
}
template <int STAG = 0, int PRE = 0, class Src, class Act, class Init, class Post, class Sargs>
__device__ __forceinline__ void tile_loop_std(LAS unsigned char* lds, int nt, int pitch, const bf16x8 (&qf)[4], St& st, Src src, Act act, Init init, Post post, Sargs sargs, int wid, int lane) {
    auto valu = [&](int t, f32x16& p0, f32x16& p1, Pf& pf) { bool live; float cadd; call_r<0>(sargs, t, live, cadd); softmax(st, p0, p1, pf, live, cadd); };
    auto pv = [&](int t, const bf16x8 (&vf)[8], const Pf& pf) { pv_mfma(st, vf, pf); };
    auto nohook = [](int, int, const float (&)[8], float) {};
    if (STAG && wid >= STAG_FROM) tile_loop_x<true, false, 1, PRE>(lds, nt, pitch, qf, &st, src, act, init, post, valu, pv, sargs, nohook, wid, lane);
    else tile_loop_x<true, false, 0, PRE>(lds, nt, pitch, qf, &st, src, act, init, post, valu, pv, sargs, nohook, wid, lane);
}
template <int STAG = 0, int PRE = 0, class Src, class Init, class Post, class Sargs, class Hook>
__device__ __forceinline__ void tile_loop_hooked(LAS unsigned char* lds, int nt, int pitch, const bf16x8 (&qf)[4], St& st, Src src, Init init, Post post, Sargs sargs, Hook hook, int wid, int lane) {
    auto act = [](int) { return true; }; auto valu = [&](int t, f32x16& p0, f32x16& p1, Pf& pf) {}; auto pv = [&](int t, const bf16x8 (&vf)[8], const Pf& pf) {};
    if (STAG && wid >= STAG_FROM) tile_loop_x<true, true, 1, PRE>(lds, nt, pitch, qf, &st, src, act, init, post, valu, pv, sargs, hook, wid, lane);
    else tile_loop_x<true, true, 0, PRE>(lds, nt, pitch, qf, &st, src, act, init, post, valu, pv, sargs, hook, wid, lane);
}
#define SARGS_STD [](int, bool& live, float& cadd) { live = true; cadd = 0.f; }
#define ACT_ALL [](int) { return true; }
#define POST_NONE [](int, f32x16&, f32x16&) {}

__device__ __forceinline__ void fox_unit(LAS unsigned char* lds, int wv, const bf16* proj, const float* cum, bf16* O, float* ssq, int b, int h, int qb) {
    int tid_l = wv * 64 + lane_id_fresh(); asm volatile("" : "+v"(tid_l));
    const int tid = tid_l, lane = tid & 63, r32 = lane & 31, hi = lane >> 5, wid = __builtin_amdgcn_readfirstlane(tid >> 6);
    const int t0 = qb * 256, tw0 = t0 + 32 * wid, tq = tw0 + r32;
    bf16x8 qf[4];
    { const bf16* qp = proj + (size_t)(b * SEQ + tq) * NPROJ + C_QB + h * 64 + 8 * hi;
#pragma unroll
      for (int d0 = 0; d0 < 4; ++d0) qf[d0] = *(const GAS bf16x8*)(qp + 16 * d0); }
    const bf16* Kb = proj + (size_t)(b * SEQ) * NPROJ + C_KB + h * 64; const bf16* Vb = proj + (size_t)(b * SEQ) * NPROJ + C_VB + h * 64;
    const int NT = 4 * (qb + 1);
    if (HOIST_FOX) prologue_dma(lds, NT, NPROJ, Kb + (size_t)(64 * (NT - 1)) * NPROJ, Vb + (size_t)(64 * (NT - 1)) * NPROJ, Kb + (size_t)(64 * (NT - 2)) * NPROJ, wid, lane);
    LAS float* cs = (LAS float*)(lds + L_AUX);
    { LAS float* wt = (LAS float*)(lds + L_AUX + 16384);
      const float* src = cum + (size_t)(b * 4 + h) * SEQ + tid * 8;
      f32x4 v0 = {0.f, 0.f, 0.f, 0.f}, v1 = v0;
      if (tid * 8 < t0 + 256) { v0 = *(const GAS f32x4*)src; v1 = *(const GAS f32x4*)(src + 4); }
      const float sm = ((v0.x + v0.y) + (v0.z + v0.w)) + ((v1.x + v1.y) + (v1.z + v1.w));
      float x = sm;
#pragma unroll
      for (int o = 1; o < 64; o <<= 1) { const float tt = __shfl_up(x, o); if (lane >= o) x += tt; }
      if (lane == 63) wt[wid] = x;
      ATT_BAR();
      float run = x - sm;
      for (int w = 0; w < wid; ++w) run += wt[w];
      f32x4 o0, o1; run += v0.x; o0.x = run; run += v0.y; o0.y = run; run += v0.z; o0.z = run; run += v0.w; o0.w = run;
      run += v1.x; o1.x = run; run += v1.y; o1.y = run; run += v1.z; o1.z = run; run += v1.w; o1.w = run;
      *(LAS f32x4*)(cs + tid * 8) = o0 * (-LOG2E); *(LAS f32x4*)(cs + tid * 8 + 4) = o1 * (-LOG2E); }
    St st; st_init(st, -1e30f, 0.f);
    tile_loop_std<STAG_FOX, HOIST_FOX>(lds, NT, NPROJ, qf, st,
        [&](int i, const bf16*& kp, const bf16*& vp) { const int s0 = 64 * (NT - 1 - i); kp = Kb + (size_t)s0 * NPROJ; vp = Vb + (size_t)s0 * NPROJ; },
        [&](int i) { return 64 * (NT - 1 - i) <= tw0 + 31; },
        [&](int i, f32x16& p0, f32x16& p1) { const int s0 = 64 * (NT - 1 - i);
#pragma unroll
            for (int a = 0; a < 4; ++a) { const f32x4 c0 = *(const LAS f32x4*)(cs + s0 + 8 * a + 4 * hi), c1 = *(const LAS f32x4*)(cs + s0 + 32 + 8 * a + 4 * hi);
#pragma unroll
                for (int e = 0; e < 4; ++e) { p0[4 * a + e] = c0[e]; p1[4 * a + e] = c1[e]; } } },
        [&](int i, f32x16& p0, f32x16& p1) { const int s0 = 64 * (NT - 1 - i);
            if (s0 + 63 > tw0) { asm volatile("" ::: "memory");
#pragma unroll
                for (int r = 0; r < 16; ++r) { const int kv = s0 + (r & 3) + 8 * (r >> 2) + 4 * hi; if (kv > tq) p0[r] = NEG_INF; if (kv + 32 > tq) p1[r] = NEG_INF; } } },
        SARGS_STD, wid, lane);
    const float inv = 1.f / xhalf_sum(st.l);
    store_o(O + (size_t)(b * SEQ + tw0) * DM + 256 + h * 64, st.o0, st.o1, inv, lane, ssq + (size_t)(b * SEQ + tq) * 16 + 4 + h, lds + wid * 4608);
}
__device__ __forceinline__ void fox_phase(LAS unsigned char* lds, int wv, const bf16* proj, const float* cum, bf16* O, float* ssq, unsigned* ctr) {
    volatile LAS int* slot = (volatile LAS int*)(lds + LDSCTL_OFF + 64);
    for (int idx = (int)blockIdx.x; idx < 512; idx = (int)gridDim.x + next_unit(ctr, slot, wv)) {
        fox_unit(lds, wv, proj, cum, O, ssq, (idx & 31) >> 2, idx & 3, 15 - (idx >> 5));
    }
}

__device__ __forceinline__ void swa_unit(LAS unsigned char* lds, int wv, const bf16* proj, const float* rel_bias, const float* sinks, bf16* O, float* ssq, int b, int hkv, int qblk) {
    int tid_l = wv * 64 + lane_id_fresh(); asm volatile("" : "+v"(tid_l));
    const int tid = tid_l, lane = tid & 63, r32 = lane & 31, hi = lane >> 5, wid = __builtin_amdgcn_readfirstlane(tid >> 6);
    const int hq = 2 * hkv + (wid >> 2), t0 = qblk * 128, tq = t0 + 32 * (wid & 3) + r32;
    bf16x8 qf[4];
    { const bf16* qp = proj + (size_t)(b * SEQ + tq) * NPROJ + C_QA + hq * 64 + 8 * hi;
#pragma unroll
      for (int d0 = 0; d0 < 4; ++d0) qf[d0] = *(const GAS bf16x8*)(qp + 16 * d0); }
    const int k0 = (t0 == 0) ? 2 : 0;
    const bf16* Kb = proj + (size_t)(b * SEQ) * NPROJ + C_KA + hkv * 64; const bf16* Vb = proj + (size_t)(b * SEQ) * NPROJ + C_VA + hkv * 64;
    if (HOIST_SWA) { const int s00 = t0 - 128 + 64 * k0; prologue_dma(lds, 4 - k0, NPROJ, Kb + (size_t)s00 * NPROJ, Vb + (size_t)s00 * NPROJ, Kb + (size_t)(s00 + 64) * NPROJ, wid, lane); }
    LAS float* T = (LAS float*)(lds + L_AUX);
    { TabVals<384> ta, tb; tab_load(ta, 255, rel_bias, 2 * hkv, tid); tab_load(tb, 255, rel_bias, 2 * hkv + 1, tid);
      ATT_SCHED();
      tab_store(ta, T, 255, 0, 128, tid); tab_store(tb, T + 384, 255, 0, 128, tid); }
    const LAS float* Tw = T + (wid >> 2) * 384;
    St st; st_init(st, sinks[hq] * LOG2E, hi == 0 ? 1.f : 0.f);
    tile_loop_std<STAG_SWA, HOIST_SWA>(lds, 4 - k0, NPROJ, qf, st,
        [&](int t, const bf16*& kp, const bf16*& vp) { const int s0 = t0 - 128 + 64 * (k0 + t); kp = Kb + (size_t)s0 * NPROJ; vp = Vb + (size_t)s0 * NPROJ; },
        ACT_ALL,
        [&](int t, f32x16& p0, f32x16& p1) { const int s0 = t0 - 128 + 64 * (k0 + t); init_tab(p0, p1, Tw + (255 - (tq - s0) + 4 * hi)); },
        POST_NONE,
        SARGS_STD, wid, lane);
    const float inv = 1.f / xhalf_sum(st.l);
    store_o(O + (size_t)(b * SEQ + t0 + 32 * (wid & 3)) * DM + hq * 64, st.o0, st.o1, inv, lane, ssq + (size_t)(b * SEQ + tq) * 16 + hq, lds + wid * 4608);
}
__device__ __forceinline__ void swa_phase(LAS unsigned char* lds, int wv, const bf16* proj, const float* rel_bias, const float* sinks, bf16* O, float* ssq, unsigned* ctr) {
    volatile LAS int* slot = (volatile LAS int*)(lds + LDSCTL_OFF + 64);
    for (int idx = (int)blockIdx.x; idx < 512; idx = (int)gridDim.x + next_unit(ctr, slot, wv)) {
        swa_unit(lds, wv, proj, rel_bias, sinks, O, ssq, idx >> 6, (idx >> 5) & 1, idx & 31);
    }
}

constexpr int L_TSLC = L_AUX, N_TSLC = 1216, L_TWIN = L_TSLC + 4 * N_TSLC * 4, N_TWIN = 704, L_IMPB = L_TWIN + 4 * N_TWIN * 4, IMP_LD = 65;
static_assert(L_IMPB + 4 * 64 * IMP_LD * 4 <= RING_BYTES, "NSA LDS map");
constexpr int L_SELM = LDSCTL_OFF + 256, L_TLIST = LDSCTL_OFF + 1024, L_MREF = LDSCTL_OFF + 2048, L_MFIN = L_MREF + 4096;
__device__ __forceinline__ void nsa_unit(LAS unsigned char* lds, int wv, const bf16* proj, const bf16* kcmp, const bf16* vcmp, const float* rel_bias, const float* gates, bf16* O, float* ssq, int b, int hkv, int qb) {
    int tid_l = wv * 64 + lane_id_fresh(); asm volatile("" : "+v"(tid_l));
    const int tid = tid_l, lane = tid & 63, r32 = lane & 31, hi = lane >> 5, wid = __builtin_amdgcn_readfirstlane(tid >> 6);
    const int g = wid >> 1, h8 = 4 * hkv + g, t0 = qb * 64, qrow = 32 * (wid & 1) + r32, tw0 = t0 + 32 * (wid & 1), tq = t0 + qrow;
    bf16x8 qf[4];
    { const bf16* qp = proj + (size_t)(b * SEQ + tq) * NPROJ + C_QC + h8 * 64 + 8 * hi;
#pragma unroll
      for (int d0 = 0; d0 < 4; ++d0) qf[d0] = *(const GAS bf16x8*)(qp + 16 * d0); }
    const float* gp = gates + (size_t)(b * SEQ + tq) * 24 + h8 * 3;
    const float g_cmp = gp[0], g_slc = gp[1], g_win = gp[2];
    const bf16* Kc = kcmp + (size_t)((b * 2 + hkv) * 256) * 64; const bf16* Vc = vcmp + (size_t)((b * 2 + hkv) * 256) * 64;
    const int NTC = (4 * qb + 2) / 64 + 1;
    if (HOIST_CMP) prologue_dma(lds, NTC, 64, Kc, Vc, Kc + 64 * 64, wid, lane);
    LAS float* TS = (LAS float*)(lds + L_TSLC); LAS float* TW = (LAS float*)(lds + L_TWIN);
    { TabVals<N_TSLC> vs[4]; TabVals<N_TWIN> vw[4];
#pragma unroll
      for (int gg = 0; gg < 4; ++gg) { tab_load(vs[gg], 1151, rel_bias, 4 + 4 * hkv + gg, tid); tab_load(vw[gg], 639, rel_bias, 4 + 4 * hkv + gg, tid); }
      ATT_SCHED();
#pragma unroll
      for (int gg = 0; gg < 4; ++gg) { tab_store(vs[gg], TS + gg * N_TSLC, 1151, 0, 1 << 30, tid); tab_store(vw[gg], TW + gg * N_TWIN, 639, 0, 512, tid); } }
    const LAS float* Ts = TS + g * N_TSLC; const LAS float* Tw = TW + g * N_TWIN;
    LAS float* impb = (LAS float*)(lds + L_IMPB);
    volatile LAS unsigned long long* selm = (volatile LAS unsigned long long*)(lds + L_SELM);
    volatile LAS int* tlist = (volatile LAS int*)(lds + L_TLIST);
    f32x16 os0, os1;
    auto cmp_src = [&](int t, const bf16*& kp, const bf16*& vp) { kp = Kc + (size_t)t * 64 * 64; vp = Vc + (size_t)t * 64 * 64; };
    auto cmp_init = [&](int t, f32x16& p0, f32x16& p1) {
        const int dbase = tq - 31 - 16 * (64 * t + 4 * hi);
#pragma unroll
        for (int r = 0; r < 16; ++r) { const int kr = (r & 3) + 8 * (r >> 2);
            int d0 = dbase - 16 * kr, d1 = d0 - 512; d0 = d0 < -1 ? -1 : d0 > 1151 ? 1151 : d0; d1 = d1 < -1 ? -1 : d1 > 1151 ? 1151 : d1;
            p0[r] = Ts[1151 - d0]; p1[r] = Ts[1151 - d1]; }
    };
    LAS float* mref = (LAS float*)(lds + L_MREF);
    LAS float* mfin = (LAS float*)(lds + L_MFIN);
    { St st; st_init(st, -1e30f, 0.f); float carry = 0.f, ms_prev = 0.f;
      LAS float* ip = impb + (g * 64 + qrow) * IMP_LD + hi;
      tile_loop_hooked<STAG_CMP, HOIST_CMP>(lds, NTC, 64, qf, st, cmp_src, cmp_init, POST_NONE, SARGS_STD,
        [&](int t, int k, const float (&e)[8], float ms) {
            if (k == 0) { if (t > 0) carry *= ex2(ms_prev - ms); ms_prev = ms; if (hi == 0) mref[(g * 64 + qrow) * 4 + t] = ms; }
            const float own0 = (e[0] + e[1]) + (e[2] + 0.5f * e[3]), own1 = (e[4] + e[5]) + (e[6] + 0.5f * e[7]);
            const float pl0 = __shfl_xor(e[3], 32), pl1 = __shfl_xor(e[7], 32);
            const int j0 = 16 * t + 4 * k;
            ip[j0] = own0 + 0.5f * (hi ? pl0 : carry); ip[j0 + 2] = own1 + 0.5f * (hi ? pl1 : pl0);
            carry = pl1; },
        wid, lane);
      const float lt = xhalf_sum(st.l); const float inv_l = lt > 0.f ? 1.f / lt : 0.f;
      if (hi == 0) { mfin[g * 64 + qrow] = st.m; mfin[256 + g * 64 + qrow] = inv_l; }
      const float sc = g_cmp * inv_l;
      os0 = st.o0 * sc; os1 = st.o1 * sc; }
    ATT_BAR();
    if (HOIST_SLC) { const bf16* Kb0 = proj + (size_t)(b * SEQ) * NPROJ + C_KS + hkv * 64; const bf16* Vb0 = proj + (size_t)(b * SEQ) * NPROJ + C_VS + hkv * 64;
      dma_k(Kb0, NPROJ, lds + L_K, wid, lane); dma_v(Vb0, NPROJ, lds + L_V, wid, lane); }
    if (qb >= 16) {
        const int q = tid >> 3, part = tid & 7;
        LAS float* v = impb + q * IMP_LD;
        float fac[4];
#pragma unroll
        for (int gg = 0; gg < 4; ++gg) fac[gg] = ex2(mref[(gg * 64 + q) * 4 + (part >> 1)] - mfin[gg * 64 + q]) * mfin[256 + gg * 64 + q];
#pragma unroll
        for (int jj = 0; jj < 8; ++jj) { const int j = 8 * part + jj; v[j] = (v[j] * fac[0] + v[64 * IMP_LD + j] * fac[1]) + (v[2 * 64 * IMP_LD + j] * fac[2] + v[3 * 64 * IMP_LD + j] * fac[3]); }
        ATT_BAR();
        unsigned long long mk = part == 0 ? (1ull | (1ull << qb) | (1ull << (qb - 1))) : 0ull;
        unsigned long long kj[8]; int rank[8];
#pragma unroll
        for (int jj = 0; jj < 8; ++jj) { kj[jj] = ((unsigned long long)__float_as_uint(v[8 * part + jj]) << 6) | (unsigned)(63 - (8 * part + jj)); rank[jj] = 3; }
        for (int k = 1; k <= qb - 2; ++k) { const unsigned long long kk = ((unsigned long long)__float_as_uint(v[k]) << 6) | (unsigned)(63 - k);
#pragma unroll
            for (int jj = 0; jj < 8; ++jj) rank[jj] += kk > kj[jj] ? 1 : 0; }
#pragma unroll
        for (int jj = 0; jj < 8; ++jj) { const int j = 8 * part + jj; if (j >= 1 && j <= qb - 2 && rank[jj] < 16) mk |= 1ull << j; }
        unsigned lo = (unsigned)mk, hh = (unsigned)(mk >> 32);
#pragma unroll
        for (int o = 1; o < 8; o <<= 1) { lo |= __shfl_xor(lo, o); hh |= __shfl_xor(hh, o); }
        if (part == 0) selm[q] = ((unsigned long long)hh << 32) | lo;
    } else {
        if (tid < 64) selm[tid] = (2ull << qb) - 1ull;
    }
    ATT_BAR();
    if (wid == 0) {
        const unsigned long long mine = selm[lane]; unsigned lo = (unsigned)mine, hh = (unsigned)(mine >> 32);
#pragma unroll
        for (int o = 1; o < 64; o <<= 1) { lo |= __shfl_xor(lo, o); hh |= __shfl_xor(hh, o); }
        if (lane == 0) { tlist[0] = __builtin_popcount(lo) + __builtin_popcount(hh); tlist[65] = (int)lo; tlist[66] = (int)hh; }
    }
    ATT_BAR();
    const unsigned long long mysel = selm[qrow];
    const int ntl = tlist[0];
    LAS float* osl = (LAS float*)(lds + L_IMPB) + wid * 2048 + lane;
#pragma unroll
    for (int r = 0; r < 16; ++r) { osl[r * 64] = os0[r]; osl[(16 + r) * 64] = os1[r]; }
    { St st; st_init(st, -1e30f, 0.f);
      const bf16* Kb = proj + (size_t)(b * SEQ) * NPROJ + C_KS + hkv * 64; const bf16* Vb = proj + (size_t)(b * SEQ) * NPROJ + C_VS + hkv * 64;
      const float cfar = Ts[1151 - 1100];
      unsigned long long rem = ((unsigned long long)(unsigned)__builtin_amdgcn_readfirstlane(tlist[66]) << 32) | (unsigned)__builtin_amdgcn_readfirstlane(tlist[65]);
      auto pop = [&]() { const int j = rem ? __builtin_ctzll(rem) : 0; rem &= rem - 1ull; return j; };
      int tc = 0, w0 = pop(), w1 = pop(), w2 = pop();
      auto tile = [&](auto rel) { constexpr int R = decltype(rel)::value; return R == 0 ? w0 : R == 1 ? w1 : w2; };
      tile_loop_std<STAG_SLC, 2 * HOIST_SLC>(lds, ntl, NPROJ, qf, st,
        [&](auto rel, int t, const bf16*& kp, const bf16*& vp) { const int s0 = 64 * tile(rel); kp = Kb + (size_t)s0 * NPROJ; vp = Vb + (size_t)s0 * NPROJ; },
        ACT_ALL,
        [&](auto rel, int t, f32x16& p0, f32x16& p1) -> bool { const int s0 = 64 * tile(rel);
            if (tw0 - s0 <= 852) { init_tab(p0, p1, Ts + (1151 - (tq - s0) + 4 * hi)); return false; }
            return true; },
        [&](int t, f32x16&, f32x16&) { if (t > tc) { tc = t; w0 = w1; w1 = w2; w2 = pop(); } },
        [&](auto rel, int t, bool& live, float& cadd) { const int j = tile(rel); live = (mysel >> j) & 1ull; cadd = (tw0 - 64 * j <= 852) ? 0.f : cfar; },
        wid, lane);
      const float sc = g_slc / xhalf_sum(st.l);
#pragma unroll
      for (int r = 0; r < 16; ++r) { osl[r * 64] += st.o0[r] * sc; osl[(16 + r) * 64] += st.o1[r] * sc; } }
    { St st; st_init(st, -1e30f, 0.f);
      const bf16* Kb = proj + (size_t)(b * SEQ) * NPROJ + C_KW + hkv * 64; const bf16* Vb = proj + (size_t)(b * SEQ) * NPROJ + C_VW + hkv * 64;
      const int j0 = qb >= 8 ? qb - 8 : 0;
      tile_loop_std<STAG_WIN>(lds, qb - j0 + 1, NPROJ, qf, st,
        [&](int t, const bf16*& kp, const bf16*& vp) { const int s0 = 64 * (j0 + t); kp = Kb + (size_t)s0 * NPROJ; vp = Vb + (size_t)s0 * NPROJ; },
        ACT_ALL,
        [&](int t, f32x16& p0, f32x16& p1) { const int s0 = 64 * (j0 + t); init_tab(p0, p1, Tw + (639 - (tq - s0) + 4 * hi)); },
        POST_NONE,
        SARGS_STD, wid, lane);
      const float sc = g_win / xhalf_sum(st.l);
#pragma unroll
      for (int r = 0; r < 16; ++r) { os0[r] = osl[r * 64] + st.o0[r] * sc; os1[r] = osl[(16 + r) * 64] + st.o1[r] * sc; } }
    { int tq2 = tq; asm volatile("" : "+v"(tq2));
      store_o(O + (size_t)(b * SEQ + tw0) * DM + 512 + h8 * 64, os0, os1, 1.f, lane, ssq + (size_t)(b * SEQ + tq2) * 16 + 8 + h8, lds + wid * 4608); }
}
__device__ __forceinline__ void nsa_phase(LAS unsigned char* lds, int wv, const bf16* proj, const bf16* kcmp, const bf16* vcmp, const float* rel_bias, const float* gates, bf16* O, float* ssq, unsigned* ctr) {
    volatile LAS int* slot = (volatile LAS int*)(lds + LDSCTL_OFF + 64);
    for (int idx = (int)blockIdx.x; idx < 1024; idx = (int)gridDim.x + next_unit(ctr, slot, wv)) {
        nsa_unit(lds, wv, proj, kcmp, vcmp, rel_bias, gates, O, ssq, (idx & 15) >> 1, idx & 1, 63 - (idx >> 4));
    }
}

constexpr int L_RED = 0, L_HID = 16384, HID_LD = 136, L_HID2 = LDSCTL_OFF + 2048;
__device__ __forceinline__ void compress_unit(LAS unsigned char* lds, int wv, const bf16* proj, const bf16* w1t, const bf16* w2t, const float* cb1, bf16* kcmp, bf16* vcmp, int u) {
    int tid_l = wv * 64 + lane_id_fresh(); asm volatile("" : "+v"(tid_l));
    const int tid = tid_l, lane = tid & 63, r32 = lane & 31, hi = lane >> 5, wid = __builtin_amdgcn_readfirstlane(tid >> 6);
    const int i16 = lane & 15, kg = lane >> 4;
    const int mt = u & 7, kv = (u >> 3) & 1, hk = (u >> 4) & 1, b = u >> 5, n0 = 32 * mt;
    const int col0 = (kv ? C_VC : C_KC) + hk * 64;
    typedef float f32x4v __attribute__((ext_vector_type(4)));
    f32x4v acc[2][8];
#pragma unroll
    for (int rb = 0; rb < 2; ++rb)
#pragma unroll
        for (int cb = 0; cb < 8; ++cb) acc[rb][cb] = (f32x4v){0.f, 0.f, 0.f, 0.f};
    const bf16x8 zero8 = {0, 0, 0, 0, 0, 0, 0, 0};
    const int na = n0 + i16, nb = n0 + 16 + i16;
    const bf16* ar0 = proj + (size_t)(b * SEQ + 16 * (na < 255 ? na : 0)) * NPROJ + col0 + 8 * kg;
    const bf16* ar1 = proj + (size_t)(b * SEQ + 16 * (nb < 255 ? nb : 0)) * NPROJ + col0 + 8 * kg;
    const bf16* br = w1t + ((size_t)kv * 128 + i16) * 2048 + 8 * kg;
#pragma unroll 2
    for (int s8 = 0; s8 < 8; ++s8) { const int k = 256 * wid + 32 * s8;
        const size_t ao = (size_t)(k >> 6) * NPROJ + (k & 63);
        bf16x8 a0 = *(const GAS bf16x8*)(ar0 + ao), a1 = *(const GAS bf16x8*)(ar1 + ao);
        if (na >= 255) a0 = zero8; if (nb >= 255) a1 = zero8;
        bf16x8 bf[8];
#pragma unroll
        for (int cb = 0; cb < 8; ++cb) bf[cb] = *(const GAS bf16x8*)(br + (size_t)cb * 16 * 2048 + k);
#pragma unroll
        for (int cb = 0; cb < 8; ++cb) { acc[0][cb] = __builtin_amdgcn_mfma_f32_16x16x32_bf16(a0, bf[cb], acc[0][cb], 0, 0, 0); acc[1][cb] = __builtin_amdgcn_mfma_f32_16x16x32_bf16(a1, bf[cb], acc[1][cb], 0, 0, 0); } }
    LAS float* part = (LAS float*)lds;
#pragma unroll
    for (int rb = 0; rb < 2; ++rb)
#pragma unroll
        for (int cb = 0; cb < 8; ++cb)
#pragma unroll
            for (int e = 0; e < 4; ++e) part[(wid * 64 + (rb * 8 + cb) * 4 + e) * 64 + lane] = acc[rb][cb][e];
    ATT_BAR();
    LAS bf16* hid = (LAS bf16*)(lds + L_HID2);
#pragma unroll
    for (int q = 0; q < 8; ++q) { const int rr = 8 * wid + q; float x = 0.f;
#pragma unroll
        for (int w8 = 0; w8 < 8; ++w8) x += part[(w8 * 64 + rr) * 64 + lane];
        const int rb = rr >> 5, cb = (rr >> 2) & 7, e = rr & 3, row = 16 * rb + 4 * kg + e, col = 16 * cb + i16;
        x += cb1[kv * 128 + col];
        const float z = 0.7978845608028654f * (x + 0.044715f * x * x * x); const float th = 1.f - 2.f / (1.f + __expf(2.f * z));
        hid[row * HID_LD + col] = (bf16)f2bf(0.5f * x * (1.f + th)); }
    ATT_BAR();
    if (wid < 2) {
        f32x16 a2;
#pragma unroll
        for (int r = 0; r < 16; ++r) a2[r] = 0.f;
        const bf16* b2 = w2t + ((size_t)kv * 64 + 32 * wid + r32) * 128 + 8 * hi;
#pragma unroll
        for (int ks = 0; ks < 8; ++ks) { const bf16x8 a = *(const LAS bf16x8*)(hid + r32 * HID_LD + 16 * ks + 8 * hi); const bf16x8 bb = *(const GAS bf16x8*)(b2 + 16 * ks);
            a2 = __builtin_amdgcn_mfma_f32_32x32x16_bf16(a, bb, a2, 0, 0, 0); }
        bf16* out = (kv ? vcmp : kcmp) + (size_t)((b * 2 + hk) * 256 + n0) * 64 + 32 * wid + r32;
#pragma unroll
        for (int r = 0; r < 16; ++r) { const int row = (r & 3) + 8 * (r >> 2) + 4 * hi; out[(size_t)row * 64] = (n0 + row < 255) ? (bf16)f2bf(a2[r]) : (bf16)0; }
    }
    ATT_BAR();
}
__device__ __forceinline__ void thin_block(LAS unsigned char* lds, int wv, const bf16* hbuf, const bf16* wt, const float* fbias, float* logf, float* gates, int tb) {
    int tid_l = wv * 64 + lane_id_fresh(); asm volatile("" : "+v"(tid_l));
    const int tid = tid_l, lane = tid & 63, wid = __builtin_amdgcn_readfirstlane(tid >> 6), i16 = lane & 15, kg = lane >> 4, r0 = 128 * tb;
    typedef float f32x4v __attribute__((ext_vector_type(4)));
    f32x4v acc[8][2];
#pragma unroll
    for (int rb = 0; rb < 8; ++rb) { acc[rb][0] = (f32x4v){0.f, 0.f, 0.f, 0.f}; acc[rb][1] = (f32x4v){0.f, 0.f, 0.f, 0.f}; }
    const bf16* ar = hbuf + (size_t)(r0 + i16) * DM + 128 * wid + 8 * kg;
    const bf16* br = wt + (size_t)(C_FB + i16) * DM + 128 * wid + 8 * kg;
#pragma unroll 2
    for (int s4 = 0; s4 < 4; ++s4) {
        bf16x8 af[8];
#pragma unroll
        for (int rb = 0; rb < 8; ++rb) af[rb] = *(const GAS bf16x8*)(ar + (size_t)rb * 16 * DM + 32 * s4);
        const bf16x8 b0 = *(const GAS bf16x8*)(br + 32 * s4), b1 = *(const GAS bf16x8*)(br + (size_t)16 * DM + 32 * s4);
#pragma unroll
        for (int rb = 0; rb < 8; ++rb) { acc[rb][0] = __builtin_amdgcn_mfma_f32_16x16x32_bf16(af[rb], b0, acc[rb][0], 0, 0, 0); acc[rb][1] = __builtin_amdgcn_mfma_f32_16x16x32_bf16(af[rb], b1, acc[rb][1], 0, 0, 0); } }
    LAS float* part = (LAS float*)lds;
#pragma unroll
    for (int rb = 0; rb < 8; ++rb)
#pragma unroll
        for (int cb = 0; cb < 2; ++cb)
#pragma unroll
            for (int e = 0; e < 4; ++e) part[(wid * 64 + (rb * 2 + cb) * 4 + e) * 64 + lane] = acc[rb][cb][e];
    ATT_BAR();
#pragma unroll
    for (int q = 0; q < 8; ++q) { const int rr = 8 * wid + q; float v = 0.f;
#pragma unroll
        for (int w8 = 0; w8 < 8; ++w8) v += part[(w8 * 64 + rr) * 64 + lane];
        const int rb = rr >> 3, cb = (rr >> 2) & 1, e = rr & 3, row = r0 + 16 * rb + 4 * kg + e, c = 16 * cb + i16;
        if (c < 4) { const float z = v + fbias[c]; logf[(size_t)((row / SEQ) * 4 + c) * SEQ + (row % SEQ)] = fminf(z, 0.f) - log1pf(__expf(-fabsf(z))); }
        else if (c < 28) gates[(size_t)row * 24 + (c - 4)] = 1.f / (1.f + __expf(-v)); }
    ATT_BAR();
}
__device__ __forceinline__ void prep_phase(LAS unsigned char* lds, int wv, const bf16* proj, const bf16* w1t, const bf16* w2t, const float* cb1, bf16* kcmp, bf16* vcmp,
                                           const bf16* hbuf, const bf16* wint, const float* fbias, float* logf, float* gates) {
    int G = gridDim.x, bx = blockIdx.x; asm volatile("" : "+s"(G), "+s"(bx));
    for (int tb = bx; tb < M / 128; tb += G) thin_block(lds, wv, hbuf, wint, fbias, logf, gates, tb);
    for (int u = bx; u < 256; u += G) compress_unit(lds, wv, proj, w1t, w2t, cb1, kcmp, vcmp, u);
}
}
#define GBX() int G = G0, bx = bx0; asm volatile("" : "+s"(G), "+s"(bx))
#define FRAME() GBX(); Frame F; { int t_ = wv * 64 + lane_id_fresh(); asm volatile("" : "+v"(t_)); F.lds = lds_raw; F.tid = t_; F.lane = t_ & 63; F.wave = __builtin_amdgcn_readfirstlane(t_ >> 6); \
        const int vcu_ = (G % 8 == 0) ? (bx % 8) * (G / 8) + bx / 8 : bx; F.gw = vcu_ * NWAVES + F.wave; F.NGW = G * NWAVES; }
#define GRID_BAR() do { if (KINT(5)) xcd_barrier(bar); } while (0)
#define WSB(off) (KWS + (off))
#define P_H ((bf16*)WSB(WS_RH))
#define P_O ((bf16*)WSB(WS_RH))
#define P_PROJ ((bf16*)WSB(WS_R1))
#define P_U ((bf16*)WSB(WS_R1))
#define P_Y ((bf16*)WSB(WS_Y))
#define P_Y2 ((bf16*)WSB(WS_Y + 64 * MiB))
#define P_MOD(l) ((const float*)WSB(WS_MOD) + (size_t)(l) * 8 * 6144)
#define P_WL(l, off) ((const bf16*)(WSB(WS_W) + (size_t)(l) * WL_STRIDE + (off)))
#define IN(p) (KINT(2) <= (p) && (p) < KINT(3))
template <int l>
__device__ __forceinline__ void layer_body(LAS unsigned char* lds_raw, int wv, const XcdBarrier& bar, int G0, int bx0) {
    if (!(l >= KINT(0) && l < KINT(1))) return;
        if (IN(PH_PROJ)) for (int rep = 0; rep <= ((KINT(7) >> PH_PROJ) & 1); ++rep) {
            GBX(); pg8::Gemm g{P_H, P_WL(l, WL_IN), M, C_FB, DM}; pg8::StaticOrder S; S.init(M, C_FB, G, bx);
            pg8::EpiProj E{P_PROJ, (float*)WSB(WS_LOGF), (float*)WSB(WS_GATES), KIN(10) + l * 4};
            pg8::gemm_phase<pg8::EpiProj, pg8::StaticOrder, true, true>(lds_raw, g, S, E, wv);
            GRID_BAR();
        }
        if (IN(PH_PREP)) for (int rep = 0; rep <= ((KINT(7) >> PH_PREP) & 1); ++rep) {
            att::prep_phase(lds_raw, wv, P_PROJ, P_WL(l, WL_CW1), P_WL(l, WL_CW2), (const float*)WSB(WS_CB1) + l * 256, (bf16*)WSB(WS_KCMP), (bf16*)WSB(WS_VCMP),
                            P_H, P_WL(l, WL_IN), KIN(10) + l * 4, (float*)WSB(WS_LOGF), (float*)WSB(WS_GATES));
            GRID_BAR();
        }
        if (IN(PH_ATT)) for (int rep = 0; rep <= ((KINT(7) >> PH_ATT) & 1); ++rep) {
            if ((rep ? KINT(7) >> 16 : KINT(6)) & 4) att::nsa_phase(lds_raw, wv, P_PROJ, (const bf16*)WSB(WS_KCMP), (const bf16*)WSB(WS_VCMP), (const float*)WSB(WS_B2), (const float*)WSB(WS_GATES), P_O, (float*)WSB(WS_SS), (unsigned*)KWS + CW_Q + 64 * (16 * rep + 4 * l + 1));
            if ((rep ? KINT(7) >> 16 : KINT(6)) & 1) att::fox_phase(lds_raw, wv, P_PROJ, (const float*)WSB(WS_LOGF), P_O, (float*)WSB(WS_SS), (unsigned*)KWS + CW_Q + 64 * (16 * rep + 4 * l + 0));
            if ((rep ? KINT(7) >> 16 : KINT(6)) & 2) att::swa_phase(lds_raw, wv, P_PROJ, (const float*)WSB(WS_B2), KIN(11) + l * 4, P_O, (float*)WSB(WS_SS), (unsigned*)KWS + CW_Q + 64 * (16 * rep + 4 * l + 2));
            GRID_BAR();
        }
        if (IN(PH_WOUT)) for (int rep = 0; rep <= ((KINT(7) >> PH_WOUT) & 1); ++rep) {
            GBX(); pg8::Gemm g{P_O, P_WL(l, WL_OUT), M, DM, DM}; pg8::StaticOrder S; S.init(M, DM, G, bx);
            LAS f32x4* rf = (LAS f32x4*)(lds_raw + L_RF);
            pg8::Unit u0, u1; const bool h0 = S.next(0, u0), h1 = S.next(1, u1);
            { int t_ = wv * 64 + lane_id_fresh(); asm volatile("" : "+v"(t_));
              const bool hv = t_ < 256 ? h0 : h1; const int row = (t_ < 256 ? u0.pm : u1.pm) * 256 + (t_ & 255);
              if (hv) { const GAS f32x4* sp = (const GAS f32x4*)((const float*)WSB(WS_SS) + (size_t)row * 16); const f32x4 a = sp[0], b = sp[1], c = sp[2], d = sp[3];
                  const float qa = ((a[0] + a[1]) + (a[2] + a[3])) * (1.f / 256.f) + RMS_EPS, qb = ((b[0] + b[1]) + (b[2] + b[3])) * (1.f / 256.f) + RMS_EPS,
                              qc = (((c[0] + c[1]) + (c[2] + c[3])) + ((d[0] + d[1]) + (d[2] + d[3]))) * (1.f / 512.f) + RMS_EPS;
                  rf[t_] = (f32x4){sqrtf(qb / qa), sqrtf(qc / qb), rsqrtf(qc), 0.f}; } }
            __syncthreads();
            pg8::EpiYGn E{P_Y, DM, rf, u0.pm}; pg8::GnHook KH{rf};
            pg8::gemm_phase<pg8::EpiYGn, pg8::StaticOrder, true, true, pg8::GnHook>(lds_raw, g, S, E, wv, KH);
            GRID_BAR();
        }
        if (IN(PH_NORM2)) for (int rep = 0; rep <= ((KINT(7) >> PH_NORM2) & 1); ++rep) { FRAME(); norm_phase(F, KIN(0), P_Y, KIN(6) + l * DM, P_MOD(l), 2, nullptr, nullptr, 0, nullptr, KIN(7) + l * DM, P_MOD(l), 4, 3, P_H, l == 0 ? (const bf16*)nullptr : (const bf16*)KOUT); GRID_BAR(); }
        if (IN(PH_GU)) for (int rep = 0; rep <= ((KINT(7) >> PH_GU) & 1); ++rep) {
            GBX(); pg8::Gemm g{P_H, P_WL(l, WL_GU), M, 2 * FFN, DM}; pg8::StaticOrder S; S.init(M, 2 * FFN, G, bx);
            pg8::EpiSwiglu E{P_U};
            pg8::gemm_phase<pg8::EpiSwiglu, pg8::StaticOrder, true, true>(lds_raw, g, S, E, wv);
            GRID_BAR();
        }
        if (IN(PH_DOWN)) for (int rep = 0; rep <= ((KINT(7) >> PH_DOWN) & 1); ++rep) {
            GBX(); pg8::Gemm g{P_U, P_WL(l, WL_DOWN), M, DM, FFN}; pg8::StaticOrder S; S.init(M, DM, G, bx);
            pg8::EpiY E{P_Y2, DM};
            pg8::gemm_phase<pg8::EpiY, pg8::StaticOrder, true, true>(lds_raw, g, S, E, wv);
            GRID_BAR();
        }
        if (IN(PH_NORM3)) {
            const bool last = (l == DEPTH - 1); FRAME();
            norm_phase(F, KIN(0), P_Y, KIN(6) + l * DM, P_MOD(l), 2, P_Y2, KIN(8) + l * DM, 5, KOUT, KIN(5) + (last ? l : l + 1) * DM, P_MOD(last ? l : l + 1), 1, 0, last ? (bf16*)nullptr : P_H,
                       l == 0 ? (const bf16*)nullptr : (const bf16*)KOUT, last ? (bf16*)nullptr : (bf16*)KOUT);
            if (!last) GRID_BAR();
        }
}
__global__ void __launch_bounds__(NTHR, 2) __attribute__((target("no-packed-fp32-ops"))) mega(MArgs a) {
    extern __shared__ __attribute__((aligned(16))) unsigned char lds_dyn[];
    LAS unsigned char* lds_raw = (LAS unsigned char*)lds_dyn;
    const int G0 = gridDim.x, bx0 = blockIdx.x;
    const int wv = __builtin_amdgcn_readfirstlane((int)(threadIdx.x >> 6));
    { FRAME();
    for (int u = F.tid; u < (LDS_BYTES - LDSCTL_OFF) / 4; u += NTHR) ((LAS unsigned*)(F.lds + LDSCTL_OFF))[u] = 0u;
    __syncthreads(); }
    XcdBarrier bar; bar.bar = (unsigned*)KWS + CW_BAR; bar.x = 0; bar.st = nullptr; bar.wv = wv;
    if (KINT(5)) bar = xcd_barrier_post((unsigned*)KWS + CW_BAR, (volatile LAS unsigned*)(lds_raw + LDSCTL_OFF + 32), wv);
    if (KINT(4) & 1) for (int rep = 0; rep <= ((KINT(7) >> 9) & 1); ++rep) { FRAME(); pro_a(F); GRID_BAR(); }
    if (KINT(4) & 2) { FRAME(); cb1_finish(F); norm_phase(F, KIN(0), nullptr, nullptr, nullptr, 0, nullptr, nullptr, 0, nullptr, KIN(5), P_MOD(0), 1, 0, P_H); GRID_BAR(); }
    layer_body<0>(lds_raw, wv, bar, G0, bx0);
    layer_body<1>(lds_raw, wv, bar, G0, bx0);
    layer_body<2>(lds_raw, wv, bar, G0, bx0);
    layer_body<3>(lds_raw, wv, bar, G0, bx0);
}
#ifndef DUP_MASK
#define DUP_MASK 0
#endif
extern "C" void kernel_launch(void* const* d_in, const int* in_sizes, int n_in, void* d_out, int out_size, void* d_ws, size_t ws_size, hipStream_t stream) {
    if (n_in != 20 || out_size != M * DM || ws_size < WS_END) { fprintf(stderr, "kernel_launch: unexpected sizes n_in %d out %d ws %zu\n", n_in, out_size, ws_size); return; }
    static int grid = 0;
    if (grid == 0) {
        int dev = 0, cus = 0;
        if (hipGetDevice(&dev) != hipSuccess || hipDeviceGetAttribute(&cus, hipDeviceAttributeMultiprocessorCount, dev) != hipSuccess) { grid = -1; return; }
        if (hipFuncSetAttribute((const void*)mega, hipFuncAttributeMaxDynamicSharedMemorySize, LDS_BYTES) != hipSuccess) { fprintf(stderr, "hipFuncSetAttribute failed\n"); grid = -1; return; }
        int per_cu = 0;
        if (hipOccupancyMaxActiveBlocksPerMultiprocessor(&per_cu, (const void*)mega, NTHR, LDS_BYTES) != hipSuccess || per_cu < 1) { fprintf(stderr, "occupancy query reports %d workgroups per CU\n", per_cu); (void)hipGetLastError(); grid = -1; return; }
        grid = cus;
        if (grid != 256) { fprintf(stderr, "kernel_launch: this kernel is laid out for a 256-CU device (one workgroup per CU); found %d CUs\n", cus); grid = -1; return; }
    }
    if (grid < 0) return;
    (void)hipMemsetAsync(d_ws, 0, 64 * 1024, stream);
    MArgs a{};
    for (int i = 0; i < 20; ++i) a.in[i] = (const float*)d_in[i];
    a.out = (float*)d_out; a.ws = (unsigned char*)d_ws;
    a.lay_lo = 0; a.lay_hi = DEPTH; a.ph_lo = 0; a.ph_hi = NPH; a.do_pro = 3; a.use_bar = 1; a.att_mask = 7; a.pad = DUP_MASK;
    hipLaunchKernelGGL(mega, dim3(grid), dim3(NTHR), LDS_BYTES, stream, a);
}
```

```cpp
#include <hip/hip_runtime.h>
#include <cstdio>
#include <cstdint>
#include <type_traits>

#ifndef F32_MODE
#define F32_MODE 0
#endif

constexpr int DM = 1024, NB = 8, SEQ = 4096, DEPTH = 4, HD = 64;
constexpr int M = NB * SEQ;
constexpr int NIN = 2588, NPROJ = 2816, FFN = 2816;
constexpr float RMS_EPS = 1e-6f;
constexpr float LOG2E = 1.4426950408889634f;
constexpr float QSCALE = 0.125f * LOG2E;
constexpr int C_QA = 0, C_KA = 256, C_VA = 384, C_QB = 512, C_KB = 768, C_VB = 1024, C_QC = 1280, C_KC = 1792, C_VC = 1920,
              C_KS = 2048, C_VS = 2176, C_KW = 2304, C_VW = 2432, C_FB = 2560, C_GC = 2564;

#if F32_MODE
typedef float act_t;
__device__ __forceinline__ float ldA(const act_t* p) { return *p; }
__device__ __forceinline__ void stA(act_t* p, float v) { *p = v; }
#else
typedef unsigned short act_t;
__device__ __forceinline__ float ldA(const act_t* p) { return __uint_as_float(((unsigned)*p) << 16); }
__device__ __forceinline__ void stA(act_t* p, float v) { unsigned u = __float_as_uint(v); *p = (act_t)((u + 0x7fffu + ((u >> 16) & 1u)) >> 16); }
#endif

constexpr size_t MiB = 1u << 20;
constexpr size_t WS_MOD = 1 * MiB, WS_LOGF = 2 * MiB, WS_CUM = 2 * MiB + 512 * 1024, WS_GATES = 3 * MiB, WS_KCMP = 6 * MiB, WS_VCMP = 7 * MiB,
                 WS_SEL = 8 * MiB, WS_IMP = 9 * MiB, WS_STATS = 25 * MiB;
#if F32_MODE
constexpr size_t WS_RH = 32 * MiB, WS_R1 = 160 * MiB, WS_Y = WS_R1, WS_Y2 = WS_RH, WS_END = 512 * MiB;
#else
constexpr size_t WS_RH = 32 * MiB, WS_Y = 96 * MiB, WS_Y2 = WS_Y, WS_R1 = 224 * MiB, WS_W = 400 * MiB, WS_END = 512 * MiB;
#endif

__device__ __forceinline__ int t5_bucket(int dist) {
    if (dist < 16) return dist < 0 ? 0 : dist;
    int b = 16;
    b += dist >= 21; b += dist >= 27; b += dist >= 35; b += dist >= 46; b += dist >= 59; b += dist >= 77; b += dist >= 99; b += dist >= 128;
    b += dist >= 166; b += dist >= 216; b += dist >= 280; b += dist >= 363; b += dist >= 470; b += dist >= 609; b += dist >= 790;
    return b;
}
__device__ __forceinline__ float wave_sum(float v) {
#pragma unroll
    for (int o = 1; o < 64; o <<= 1) v += __shfl_xor(v, o);
    return v;
}

__device__ __forceinline__ int lane_id_fresh() { int x; asm volatile("v_mbcnt_lo_u32_b32 %0, -1, 0\n\tv_mbcnt_hi_u32_b32 %0, -1, %0" : "=v"(x)); return x; }
namespace pg8 {
#define PG8_LAS __attribute__((address_space(3)))
typedef unsigned short bf16_t;
typedef short bf16x8 __attribute__((ext_vector_type(8)));
typedef float f32x4 __attribute__((ext_vector_type(4)));
typedef unsigned u32x4 __attribute__((ext_vector_type(4)));
constexpr int BM = 256, BK = 64, HALF = 128, HTB = HALF * BK * 2  , STAGE_BYTES = 8 * HTB, NXCD = 8, WGM = 8;

__host__ __device__ __forceinline__ int lds_byte(int r, int c) { const int st = (r >> 4) * 2 + (c >> 5), rr = r & 15, cc = c & 31, ob = rr * 64 + cc * 2; return st * 1024 + (ob ^ (((ob >> 9) & 1) << 5)); }
__host__ __device__ __forceinline__ void stage_rc(int b, int& R, int& C) { const int st = b / 1024, sb = b % 1024, swz = sb ^ (((sb >> 9) & 1) << 5); R = (st >> 1) * 16 + swz / 64; C = (st & 1) * 32 + (swz % 64) / 2; }
__host__ __device__ __forceinline__ int perm32(int rho) { const int n = rho >> 4, i = rho & 15; return 8 * (i >> 2) + 4 * n + (i & 3); }

struct Unit { int pm, pn; };
struct Gemm { const bf16_t* A; const bf16_t* Bt; int M, N, K; };

struct StaticOrder {
    int nM, nN, nwg, G, c;
    __host__ __device__ __forceinline__ void init(int M, int N, int G_, int c_) { nM = M / BM; nN = N / BM; nwg = nM * nN; G = G_; c = c_; }
    __host__ __device__ __forceinline__ bool next(int i, Unit& u) const {
        const long L = (long)i * G + c; if (L >= nwg) return false;
        int wgid = (int)L; { const int q = nwg / NXCD, r = nwg % NXCD, xcd = wgid % NXCD, off = wgid / NXCD; wgid = (xcd < r ? xcd * (q + 1) : r * (q + 1) + (xcd - r) * q) + off; }
        const int nig = WGM * nN, gid = wgid / nig, fm = gid * WGM, gsz = (nM - fm) < WGM ? (nM - fm) : WGM;
        u.pm = fm + ((wgid % nig) % gsz); u.pn = (wgid % nig) / gsz; return true;
    }
    __device__ __forceinline__ void a_ready(const Unit&) const {}
    __device__ __forceinline__ void done(const Unit&) const {}
};

__device__ __forceinline__ unsigned cvt_pk_bf16(float lo, float hi) { unsigned r; asm volatile("v_cvt_pk_bf16_f32 %0, %1, %2" : "=v"(r) : "v"(lo), "v"(hi)); return r; }
struct NoKHook { static constexpr bool ACTIVE = false; };
template <class Epi, class Sched, bool ALIGN_EPI = false, bool SP2 = false, class KH = NoKHook>
__device__ __forceinline__ void gemm_phase(PG8_LAS unsigned char* lds, const Gemm g, const Sched& S, const Epi& E, int wv, const KH& kh = KH()) {
    int tid_l = wv * 64 + lane_id_fresh(); asm volatile("" : "+v"(tid_l));
    const int tid = tid_l, wid = __builtin_amdgcn_readfirstlane(tid >> 6), lane = tid & 63, wr = wid >> 2, wc = wid & 3, fr = lane & 15, fq = lane >> 4;
    const int K = g.K, nt = K / BK;
    unsigned voffA[2], voffB[2];
#pragma unroll
    for (int i = 0; i < 2; ++i) { int R, C; stage_rc(tid * 16 + i * 8192, R, C); const int Rb = Epi::PERM ? ((R & ~31) + perm32(R & 31)) : R;
        voffA[i] = (unsigned)(R * K + C) * 2u; voffB[i] = (unsigned)(Rb * K + C) * 2u; }
    const size_t kstep = (size_t)(BK * 2);
    const size_t hstep = (size_t)HALF * K * 2;
    const size_t tstep = 2 * hstep;
    const unsigned ldsw = (unsigned)wid * 1024u;
    const int aoff = lds_byte(wr * 64 + fr, fq * 8), boff = lds_byte(wc * 32 + fr, fq * 8);
#define PG8_SA(b, h) (((b) * 2 + (h)) * HTB)
#define PG8_SB(b, h) ((4 + (b) * 2 + (h)) * HTB)
#define PG8_STAGE(bufoff, gbase, voff) do { _Pragma("unroll") for (int _i = 0; _i < 2; ++_i) \
        __builtin_amdgcn_global_load_lds((const unsigned*)((const char*)(gbase) + (voff)[_i]), (PG8_LAS unsigned*)(lds + (bufoff) + ldsw + _i * 8192), 16, 0, 0); } while (0)
#define PG8_LDA(dst, b, h) do { _Pragma("unroll") for (int m = 0; m < 4; ++m) _Pragma("unroll") for (int k = 0; k < 2; ++k) dst[m][k] = *(const PG8_LAS bf16x8*)(lds + PG8_SA(b, h) + aoff + m * 2048 + k * 1024); } while (0)
#define PG8_LDB(dst, b, h) do { _Pragma("unroll") for (int n = 0; n < 2; ++n) _Pragma("unroll") for (int k = 0; k < 2; ++k) dst[n][k] = *(const PG8_LAS bf16x8*)(lds + PG8_SB(b, h) + boff + n * 2048 + k * 1024); } while (0)
#define PG8_MMA(ai, bj, At, Bt) do { __builtin_amdgcn_s_setprio(1); _Pragma("unroll") for (int m = 0; m < 4; ++m) _Pragma("unroll") for (int n = 0; n < 2; ++n) _Pragma("unroll") for (int k = 0; k < 2; ++k) \
        acc[ai][bj][m][n] = __builtin_amdgcn_mfma_f32_16x16x32_bf16(Bt[n][k], At[m][k], acc[ai][bj][m][n], 0, 0, 0); __builtin_amdgcn_s_setprio(0); } while (0)
#define PG8_WAIT_V(n) asm volatile("s_waitcnt vmcnt(" #n ")" ::: "memory")
#define PG8_WAIT_L(n) asm volatile("s_waitcnt lgkmcnt(" #n ")" ::: "memory")
#define PG8_BAR __builtin_amdgcn_s_barrier()
#define PG8_SCHED __builtin_amdgcn_sched_barrier(0)
    Unit cur, nxt; int ui = 0;
    if (!S.next(0, cur)) return;
    f32x4 acc[2][2][4][2];
#pragma unroll
    for (int a = 0; a < 2; ++a)
#pragma unroll
        for (int b = 0; b < 2; ++b)
#pragma unroll
            for (int m = 0; m < 4; ++m)
#pragma unroll
                for (int n = 0; n < 2; ++n) acc[a][b][m][n] = (f32x4){0.f, 0.f, 0.f, 0.f};
    bf16x8 At[4][2], B0[2][2], B1[2][2];
    const char* cA = (const char*)g.A + (size_t)cur.pm * tstep; const char* cB = (const char*)g.Bt + (size_t)cur.pn * tstep;
    S.a_ready(cur);
    if constexpr (SP2) {
        PG8_STAGE(PG8_SB(0, 0), cB, voffB); PG8_STAGE(PG8_SB(0, 1), cB + hstep, voffB); PG8_STAGE(PG8_SA(0, 0), cA, voffA); PG8_STAGE(PG8_SA(0, 1), cA + hstep, voffA);
        if (wr == 1) PG8_BAR;
        PG8_WAIT_V(2); PG8_BAR;
        PG8_STAGE(PG8_SB(1, 0), cB + kstep, voffB); PG8_STAGE(PG8_SA(1, 0), cA + kstep, voffA); PG8_STAGE(PG8_SB(1, 1), cB + hstep + kstep, voffB);
        PG8_WAIT_V(6); PG8_BAR;
    } else {
        PG8_STAGE(PG8_SB(0, 0), cB, voffB); PG8_STAGE(PG8_SA(0, 0), cA, voffA); PG8_STAGE(PG8_SB(0, 1), cB + hstep, voffB); PG8_STAGE(PG8_SA(0, 1), cA + hstep, voffA);
        if (wr == 1) PG8_BAR;
        PG8_WAIT_V(4); PG8_BAR;
        PG8_STAGE(PG8_SB(1, 0), cB + kstep, voffB); PG8_STAGE(PG8_SA(1, 0), cA + kstep, voffA); PG8_STAGE(PG8_SB(1, 1), cB + hstep + kstep, voffB);
        PG8_WAIT_V(6); PG8_BAR;
    }
    for (;;) {
        const bool has_next = S.next(ui + 1, nxt);
        const char* nA = has_next ? (const char*)g.A + (size_t)nxt.pm * tstep : cA; const char* nB = has_next ? (const char*)g.Bt + (size_t)nxt.pn * tstep : cB;
        for (int t = 0; t < nt; t += 2) {
            if constexpr (KH::ACTIVE) { if (t == KH::T1 || t == KH::T2) kh.apply(acc, t, ui, wr, fr); }
            const bool last = (t == nt - 2);
            const char* a1 = cA + (size_t)(t + 1) * kstep;
            const char* a2 = last ? nA : cA + (size_t)(t + 2) * kstep; const char* b2 = last ? nB : cB + (size_t)(t + 2) * kstep;
            const char* a3 = a2 + kstep; const char* b3 = b2 + kstep;
            if (last && has_next) S.a_ready(nxt);
            if constexpr (SP2) {
            PG8_LDB(B0, 0, 0); PG8_LDB(B1, 0, 1); PG8_SCHED; PG8_LDA(At, 0, 0); PG8_STAGE(PG8_SA(1, 1), a1 + hstep, voffA);
            PG8_WAIT_V(8); PG8_WAIT_L(0); PG8_BAR; PG8_MMA(0, 0, At, B0); PG8_MMA(0, 1, At, B1); PG8_BAR; PG8_SCHED;
            PG8_LDA(At, 0, 1); PG8_STAGE(PG8_SB(0, 0), b2, voffB); PG8_STAGE(PG8_SB(0, 1), b2 + hstep, voffB); PG8_STAGE(PG8_SA(0, 0), a2, voffA);
            PG8_WAIT_V(8); PG8_WAIT_L(0); PG8_BAR; PG8_MMA(1, 0, At, B0); PG8_MMA(1, 1, At, B1); PG8_BAR; PG8_SCHED;
            PG8_LDB(B0, 1, 0); PG8_LDB(B1, 1, 1); PG8_SCHED; PG8_LDA(At, 1, 0); PG8_STAGE(PG8_SA(0, 1), a2 + hstep, voffA);
            PG8_WAIT_V(8); PG8_WAIT_L(0); PG8_BAR; PG8_MMA(0, 0, At, B0); PG8_MMA(0, 1, At, B1); PG8_BAR; PG8_SCHED;
            PG8_LDA(At, 1, 1); PG8_STAGE(PG8_SB(1, 0), b3, voffB); PG8_STAGE(PG8_SB(1, 1), b3 + hstep, voffB); PG8_STAGE(PG8_SA(1, 0), a3, voffA);
            PG8_WAIT_V(8); PG8_WAIT_L(0); PG8_BAR; PG8_MMA(1, 0, At, B0); PG8_MMA(1, 1, At, B1); PG8_BAR; PG8_SCHED;
            } else {
            PG8_LDB(B0, 0, 0); PG8_SCHED; PG8_LDA(At, 0, 0); PG8_STAGE(PG8_SA(1, 1), a1 + hstep, voffA);
            PG8_WAIT_L(8); PG8_BAR; PG8_WAIT_L(0); PG8_MMA(0, 0, At, B0); PG8_BAR; PG8_SCHED;
            PG8_LDB(B1, 0, 1); PG8_STAGE(PG8_SB(0, 0), b2, voffB);
            PG8_BAR; PG8_WAIT_L(0); PG8_MMA(0, 1, At, B1); PG8_BAR;
            PG8_LDA(At, 0, 1); PG8_STAGE(PG8_SA(0, 0), a2, voffA);
            PG8_BAR; PG8_WAIT_L(0); PG8_MMA(1, 0, At, B0); PG8_BAR; PG8_SCHED;
            PG8_STAGE(PG8_SB(0, 1), b2 + hstep, voffB);
            PG8_WAIT_V(6); PG8_BAR; PG8_MMA(1, 1, At, B1); PG8_BAR;
            PG8_LDB(B0, 1, 0); PG8_SCHED; PG8_LDA(At, 1, 0); PG8_STAGE(PG8_SA(0, 1), a2 + hstep, voffA);
            PG8_WAIT_L(8); PG8_BAR; PG8_WAIT_L(0); PG8_MMA(0, 0, At, B0); PG8_BAR; PG8_SCHED;
            PG8_LDB(B1, 1, 1); PG8_STAGE(PG8_SB(1, 0), b3, voffB);
            PG8_BAR; PG8_WAIT_L(0); PG8_MMA(0, 1, At, B1); PG8_BAR;
            PG8_LDA(At, 1, 1); PG8_STAGE(PG8_SA(1, 0), a3, voffA);
            PG8_BAR; PG8_WAIT_L(0); PG8_MMA(1, 0, At, B0); PG8_BAR; PG8_SCHED;
            PG8_STAGE(PG8_SB(1, 1), b3 + hstep, voffB);
            PG8_WAIT_V(6); PG8_BAR; PG8_MMA(1, 1, At, B1); PG8_BAR;
            }
        }
        if constexpr (ALIGN_EPI) { if (wr == 0) PG8_BAR; }
        if constexpr (!Epi::AFTER_DRAIN) { E(acc, cur, wr, wc, fr, fq); S.done(cur); }
        if (!has_next) break;
#pragma unroll
        for (int a = 0; a < 2; ++a)
#pragma unroll
            for (int b = 0; b < 2; ++b)
#pragma unroll
                for (int m = 0; m < 4; ++m)
#pragma unroll
                    for (int n = 0; n < 2; ++n) acc[a][b][m][n] = (f32x4){0.f, 0.f, 0.f, 0.f};
        cur = nxt; cA = nA; cB = nB; ++ui;
        if constexpr (ALIGN_EPI) { if (wr == 1) PG8_BAR; }
    }
    PG8_WAIT_V(0);
    if constexpr (!ALIGN_EPI) { if (wr == 0) PG8_BAR; }
    PG8_BAR;
    if constexpr (Epi::AFTER_DRAIN) { E.fused(acc, cur, wr, wc, fr, fq, lds, wid, lane); S.done(cur); }
#undef PG8_SA
#undef PG8_SB
#undef PG8_STAGE
#undef PG8_LDA
#undef PG8_LDB
#undef PG8_MMA
#undef PG8_WAIT_V
#undef PG8_WAIT_L
#undef PG8_BAR
#undef PG8_SCHED
}
}
#define LAS __attribute__((address_space(3)))
#define XB_TMO      128
#define XB_XCNT(j)  (256  + 64 * (j))
#define XB_XSUB(j)  (1280 + 64 * (j))
#define XB_XGEN(j)  (2304 + 64 * (j))
#define XB_TOP      3328
#define XB_TOPGEN   3392
#define XCD_BAR_WORDS 3456
#define XB_SPIN_CAP (1u << 18)

__device__ __forceinline__ unsigned xb_ld(unsigned* p)              { return __hip_atomic_load(p, __ATOMIC_RELAXED, __HIP_MEMORY_SCOPE_AGENT); }
__device__ __forceinline__ unsigned xb_add(unsigned* p, unsigned v) { return __hip_atomic_fetch_add(p, v, __ATOMIC_RELAXED, __HIP_MEMORY_SCOPE_AGENT); }
__device__ __forceinline__ unsigned xb_xcc_id() { return (unsigned)__builtin_amdgcn_s_getreg((3 << 11) | 20) & 0xFu; }
#define XB_SPIN(cond, bar) do { unsigned _sp = 0; while (cond) { __builtin_amdgcn_s_sleep(1); \
    if ((++_sp & 255u) == 0u) { if (xb_ld(&(bar)[XB_TMO])) break; if (_sp > XB_SPIN_CAP) { atomicAdd(&(bar)[XB_TMO], 1u); break; } } } } while (0)

struct XcdBarrier {
    unsigned* bar; unsigned x; int wv;
    volatile LAS unsigned* st;
};

__device__ __forceinline__ bool xb_thread0(int wv) { return wv == 0 && lane_id_fresh() == 0; }
__device__ __forceinline__ XcdBarrier xcd_barrier_post(unsigned* bar, volatile LAS unsigned* st, int wv) {
    XcdBarrier b; b.bar = bar; b.x = xb_xcc_id(); b.st = st; b.wv = wv;
    if (xb_thread0(wv)) (void)xb_add(&bar[XB_XCNT(b.x)], 1u);
    return b;
}
__device__ __forceinline__ void xcd_barrier_complete(unsigned* bar, unsigned x, unsigned& nloc, unsigned& nx) {
    const unsigned G = gridDim.x * gridDim.y * gridDim.z;
    unsigned sum, cnt, mine, sp = 0u;
    for (;;) {
        sum = 0u; cnt = 0u; mine = 0u;
#pragma unroll
        for (unsigned j = 0; j < 16; ++j) { const unsigned c = xb_ld(&bar[XB_XCNT(j)]); sum += c; cnt += (c > 0u) ? 1u : 0u; mine = (j == x) ? c : mine; }
        if (sum == G) break;
        __builtin_amdgcn_s_sleep(1);
        if ((++sp & 255u) == 0u) { if (xb_ld(&bar[XB_TMO])) break; if (sp > XB_SPIN_CAP) { atomicAdd(&bar[XB_TMO], 1u); break; } }
    }
    nloc = mine > 0u ? mine : 1u; nx = cnt > 0u ? cnt : 1u;
}

__device__ __forceinline__ void xcd_barrier(const XcdBarrier& b) {
    asm volatile("s_waitcnt vmcnt(0)" ::: "memory");
    __syncthreads();
    if (xb_thread0(b.wv)) {
        unsigned* bar = b.bar;
        __builtin_amdgcn_s_waitcnt(0);
        unsigned nloc = b.st[0], nx = b.st[1];
        if (nloc == 0u) { xcd_barrier_complete(bar, b.x, nloc, nx); b.st[0] = nloc; b.st[1] = nx; }
        const unsigned old = xb_add(&bar[XB_XSUB(b.x)], 1u);
        const unsigned gen = old / nloc;
        if (old + 1u == (gen + 1u) * nloc) {
            __builtin_amdgcn_fence(__ATOMIC_RELEASE, "agent");
            asm volatile("s_waitcnt vmcnt(0)" ::: "memory");
            const unsigned og = xb_add(&bar[XB_TOP], 1u);
            const unsigned tg = og / nx;
            if (og + 1u == (tg + 1u) * nx) xb_add(&bar[XB_TOPGEN], 1u);
            else XB_SPIN(xb_ld(&bar[XB_TOPGEN]) == tg, bar);
            __builtin_amdgcn_fence(__ATOMIC_ACQUIRE, "agent");
            xb_add(&bar[XB_XGEN(b.x)], 1u);
            asm volatile("s_waitcnt vmcnt(0)" ::: "memory");
        } else {
            XB_SPIN(xb_ld(&bar[XB_XGEN(b.x)]) == gen, bar);
            __builtin_amdgcn_fence(__ATOMIC_ACQUIRE, "agent");
            asm volatile("s_waitcnt vmcnt(0)" ::: "memory");
        }
    }
    __syncthreads();
}

#undef LAS
#define GAS __attribute__((address_space(1)))
#define LAS __attribute__((address_space(3)))
typedef unsigned short bf16;
typedef unsigned v4u __attribute__((ext_vector_type(4)));
typedef unsigned v2u __attribute__((ext_vector_type(2)));
typedef float f32x4 __attribute__((ext_vector_type(4)));
#define LDS_WAIT() asm volatile("s_waitcnt lgkmcnt(0)" ::: "memory")
#define VM_WAIT() asm volatile("s_waitcnt vmcnt(0)" ::: "memory")
__device__ __forceinline__ unsigned f2bf(float f) { unsigned u = __builtin_bit_cast(unsigned, f); return (u + 0x7fffu + ((u >> 16) & 1u)) >> 16; }
__device__ __forceinline__ unsigned pk2(float lo, float hi) { return f2bf(lo) | (f2bf(hi) << 16); }
__device__ __forceinline__ float bf_lo(unsigned w) { return __uint_as_float(w << 16); }
__device__ __forceinline__ float bf_hi(unsigned w) { return __uint_as_float(w & 0xffff0000u); }

constexpr int NWAVES = 8, NTHR = 512;
constexpr int RING_BYTES = 131072, LDSCTL_OFF = RING_BYTES, LDS_BYTES = 147456;
constexpr size_t WL_STRIDE = 26 * MiB, WL_IN = 0, WL_OUT = 6 * MiB, WL_GU = 8 * MiB, WL_DOWN = 19 * MiB, WL_CW2 = 24 * MiB + 512 * 1024, WL_CW1 = 25 * MiB;
constexpr size_t WS_SS = 9 * MiB;
constexpr int L_RF = LDSCTL_OFF + 2048;
constexpr size_t WS_B2 = 600 * 1024;
constexpr size_t WS_CB1P = 704 * 1024;
constexpr size_t WS_CB1 = 512 * 1024;
constexpr int CW_BAR = 1024, CW_Q = 8192;
static_assert(WS_W + 4 * WL_STRIDE <= WS_END, "weights fit");

enum { PH_PROJ = 0, PH_PREP = 1, PH_ATT = 2, PH_GN = 3, PH_WOUT = 4, PH_NORM2 = 5, PH_GU = 6, PH_DOWN = 7, PH_NORM3 = 8, NPH = 9 };
struct MArgs { const float* in[20]; float* out; unsigned char* ws; int lay_lo, lay_hi, ph_lo, ph_hi; int do_pro, use_bar, att_mask, pad; };

struct Frame { LAS unsigned char* lds; int tid, lane, wave, gw, NGW; };
typedef const __attribute__((address_space(4))) unsigned char* kargp_t;
__device__ __forceinline__ kargp_t kargp() { kargp_t p = (kargp_t)__builtin_amdgcn_kernarg_segment_ptr(); asm volatile("" : "+s"(p)); return p; }
#define KIN(i) (*(const float* const __attribute__((address_space(4)))*)(kargp() + 8 * (i)))
#define KOUT (*(float* const __attribute__((address_space(4)))*)(kargp() + 160))
#define KWS (*(unsigned char* const __attribute__((address_space(4)))*)(kargp() + 168))
#define KINT(k) (*(const int __attribute__((address_space(4)))*)(kargp() + 176 + 4 * (k)))
static_assert(sizeof(MArgs) == 208, "MArgs layout");

__device__ __forceinline__ int maprow(int code, int n) {
    switch (code) {
        case 1: return n < 1280 ? n : n < 1284 ? n + 1280 : n < 2564 ? n - 4 : n;
        case 2: return (n >> 7) * 256 + (n & 127);
        case 3: return (n >> 7) * 256 + 128 + (n & 127);
        default: return n;
    }
}
struct TrDesc { const float* W; int K, N; bf16* WT; int code; const float* ks; int item; };
__device__ __forceinline__ void tr_load(const TrDesc& d, f32x4 (&v)[8], int lane) {
    const int nblk = (d.N + 31) / 32, kb = d.item / nblk, nb = d.item % nblk, k0 = 64 * kb, n0 = 32 * nb;
    const int n4 = (lane & 7) * 4, nn = n0 + n4;
#pragma unroll
    for (int i = 0; i < 8; ++i) { const int kk = 8 * i + (lane >> 3);
        v[i] = nn < d.N ? *(const GAS f32x4*)(d.W + (size_t)(k0 + kk) * d.N + nn) : (f32x4){0.f, 0.f, 0.f, 0.f};
        if (d.ks) v[i] = v[i] * d.ks[k0 + kk]; }
}
__device__ __forceinline__ void tr_finish(const TrDesc& d, const f32x4 (&v)[8], LAS float* scr, int lane) {
    const int nblk = (d.N + 31) / 32, kb = d.item / nblk, nb = d.item % nblk, k0 = 64 * kb, n0 = 32 * nb;
    const int n4 = (lane & 7) * 4;
#pragma unroll
    for (int i = 0; i < 8; ++i) { const int kk = 8 * i + (lane >> 3);
        scr[kk * 33 + n4] = v[i].x; scr[kk * 33 + n4 + 1] = v[i].y; scr[kk * 33 + n4 + 2] = v[i].z; scr[kk * 33 + n4 + 3] = v[i].w; }
    LDS_WAIT(); asm volatile("" ::: "memory");
    const int c = lane & 7;
#pragma unroll
    for (int j = 0; j < 4; ++j) { const int n = (lane >> 3) + 8 * j; const LAS float* s = scr + (8 * c) * 33 + n;
        v4u o; o.x = pk2(s[0 * 33], s[1 * 33]); o.y = pk2(s[2 * 33], s[3 * 33]); o.z = pk2(s[4 * 33], s[5 * 33]); o.w = pk2(s[6 * 33], s[7 * 33]);
        if (n0 + n < d.N) *(GAS v4u*)(d.WT + (size_t)maprow(d.code, n0 + n) * d.K + k0 + 8 * c) = o; }
    LDS_WAIT(); asm volatile("" ::: "memory");
}

__device__ __forceinline__ void pro_a(const Frame& F) {
    unsigned char* ws = KWS;
    {
        LAS float* ca = (LAS float*)F.lds;
        LAS float* red = (LAS float*)(F.lds + 32768);
        const float* c = KIN(1);
        for (int i = F.tid; i < 8192; i += NTHR) { const float v = c[i]; ca[i] = v / (1.f + __expf(-v)); }
        __syncthreads();
        float* mod = (float*)(ws + WS_MOD);
        for (int task = blockIdx.x; task < DEPTH * 96; task += gridDim.x) {
            const int l = task / 96, n0 = (task % 96) * 64;
            const int cg = F.lane & 15, kq = F.lane >> 4;
            const float* w = KIN(3) + (size_t)l * 1024 * 6144 + n0 + 4 * cg;
            f32x4 acc[8];
#pragma unroll
            for (int b = 0; b < 8; ++b) acc[b] = (f32x4){0.f, 0.f, 0.f, 0.f};
            const int kb = F.wave * 128 + kq;
#pragma unroll 8
            for (int i = 0; i < 32; ++i) { const int k = kb + 4 * i; const f32x4 wv = *(const GAS f32x4*)(w + (size_t)k * 6144);
#pragma unroll
                for (int b = 0; b < 8; ++b) acc[b] += wv * ca[b * 1024 + k]; }
#pragma unroll
            for (int b = 0; b < 8; ++b)
#pragma unroll
                for (int e = 0; e < 4; ++e) { float v = acc[b][e]; v += __shfl_xor(v, 16); v += __shfl_xor(v, 32); if (kq == 0) red[(F.wave * 8 + b) * 64 + 4 * cg + e] = v; }
            __syncthreads();
            { const int b = F.tid >> 6, n = F.tid & 63; float s = 0.f;
#pragma unroll
              for (int wv = 0; wv < 8; ++wv) s += red[(wv * 8 + b) * 64 + n];
              mod[(size_t)(l * 8 + b) * 6144 + n0 + n] = s + KIN(4)[l * 6144 + n0 + n]; }
            __syncthreads();
        }
    }
    {
        LAS float* scr = (LAS float*)(F.lds + F.wave * 16384);
        constexpr int I_IN = 16 * 81, I_OUT = 16 * 32, I_G = 16 * 88, I_D = 44 * 32, I_C1 = 32 * 4, I_C2 = 2 * 2;
        constexpr int PER_L = I_IN + I_OUT + 2 * I_G + I_D + 2 * I_C1 + 2 * I_C2;
        auto decode = [&](int it, TrDesc& d) {
            const int l = it / PER_L; int r = it % PER_L;
            unsigned char* wl = ws + WS_W + (size_t)l * WL_STRIDE;
            if (r < I_IN) { d = TrDesc{KIN(9) + (size_t)l * DM * NIN, DM, NIN, (bf16*)(wl + WL_IN), 1, nullptr, r}; return; } r -= I_IN;
            if (r < I_OUT) { d = TrDesc{KIN(16) + (size_t)l * DM * DM, DM, DM, (bf16*)(wl + WL_OUT), 0, KIN(15) + l * DM, r}; return; } r -= I_OUT;
            if (r < I_G) { d = TrDesc{KIN(17) + (size_t)l * DM * FFN, DM, FFN, (bf16*)(wl + WL_GU), 2, nullptr, r}; return; } r -= I_G;
            if (r < I_G) { d = TrDesc{KIN(18) + (size_t)l * DM * FFN, DM, FFN, (bf16*)(wl + WL_GU), 3, nullptr, r}; return; } r -= I_G;
            if (r < I_D) { d = TrDesc{KIN(19) + (size_t)l * FFN * DM, FFN, DM, (bf16*)(wl + WL_DOWN), 0, nullptr, r}; return; } r -= I_D;
            if (r < 2 * I_C1) { const int kv = r / I_C1; d = TrDesc{KIN(13) + (size_t)(l * 2 + kv) * 2048 * 128, 2048, 128, (bf16*)(wl + WL_CW1) + (size_t)kv * 128 * 2048, 0, nullptr, r % I_C1}; return; } r -= 2 * I_C1;
            { const int kv = r / I_C2; d = TrDesc{KIN(14) + (size_t)(l * 2 + kv) * 128 * 64, 128, 64, (bf16*)(wl + WL_CW2) + (size_t)kv * 64 * 128, 0, nullptr, r % I_C2}; }
        };
        for (int it = F.gw; it < DEPTH * PER_L; it += 4 * F.NGW) {
            const int tot = DEPTH * PER_L; const bool h1 = it + F.NGW < tot, h2 = it + 2 * F.NGW < tot, h3 = it + 3 * F.NGW < tot;
            TrDesc d0, d1, d2, d3; decode(it, d0); decode(h1 ? it + F.NGW : it, d1); decode(h2 ? it + 2 * F.NGW : it, d2); decode(h3 ? it + 3 * F.NGW : it, d3);
            f32x4 v0[8], v1[8], v2[8], v3[8];
            tr_load(d0, v0, F.lane); if (h1) tr_load(d1, v1, F.lane); if (h2) tr_load(d2, v2, F.lane); if (h3) tr_load(d3, v3, F.lane);
            tr_finish(d0, v0, scr, F.lane); if (h1) tr_finish(d1, v1, scr, F.lane); if (h2) tr_finish(d2, v2, scr, F.lane); if (h3) tr_finish(d3, v3, scr, F.lane);
        }
        for (int it = F.gw; it < DEPTH * 228; it += F.NGW) { const int l = it / 228, row = NIN + it % 228;
            GAS v4u* p = (GAS v4u*)(ws + WS_W + (size_t)l * WL_STRIDE + WL_IN + (size_t)row * DM * 2);
            p[F.lane] = (v4u){0u, 0u, 0u, 0u}; p[64 + F.lane] = (v4u){0u, 0u, 0u, 0u}; }
        { const int gt = blockIdx.x * NTHR + F.tid;
          if (gt < 12 * 1152) { const int hd = gt / 1152, dist = gt % 1152; ((float*)(ws + WS_B2))[gt] = KIN(2)[t5_bucket(dist) * 12 + hd] * LOG2E; } }
        { LAS float* red = (LAS float*)(F.lds + 12288);
          for (int task = blockIdx.x; task < DEPTH * 2 * 32; task += gridDim.x) {
              const int lk = task >> 5, i0 = (task & 31) * 64 + (F.tid >> 7) * 16, j = F.tid & 127;
              const float* pe = KIN(12) + (size_t)lk * 2048 + i0; const float* w1 = KIN(13) + ((size_t)lk * 2048 + i0) * 128 + j; float s = 0.f;
#pragma unroll
              for (int i = 0; i < 16; ++i) s += pe[i] * w1[(size_t)i * 128];
              __syncthreads(); red[F.tid] = s; __syncthreads();
              if (F.tid < 128) ((float*)(ws + WS_CB1P))[(size_t)task * 128 + F.tid] = (red[F.tid] + red[128 + F.tid]) + (red[256 + F.tid] + red[384 + F.tid]); } }
    }
}
__device__ __forceinline__ void cb1_finish(const Frame& F) {
    unsigned char* ws = KWS;
    const int gt = blockIdx.x * NTHR + F.tid;
    if (gt < DEPTH * 2 * 128) { const int j = gt & 127, lk = gt >> 7; const float* pp = (const float*)(ws + WS_CB1P) + (size_t)lk * 32 * 128 + j; float s = 0.f;
#pragma unroll
        for (int c = 0; c < 32; ++c) s += pp[c * 128];
        ((float*)(ws + WS_CB1))[gt] = s; }
}

__device__ __forceinline__ void norm_phase(const Frame& F, const float* xin, const bf16* y, const float* g_post, const float* mod_post, int gate_chunk,
                                           const bf16* y2, const float* g_post2, int gate_chunk2, float* xout,
                                           const float* g_pre, const float* mod_pre, int scale_chunk, int shift_chunk, bf16* h, const bf16* xin16 = nullptr, bf16* xout16 = nullptr) {
    const size_t x16 = (size_t)F.gw * 32768 + 16384;
    const int row0 = F.gw * 16, b = row0 / SEQ;
    const f32x4 z4 = {0.f, 0.f, 0.f, 0.f};
    f32x4 gg[4], gg2[4], gqs[4], sh[4];
#pragma unroll
    for (int j = 0; j < 4; ++j) { const int col = j * 256 + F.lane * 4;
        gg[j] = y ? *(const GAS f32x4*)(mod_post + (size_t)b * 6144 + gate_chunk * 1024 + col) * *(const GAS f32x4*)(g_post + col) : z4;
        gg2[j] = y2 ? *(const GAS f32x4*)(mod_post + (size_t)b * 6144 + gate_chunk2 * 1024 + col) * *(const GAS f32x4*)(g_post2 + col) : z4;
        gqs[j] = h ? *(const GAS f32x4*)(g_pre + col) * (*(const GAS f32x4*)(mod_pre + (size_t)b * 6144 + scale_chunk * 1024 + col) + 1.f) : z4;
        sh[j] = h ? *(const GAS f32x4*)(mod_pre + (size_t)b * 6144 + shift_chunk * 1024 + col) : z4; }
    struct Raw { v2u ya[4], yb[4], y2a[4], y2b[4], xa[4], xb[4]; };
    auto fetch = [&](int i, Raw& r) {
        const size_t oa = (size_t)(row0 + i) * DM + F.lane * 4, ob = oa + DM;
#pragma unroll
        for (int j = 0; j < 4; ++j) {
            if (y) { r.ya[j] = *(const GAS v2u*)(y + oa + j * 256); r.yb[j] = *(const GAS v2u*)(y + ob + j * 256); }
            if (y2) { r.y2a[j] = *(const GAS v2u*)(y2 + oa + j * 256); r.y2b[j] = *(const GAS v2u*)(y2 + ob + j * 256); }
            if (xin16) { r.xa[j] = *(const GAS v2u*)(xin16 + x16 + (size_t)i * DM + j * 256 + F.lane * 4); r.xb[j] = *(const GAS v2u*)(xin16 + x16 + (size_t)(i + 1) * DM + j * 256 + F.lane * 4); } }
    };
    auto unpk = [](const v2u& w) { return (f32x4){bf_lo(w.x), bf_hi(w.x), bf_lo(w.y), bf_hi(w.y)}; };
    auto process = [&](int i, const Raw& r) {
        const int rowa = row0 + i, rowb = rowa + 1;
        f32x4 va[4], vb[4], ua[4], ub[4];
#pragma unroll
        for (int j = 0; j < 4; ++j) {
            if (xin16) { va[j] = unpk(r.xa[j]); vb[j] = unpk(r.xb[j]); }
            else { va[j] = *(const GAS f32x4*)(xin + (size_t)rowa * DM + j * 256 + F.lane * 4); vb[j] = *(const GAS f32x4*)(xin + (size_t)rowb * DM + j * 256 + F.lane * 4); } }
        auto add_branch = [&](const v2u (&wa)[4], const v2u (&wb)[4], const f32x4 (&g)[4]) {
            float ssa = 0.f, ssb = 0.f;
#pragma unroll
            for (int j = 0; j < 4; ++j) { ua[j] = unpk(wa[j]); ssa += (ua[j].x * ua[j].x + ua[j].y * ua[j].y) + (ua[j].z * ua[j].z + ua[j].w * ua[j].w);
                ub[j] = unpk(wb[j]); ssb += (ub[j].x * ub[j].x + ub[j].y * ub[j].y) + (ub[j].z * ub[j].z + ub[j].w * ub[j].w); }
            const float ra = rsqrtf(wave_sum(ssa) * (1.f / DM) + RMS_EPS), rb = rsqrtf(wave_sum(ssb) * (1.f / DM) + RMS_EPS);
#pragma unroll
            for (int j = 0; j < 4; ++j) { va[j] += g[j] * (ua[j] * ra); vb[j] += g[j] * (ub[j] * rb); }
        };
        if (y) add_branch(r.ya, r.yb, gg);
        if (y2) add_branch(r.y2a, r.y2b, gg2);
        if (xout16) {
#pragma unroll
            for (int j = 0; j < 4; ++j) { v2u wa, wb; wa.x = pk2(va[j].x, va[j].y); wa.y = pk2(va[j].z, va[j].w); wb.x = pk2(vb[j].x, vb[j].y); wb.y = pk2(vb[j].z, vb[j].w);
                *(GAS v2u*)(xout16 + x16 + (size_t)i * DM + j * 256 + F.lane * 4) = wa; *(GAS v2u*)(xout16 + x16 + (size_t)(i + 1) * DM + j * 256 + F.lane * 4) = wb;
                va[j] = unpk(wa); vb[j] = unpk(wb); }
        } else if (xout) {
#pragma unroll
            for (int j = 0; j < 4; ++j) { *(GAS f32x4*)(xout + (size_t)rowa * DM + j * 256 + F.lane * 4) = va[j]; *(GAS f32x4*)(xout + (size_t)rowb * DM + j * 256 + F.lane * 4) = vb[j]; }
        }
        if (h) {
            float ssa = 0.f, ssb = 0.f;
#pragma unroll
            for (int j = 0; j < 4; ++j) { ssa += (va[j].x * va[j].x + va[j].y * va[j].y) + (va[j].z * va[j].z + va[j].w * va[j].w); ssb += (vb[j].x * vb[j].x + vb[j].y * vb[j].y) + (vb[j].z * vb[j].z + vb[j].w * vb[j].w); }
            const float ra = rsqrtf(wave_sum(ssa) * (1.f / DM) + RMS_EPS), rb = rsqrtf(wave_sum(ssb) * (1.f / DM) + RMS_EPS);
#pragma unroll
            for (int j = 0; j < 4; ++j) { const int col = j * 256 + F.lane * 4;
                const f32x4 oa = va[j] * ra * gqs[j] + sh[j]; v2u w; w.x = pk2(oa.x, oa.y); w.y = pk2(oa.z, oa.w); *(GAS v2u*)(h + (size_t)rowa * DM + col) = w;
                const f32x4 ob = vb[j] * rb * gqs[j] + sh[j]; v2u w2; w2.x = pk2(ob.x, ob.y); w2.y = pk2(ob.z, ob.w); *(GAS v2u*)(h + (size_t)rowb * DM + col) = w2; }
        }
    };
    Raw ra0, ra1; fetch(0, ra0);
    for (int i = 0; i < 16; i += 4) {
        fetch(i + 2, ra1); process(i, ra0);
        if (i + 4 < 16) fetch(i + 4, ra0);
        process(i + 2, ra1);
    }
}
__device__ __forceinline__ void groupnorm_phase(const Frame& F, bf16* O, const float* gn) {
    for (int row = F.gw; row < M; row += F.NGW) {
        f32x4 v[4]; float ss[4];
#pragma unroll
        for (int j = 0; j < 4; ++j) { const v2u w = *(const GAS v2u*)(O + (size_t)row * DM + j * 256 + F.lane * 4);
            v[j] = (f32x4){bf_lo(w.x), bf_hi(w.x), bf_lo(w.y), bf_hi(w.y)}; ss[j] = (v[j].x * v[j].x + v[j].y * v[j].y) + (v[j].z * v[j].z + v[j].w * v[j].w); }
        const float r0 = rsqrtf(wave_sum(ss[0]) * (1.f / 256.f) + RMS_EPS), r1 = rsqrtf(wave_sum(ss[1]) * (1.f / 256.f) + RMS_EPS), r2 = rsqrtf(wave_sum(ss[2] + ss[3]) * (1.f / 512.f) + RMS_EPS);
#pragma unroll
        for (int j = 0; j < 4; ++j) { const float r = j == 0 ? r0 : j == 1 ? r1 : r2; const int col = j * 256 + F.lane * 4;
            const f32x4 o = v[j] * r * *(const GAS f32x4*)(gn + col);
            v2u w; w.x = pk2(o.x, o.y); w.y = pk2(o.z, o.w);
            *(GAS v2u*)(O + (size_t)row * DM + col) = w; }
    }
}

namespace pg8 {
__device__ __forceinline__ f32x4 smul(const f32x4& a, float s) {
    float z = 0.f; asm("" : "+v"(z));
    return (f32x4){a[0] * s, __builtin_fmaf(a[1], s, z), a[2] * s, __builtin_fmaf(a[3], s, z)}; }
struct EpiProj {
    static constexpr bool PERM = true, AFTER_DRAIN = false;
    bf16_t* proj; float* logf; float* gates; const float* fbias;
    __device__ __forceinline__ void operator()(const f32x4 (&acc)[2][2][4][2], const Unit& u, int wr, int wc, int fr, int fq) const {
        const int row0 = u.pm * BM + wr * 64 + fr;
        {
            const float sc = (u.pn == 0 || u.pn == 2 || u.pn == 5 || u.pn == 6) ? QSCALE : 1.f;
            const int col0 = u.pn * BM + wc * 32 + 8 * fq;
#pragma unroll
            for (int ai = 0; ai < 2; ++ai)
#pragma unroll
                for (int m = 0; m < 4; ++m) { bf16_t* rowp = proj + (size_t)(row0 + ai * HALF + m * 16) * NPROJ + col0;
#pragma unroll
                    for (int bj = 0; bj < 2; ++bj) { const f32x4 v0 = smul(acc[ai][bj][m][0], sc), v1 = smul(acc[ai][bj][m][1], sc);
                        u32x4 w; w.x = cvt_pk_bf16(v0[0], v0[1]); w.y = cvt_pk_bf16(v0[2], v0[3]); w.z = cvt_pk_bf16(v1[0], v1[1]); w.w = cvt_pk_bf16(v1[2], v1[3]);
                        *(u32x4*)(rowp + bj * HALF) = w; } }
        }
    }
};
struct EpiY {
    static constexpr bool PERM = true, AFTER_DRAIN = false;
    bf16_t* out; int ldc;
    __device__ __forceinline__ void operator()(const f32x4 (&acc)[2][2][4][2], const Unit& u, int wr, int wc, int fr, int fq) const {
        const int row0 = u.pm * BM + wr * 64 + fr, col0 = u.pn * BM + wc * 32 + 8 * fq;
#pragma unroll
        for (int ai = 0; ai < 2; ++ai)
#pragma unroll
            for (int m = 0; m < 4; ++m) { bf16_t* rowp = out + (size_t)(row0 + ai * HALF + m * 16) * ldc + col0;
#pragma unroll
                for (int bj = 0; bj < 2; ++bj) { const f32x4 v0 = acc[ai][bj][m][0], v1 = acc[ai][bj][m][1];
                    u32x4 w; w.x = cvt_pk_bf16(v0[0], v0[1]); w.y = cvt_pk_bf16(v0[2], v0[3]); w.z = cvt_pk_bf16(v1[0], v1[1]); w.w = cvt_pk_bf16(v1[2], v1[3]);
                    *(u32x4*)(rowp + bj * HALF) = w; } }
    }
};
struct GnHook { static constexpr bool ACTIVE = true; static constexpr int T1 = 4, T2 = 8;
    const PG8_LAS f32x4* rf;
    __device__ __forceinline__ void apply(f32x4 (&acc)[2][2][4][2], int t, int ui, int wr, int fr) const {
#pragma unroll
        for (int ai = 0; ai < 2; ++ai)
#pragma unroll
            for (int m = 0; m < 4; ++m) { const f32x4 f = rf[(ui & 1) * 256 + ai * HALF + wr * 64 + m * 16 + fr]; const float sc = (t == T1) ? f[0] : f[1];
#pragma unroll
                for (int bj = 0; bj < 2; ++bj)
#pragma unroll
                    for (int n = 0; n < 2; ++n) acc[ai][bj][m][n] = smul(acc[ai][bj][m][n], sc); }
    }
};
struct EpiYGn {
    static constexpr bool PERM = true, AFTER_DRAIN = false;
    bf16_t* out; int ldc; const PG8_LAS f32x4* rf; int pm0;
    __device__ __forceinline__ void operator()(const f32x4 (&acc)[2][2][4][2], const Unit& u, int wr, int wc, int fr, int fq) const {
        const int row0 = u.pm * BM + wr * 64 + fr, col0 = u.pn * BM + wc * 32 + 8 * fq; const int slot = (u.pm == pm0) ? 0 : 256;
#pragma unroll
        for (int ai = 0; ai < 2; ++ai)
#pragma unroll
            for (int m = 0; m < 4; ++m) { bf16_t* rowp = out + (size_t)(row0 + ai * HALF + m * 16) * ldc + col0; const float sc = rf[slot + ai * HALF + wr * 64 + m * 16 + fr][2];
#pragma unroll
                for (int bj = 0; bj < 2; ++bj) { const f32x4 v0 = smul(acc[ai][bj][m][0], sc), v1 = smul(acc[ai][bj][m][1], sc);
                    u32x4 w; w.x = cvt_pk_bf16(v0[0], v0[1]); w.y = cvt_pk_bf16(v0[2], v0[3]); w.z = cvt_pk_bf16(v1[0], v1[1]); w.w = cvt_pk_bf16(v1[2], v1[3]);
                    *(u32x4*)(rowp + bj * HALF) = w; } }
    }
};
struct EpiSwiglu {
    static constexpr bool PERM = true, AFTER_DRAIN = false;
    bf16_t* out;
    __device__ __forceinline__ void operator()(const f32x4 (&acc)[2][2][4][2], const Unit& u, int wr, int wc, int fr, int fq) const {
        const int row0 = u.pm * BM + wr * 64 + fr, col0 = u.pn * HALF + wc * 32 + 8 * fq;
#pragma unroll
        for (int ai = 0; ai < 2; ++ai)
#pragma unroll
            for (int m = 0; m < 4; ++m) { float o[8];
#pragma unroll
                for (int n = 0; n < 2; ++n)
#pragma unroll
                    for (int e = 0; e < 4; ++e) { const float g = acc[ai][0][m][n][e], up = acc[ai][1][m][n][e]; o[4 * n + e] = g * __builtin_amdgcn_rcpf(1.f + __expf(-g)) * up; }
                u32x4 w; w.x = cvt_pk_bf16(o[0], o[1]); w.y = cvt_pk_bf16(o[2], o[3]); w.z = cvt_pk_bf16(o[4], o[5]); w.w = cvt_pk_bf16(o[6], o[7]);
                *(u32x4*)(out + (size_t)(row0 + ai * HALF + m * 16) * FFN + col0) = w; }
    }
};
}
namespace att {
typedef short bf16x8 __attribute__((ext_vector_type(8)));
typedef short s16x4 __attribute__((ext_vector_type(4)));
typedef short v4i16_t __attribute__((ext_vector_type(4)));
typedef float f32x16 __attribute__((ext_vector_type(16)));
typedef float f32x2_t __attribute__((ext_vector_type(2)));
typedef __bf16 bf16x2_t __attribute__((ext_vector_type(2)));
typedef LAS const char* lcp;
constexpr int L_K = 0, L_V = 16384, L_AUX = 32768;
constexpr float NEG_INF = -__builtin_inff();
constexpr float SM_THR = 8.f;
struct St { float m, l; f32x16 o0, o1; };

__device__ __forceinline__ unsigned cvtpk(float lo, float hi) { f32x2_t v = {lo, hi}; bf16x2_t b = __builtin_convertvector(v, bf16x2_t); return __builtin_bit_cast(unsigned, b); }
__device__ __forceinline__ float ex2(float x) { return __builtin_amdgcn_exp2f(x); }
__device__ __forceinline__ float xhalf_max(float m) { auto rr = __builtin_amdgcn_permlane32_swap(__float_as_uint(m), __float_as_uint(m), false, false); return fmaxf(__uint_as_float(rr[0]), __uint_as_float(rr[1])); }
__device__ __forceinline__ float xhalf_sum(float m) { auto rr = __builtin_amdgcn_permlane32_swap(__float_as_uint(m), __float_as_uint(m), false, false); return __uint_as_float(rr[0]) + __uint_as_float(rr[1]); }
#define ATT_WAIT_BAR(N) asm volatile("s_waitcnt vmcnt(" #N ") lgkmcnt(0)\n\ts_barrier" ::: "memory")
#define ATT_BAR() asm volatile("s_waitcnt lgkmcnt(0)\n\ts_barrier" ::: "memory")

__device__ __forceinline__ void glds16(const void* gsrc, unsigned lds_dst) { unsigned keep;
    asm volatile("s_mov_b32 %0, m0\n\ts_mov_b32 m0, %2\n\ts_nop 0\n\tglobal_load_lds_dwordx4 %1, off\n\ts_mov_b32 m0, %0" : "=&s"(keep) : "v"(gsrc), "s"(lds_dst) : "memory"); }
__device__ __forceinline__ void dma_k(const bf16* Krow0, int pitch, LAS unsigned char* kbuf, int wid, int lane) {
    const bf16* src = Krow0 + (size_t)lane * pitch + 8 * wid;
    glds16(src, (unsigned)__builtin_amdgcn_readfirstlane((int)(unsigned)(uintptr_t)(kbuf + wid * 1024)));
}
__device__ __forceinline__ void dma_v(const bf16* Vrow0, int pitch, LAS unsigned char* vbuf, int wid, int lane) {
    const bf16* src = Vrow0 + (size_t)(16 * (wid & 3) + (lane >> 2)) * pitch + 32 * (wid >> 2) + 8 * (lane & 3);
    glds16(src, (unsigned)__builtin_amdgcn_readfirstlane((int)(unsigned)(uintptr_t)(vbuf + wid * 1024)));
}
__device__ __forceinline__ s16x4 vtr(lcp p) { return __builtin_bit_cast(s16x4, __builtin_amdgcn_ds_read_tr16_b64_v4i16((LAS v4i16_t*)p)); }


struct Pf { bf16x8 f[4]; };
__device__ __forceinline__ void load_kf(bf16x8 (&kf)[8], lcp kb, int r32, int hi) {
    lcp k0 = kb + hi * 1024 + r32 * 16;
#pragma unroll
    for (int d0 = 0; d0 < 4; ++d0) { kf[2 * d0] = *(const LAS bf16x8*)(k0 + d0 * 2048); kf[2 * d0 + 1] = *(const LAS bf16x8*)(k0 + d0 * 2048 + 512); }
}
__device__ __forceinline__ void load_vf(bf16x8 (&vf)[8], lcp vb, int lane, int hi) {
    lcp vp = vb + ((lane >> 4) & 1) * 32 + (lane & 3) * 8 + (4 * hi + ((lane & 15) >> 2)) * 64;
#pragma unroll
    for (int k = 0; k < 4; ++k) {
        const s16x4 a0 = vtr(vp + k * 1024), a1 = vtr(vp + k * 1024 + 512), b0 = vtr(vp + 4096 + k * 1024), b1 = vtr(vp + 4096 + k * 1024 + 512);
        vf[2 * k] = (bf16x8){a0[0], a0[1], a0[2], a0[3], a1[0], a1[1], a1[2], a1[3]}; vf[2 * k + 1] = (bf16x8){b0[0], b0[1], b0[2], b0[3], b1[0], b1[1], b1[2], b1[3]};
    }
}
__device__ __forceinline__ void qk_mfma(f32x16& p0, f32x16& p1, const bf16x8 (&kf)[8], const bf16x8 (&qf)[4]) {
#pragma unroll
    for (int d0 = 0; d0 < 4; ++d0) { p0 = __builtin_amdgcn_mfma_f32_32x32x16_bf16(kf[2 * d0], qf[d0], p0, 0, 0, 0); p1 = __builtin_amdgcn_mfma_f32_32x32x16_bf16(kf[2 * d0 + 1], qf[d0], p1, 0, 0, 0); }
}
__device__ __forceinline__ void pv_mfma(St& st, const bf16x8 (&vf)[8], const Pf& pf) {
#pragma unroll
    for (int k = 0; k < 4; ++k) { st.o0 = __builtin_amdgcn_mfma_f32_32x32x16_bf16(vf[2 * k], pf.f[k], st.o0, 0, 0, 0); st.o1 = __builtin_amdgcn_mfma_f32_32x32x16_bf16(vf[2 * k + 1], pf.f[k], st.o1, 0, 0, 0); }
}
__device__ __forceinline__ void pack_p(Pf& pf, const f32x16& p0, const f32x16& p1) {
    unsigned w[16];
#pragma unroll
    for (int i = 0; i < 8; ++i) { w[i] = cvtpk(p0[2 * i], p0[2 * i + 1]); w[8 + i] = cvtpk(p1[2 * i], p1[2 * i + 1]); }
#pragma unroll
    for (int k = 0; k < 4; ++k) { v4u t = {w[4 * k], w[4 * k + 1], w[4 * k + 2], w[4 * k + 3]}; pf.f[k] = __builtin_bit_cast(bf16x8, t); }
}
__device__ __forceinline__ void softmax(St& st, f32x16& p0, f32x16& p1, Pf& pf, bool live = true, float cadd = 0.f) {
    float mxa = fmaxf(p0[0], p1[0]), mxb = fmaxf(p0[1], p1[1]);
#pragma unroll
    for (int r = 2; r < 16; r += 2) { mxa = fmaxf(fmaxf(mxa, p0[r]), p1[r]); mxb = fmaxf(fmaxf(mxb, p0[r + 1]), p1[r + 1]); }
    float mx = xhalf_max(fmaxf(mxa, mxb)) + cadd;
    if (!live) mx = NEG_INF;
    const float mn = fmaxf(st.m, mx);
    if (__any(mn > st.m)) { const float f = ex2(st.m - mn); st.l *= f;
#pragma unroll
        for (int r = 0; r < 16; ++r) { st.o0[r] *= f; st.o1[r] *= f; }
        st.m = mn; }
    const float ms = live ? mn - cadd : -NEG_INF;
    float s = 0.f;
#pragma unroll
    for (int r = 0; r < 16; ++r) { p0[r] = ex2(p0[r] - ms); p1[r] = ex2(p1[r] - ms); s += p0[r] + p1[r]; }
    st.l += s;
    pack_p(pf, p0, p1);
}
__device__ __forceinline__ void st_init(St& st, float m0, float l0) { st.m = m0; st.l = l0;
#pragma unroll
    for (int r = 0; r < 16; ++r) { st.o0[r] = 0.f; st.o1[r] = 0.f; } }
__device__ __forceinline__ void store_o(bf16* obase, const f32x16& o0, const f32x16& o1, float sc, int lane, float* ssp, LAS unsigned char* stg) {
    const int r32 = lane & 31, hi = lane >> 5;
    float ss = 0.f;
#pragma unroll
    for (int a = 0; a < 4; ++a) {
        float v[8];
#pragma unroll
        for (int e = 0; e < 4; ++e) { v[e] = o0[4 * a + e] * sc; v[4 + e] = o1[4 * a + e] * sc; }
#pragma unroll
        for (int e = 0; e < 8; ++e) ss += v[e] * v[e];
        v2u w0, w1; w0.x = cvtpk(v[0], v[1]); w0.y = cvtpk(v[2], v[3]); w1.x = cvtpk(v[4], v[5]); w1.y = cvtpk(v[6], v[7]);
        *(LAS v2u*)(stg + r32 * 144 + (8 * a + 4 * hi) * 2) = w0; *(LAS v2u*)(stg + r32 * 144 + 64 + (8 * a + 4 * hi) * 2) = w1; }
    ss = xhalf_sum(ss);
    if (hi == 0) *ssp = ss;
    asm volatile("s_waitcnt lgkmcnt(0)" ::: "memory");
#pragma unroll
    for (int i = 0; i < 4; ++i) { const int row = 8 * i + (lane >> 3), ch = lane & 7; const v4u v = *(const LAS v4u*)(stg + row * 144 + ch * 16); *(GAS v4u*)(obase + (size_t)row * DM + ch * 8) = v; }
}
__device__ __forceinline__ int unit_fetch_issue(unsigned* ctr, int wv) {
    int v = 0;
    if (wv == 0 && lane_id_fresh() == 0) v = (int)__hip_atomic_fetch_add(ctr, 1u, __ATOMIC_RELAXED, __HIP_MEMORY_SCOPE_AGENT);
    return v;
}
__device__ __forceinline__ int unit_fetch_commit(int v, volatile LAS int* slot, int wv) {
    if (wv == 0 && lane_id_fresh() == 0) *slot = v;
    __syncthreads();
    const int r = *slot;
    __syncthreads();
    return r;
}
__device__ __forceinline__ int next_unit(unsigned* ctr, volatile LAS int* slot, int wv) {
    if (wv == 0 && lane_id_fresh() == 0) *slot = (int)__hip_atomic_fetch_add(ctr, 1u, __ATOMIC_RELAXED, __HIP_MEMORY_SCOPE_AGENT);
    __syncthreads();
    const int v = *slot;
    __syncthreads();
    return v;
}

template <int N> struct TabVals { float v[(N + NTHR - 1) / NTHR]; };
template <int N> __device__ __forceinline__ void tab_load(TabVals<N>& tv, int dmax, const float* b2, int col, int tid) {
#pragma unroll
    for (int it = 0; it < (N + NTHR - 1) / NTHR; ++it) { const int dist = dmax - (tid + it * NTHR); const int dc = dist < 0 ? 0 : dist > 1151 ? 1151 : dist; tv.v[it] = b2[col * 1152 + dc]; }
}
template <int N> __device__ __forceinline__ void tab_store(const TabVals<N>& tv, LAS float* T, int dmax, int lo, int hi, int tid) {
#pragma unroll
    for (int it = 0; it < (N + NTHR - 1) / NTHR; ++it) { const int i = tid + it * NTHR, dist = dmax - i; if (i < N) T[i] = (dist >= lo && dist < hi) ? tv.v[it] : NEG_INF; }
}
__device__ __forceinline__ void init_tab(f32x16& p0, f32x16& p1, const LAS float* tl) {
    asm volatile("" : "+v"(tl));
#pragma unroll
    for (int r = 0; r < 16; ++r) { p0[r] = tl[(r & 3) + 8 * (r >> 2)]; p1[r] = tl[32 + (r & 3) + 8 * (r >> 2)]; }
}
#define ATT_SCHED() __builtin_amdgcn_sched_barrier(0)
#ifndef HOIST_FOX
#define HOIST_FOX 1
#define HOIST_SWA 1
#define HOIST_CMP 0
#define HOIST_SLC 1
#endif
#ifndef STAG_FROM
#define STAG_FROM 4
#endif
#ifndef DMA_LATE
#define DMA_LATE 1
#endif
#ifndef SLC_ZC
#define SLC_ZC 1
#endif
#ifndef SLC_WINDOW
#define SLC_WINDOW 1
#endif
#ifndef STAG_FOX
#define STAG_FOX 1
#define STAG_SWA 1
#define STAG_CMP 1
#define STAG_SLC 1
#define STAG_WIN 1
#endif
__device__ __forceinline__ void load_k2(bf16x8 (&k2)[2], lcp kb, int d0, int r32, int hi) { lcp k0 = kb + hi * 1024 + r32 * 16 + d0 * 2048; k2[0] = *(const LAS bf16x8*)k0; k2[1] = *(const LAS bf16x8*)(k0 + 512); }
__device__ __forceinline__ void load_v2(bf16x8 (&v2)[2], lcp vb, int k, int lane, int hi) {
    lcp vp = vb + ((lane >> 4) & 1) * 32 + (lane & 3) * 8 + (4 * hi + ((lane & 15) >> 2)) * 64 + k * 1024;
    const s16x4 a0 = vtr(vp), a1 = vtr(vp + 512), b0 = vtr(vp + 4096), b1 = vtr(vp + 4096 + 512);
    v2[0] = (bf16x8){a0[0], a0[1], a0[2], a0[3], a1[0], a1[1], a1[2], a1[3]}; v2[1] = (bf16x8){b0[0], b0[1], b0[2], b0[3], b1[0], b1[1], b1[2], b1[3]};
}
template <int BASE, class Hook> __device__ __forceinline__ bf16x8 exp_chunk(const f32x16& c, float ms, float& s, Hook&& hook, int t, int k) {
    float e[8];
#pragma unroll
    for (int j = 0; j < 8; ++j) { e[j] = c[BASE + j] - ms; }
    float t0, t1, t2, t3;
    asm("v_exp_f32 %0, %0\n\tv_exp_f32 %1, %1\n\tv_exp_f32 %2, %2\n\tv_exp_f32 %3, %3\n\tv_exp_f32 %4, %4\n\tv_exp_f32 %5, %5\n\tv_exp_f32 %6, %6\n\tv_exp_f32 %7, %7\n\t"
        "v_add_f32 %8, %0, %1\n\tv_add_f32 %9, %2, %3\n\tv_add_f32 %10, %4, %5\n\tv_add_f32 %11, %6, %7\n\t"
        "v_add_f32 %8, %8, %9\n\tv_add_f32 %10, %10, %11\n\tv_add_f32 %8, %8, %10\n\tv_add_f32 %12, %12, %8"
        : "+v"(e[0]), "+v"(e[1]), "+v"(e[2]), "+v"(e[3]), "+v"(e[4]), "+v"(e[5]), "+v"(e[6]), "+v"(e[7]), "=&v"(t0), "=&v"(t1), "=&v"(t2), "=&v"(t3), "+v"(s));
    hook(t, k, e, ms);
    v4u w = {cvtpk(e[0], e[1]), cvtpk(e[2], e[3]), cvtpk(e[4], e[5]), cvtpk(e[6], e[7])};
    return __builtin_bit_cast(bf16x8, w);
}
__device__ __forceinline__ float softmax_head(St& st, const f32x16& p0, const f32x16& p1, bool live, float cadd, float& tmax) {
    float mxa = fmaxf(p0[0], p1[0]), mxb = fmaxf(p0[1], p1[1]);
#pragma unroll
    for (int r = 2; r < 16; r += 2) { mxa = fmaxf(fmaxf(mxa, p0[r]), p1[r]); mxb = fmaxf(fmaxf(mxb, p0[r + 1]), p1[r + 1]); }
    float mx = xhalf_max(fmaxf(mxa, mxb)) + cadd;
    if (!live) mx = NEG_INF;
    tmax = mx;
    if (__any(mx > st.m + SM_THR)) { const float mn = fmaxf(st.m, mx); const float f = ex2(st.m - mn); st.l *= f;
#pragma unroll
        for (int r = 0; r < 16; ++r) { st.o0[r] *= f; st.o1[r] *= f; }
        st.m = mn; }
    return live ? st.m - cadd : -NEG_INF;
}
#define MFMA32 __builtin_amdgcn_mfma_f32_32x32x16_bf16
template <int REL, class F, class... A> __device__ __forceinline__ decltype(auto) call_r(F& f, int t, A&... a) {
    if constexpr (std::is_invocable_v<F&, std::integral_constant<int, REL>, int, A&...>) return f(std::integral_constant<int, REL>{}, t, a...);
    else return f(t, a...);
}
template <int REL, class Init> __device__ __forceinline__ bool init_z(Init& init, int t, f32x16& p0, f32x16& p1) {
    if constexpr (std::is_same_v<decltype(call_r<REL>(init, t, p0, p1)), bool>) return call_r<REL>(init, t, p0, p1); else { call_r<REL>(init, t, p0, p1); return false; }
}
template <int REL, class Init> __device__ __forceinline__ void init_full(Init& init, int t, f32x16& p0, f32x16& p1) {
    if (init_z<REL>(init, t, p0, p1)) {
#pragma unroll
        for (int r = 0; r < 16; ++r) { p0[r] = 0.f; p1[r] = 0.f; } }
}
#define ZERO16 ((f32x16){0.f, 0.f, 0.f, 0.f, 0.f, 0.f, 0.f, 0.f, 0.f, 0.f, 0.f, 0.f, 0.f, 0.f, 0.f, 0.f})
#define QK0(KF) do { if (zi) { n0 = MFMA32(KF[0], qf[0], ZERO16, 0, 0, 0); n1 = MFMA32(KF[1], qf[0], ZERO16, 0, 0, 0); } else { n0 = MFMA32(KF[0], qf[0], n0, 0, 0, 0); n1 = MFMA32(KF[1], qf[0], n1, 0, 0, 0); } } while (0)
template <bool FAST = false, bool HOOKED = false, int STAG = 0, int PRE = 0, class Src, class Act, class Init, class Post, class Valu, class Pv, class Sargs, class Hook>
__device__ __forceinline__ void tile_loop_x(LAS unsigned char* lds, int nt, int pitch, const bf16x8 (&qf)[4], St* fst, Src src, Act act, Init init, Post post, Valu valu, Pv pv, Sargs sargs, Hook hook, int wid, int lane) {
    if (nt <= 0) return;
    const int r32 = lane & 31, hi = lane >> 5;
    if constexpr (PRE == 0) { const bf16 *kp, *vp; call_r<0>(src, 0, kp, vp); dma_k(kp, pitch, lds + L_K, wid, lane); dma_v(vp, pitch, lds + L_V, wid, lane); }
    if constexpr (PRE != 1) { if (nt > 1) { const bf16 *kp, *vp; call_r<1>(src, 1, kp, vp); dma_k(kp, pitch, lds + L_K + 8192, wid, lane); } }
    if (PRE == 2 && nt > 1) ATT_WAIT_BAR(1);
    else ATT_WAIT_BAR(0);
    f32x16 a0, a1, b0, b1;
    if (FAST || act(0)) { bf16x8 kf[8]; load_kf(kf, (lcp)(lds + L_K), r32, hi); init_full<0>(init, 0, a0, a1); qk_mfma(a0, a1, kf, qf); post(0, a0, a1); }
    auto step = [&](int t, f32x16& c0, f32x16& c1, f32x16& n0, f32x16& n1) {
        const int cur = (t & 1) * 8192, nxt = 8192 - cur;
        ATT_WAIT_BAR(0);
        auto issue_dma = [&]() {
            if (t + 2 < nt) { const bf16 *kp, *vp; call_r<2>(src, t + 2, kp, vp); dma_k(kp, pitch, lds + L_K + cur, wid, lane); }
            { const bf16 *kp, *vp; call_r<1>(src, t + 1, kp, vp); dma_v(vp, pitch, lds + L_V + nxt, wid, lane); } };
        if (!FAST || !DMA_LATE) issue_dma();
        const bool an = FAST || act(t + 1), ac = FAST || act(t);
        if constexpr (FAST) { {
            St& st = *fst; bool live; float cadd; call_r<0>(sargs, t, live, cadd);
            lcp kn = (lcp)(lds + L_K + nxt); lcp vc = (lcp)(lds + L_V + cur);
            bf16x8 ka[2], va[2], kb[2], vb[2];
            const bool zi = init_z<1>(init, t + 1, n0, n1); load_k2(ka, kn, 0, r32, hi);
            float tmax; const float ms = softmax_head(st, c0, c1, live, cadd, tmax);
            const bool alive = HOOKED || !__all(tmax < st.m - 150.f);
            if (alive) load_v2(va, vc, 0, lane, hi);
            float sacc = 0.f;
            if (DMA_LATE) issue_dma();
            ATT_SCHED();
            if constexpr (STAG == 1) {
                bf16x8 pa = {0, 0, 0, 0, 0, 0, 0, 0}, pb = {0, 0, 0, 0, 0, 0, 0, 0};
                { load_k2(kb, kn, 1, r32, hi); if (alive) { load_v2(vb, vc, 1, lane, hi); pa = exp_chunk<0>(c0, ms, sacc, hook, t, 0); } }
                ATT_SCHED();
                { if (alive) pb = exp_chunk<8>(c0, ms, sacc, hook, t, 1);
                  QK0(ka); if (alive) { st.o0 = MFMA32(va[0], pa, st.o0, 0, 0, 0); st.o1 = MFMA32(va[1], pa, st.o1, 0, 0, 0); } }
                ATT_SCHED();
                { load_k2(ka, kn, 2, r32, hi); if (alive) { load_v2(va, vc, 2, lane, hi); pa = exp_chunk<0>(c1, ms, sacc, hook, t, 2); }
                  n0 = MFMA32(kb[0], qf[1], n0, 0, 0, 0); n1 = MFMA32(kb[1], qf[1], n1, 0, 0, 0); if (alive) { st.o0 = MFMA32(vb[0], pb, st.o0, 0, 0, 0); st.o1 = MFMA32(vb[1], pb, st.o1, 0, 0, 0); } }
                ATT_SCHED();
                { load_k2(kb, kn, 3, r32, hi); if (alive) { load_v2(vb, vc, 3, lane, hi); pb = exp_chunk<8>(c1, ms, sacc, hook, t, 3); }
                  n0 = MFMA32(ka[0], qf[2], n0, 0, 0, 0); n1 = MFMA32(ka[1], qf[2], n1, 0, 0, 0); if (alive) { st.o0 = MFMA32(va[0], pa, st.o0, 0, 0, 0); st.o1 = MFMA32(va[1], pa, st.o1, 0, 0, 0); } }
                ATT_SCHED();
                { n0 = MFMA32(kb[0], qf[3], n0, 0, 0, 0); n1 = MFMA32(kb[1], qf[3], n1, 0, 0, 0); if (alive) { st.o0 = MFMA32(vb[0], pb, st.o0, 0, 0, 0); st.o1 = MFMA32(vb[1], pb, st.o1, 0, 0, 0); } }
                ATT_SCHED();
                st.l += sacc; post(t + 1, n0, n1);
                return;
            }
            { load_k2(kb, kn, 1, r32, hi); bf16x8 pk = {0, 0, 0, 0, 0, 0, 0, 0}; if (alive) { load_v2(vb, vc, 1, lane, hi); pk = exp_chunk<0>(c0, ms, sacc, hook, t, 0); }
              QK0(ka); if (alive) { st.o0 = MFMA32(va[0], pk, st.o0, 0, 0, 0); st.o1 = MFMA32(va[1], pk, st.o1, 0, 0, 0); } }
            ATT_SCHED();
            { load_k2(ka, kn, 2, r32, hi); bf16x8 pk = {0, 0, 0, 0, 0, 0, 0, 0}; if (alive) { load_v2(va, vc, 2, lane, hi); pk = exp_chunk<8>(c0, ms, sacc, hook, t, 1); }
              n0 = MFMA32(kb[0], qf[1], n0, 0, 0, 0); n1 = MFMA32(kb[1], qf[1], n1, 0, 0, 0); if (alive) { st.o0 = MFMA32(vb[0], pk, st.o0, 0, 0, 0); st.o1 = MFMA32(vb[1], pk, st.o1, 0, 0, 0); } }
            ATT_SCHED();
            { load_k2(kb, kn, 3, r32, hi); bf16x8 pk = {0, 0, 0, 0, 0, 0, 0, 0}; if (alive) { load_v2(vb, vc, 3, lane, hi); pk = exp_chunk<0>(c1, ms, sacc, hook, t, 2); }
              n0 = MFMA32(ka[0], qf[2], n0, 0, 0, 0); n1 = MFMA32(ka[1], qf[2], n1, 0, 0, 0); if (alive) { st.o0 = MFMA32(va[0], pk, st.o0, 0, 0, 0); st.o1 = MFMA32(va[1], pk, st.o1, 0, 0, 0); } }
            ATT_SCHED();
            { bf16x8 pk = {0, 0, 0, 0, 0, 0, 0, 0}; if (alive) pk = exp_chunk<8>(c1, ms, sacc, hook, t, 3);
              n0 = MFMA32(kb[0], qf[3], n0, 0, 0, 0); n1 = MFMA32(kb[1], qf[3], n1, 0, 0, 0); if (alive) { st.o0 = MFMA32(vb[0], pk, st.o0, 0, 0, 0); st.o1 = MFMA32(vb[1], pk, st.o1, 0, 0, 0); } }
            ATT_SCHED();
            st.l += sacc; post(t + 1, n0, n1);
            return;
        } }
        bf16x8 kf[8], vf[8]; Pf pf;
        if (an) { load_kf(kf, (lcp)(lds + L_K + nxt), r32, hi); init_full<1>(init, t + 1, n0, n1); ATT_SCHED(); }
        if (ac) { valu(t, c0, c1, pf); ATT_SCHED(); load_vf(vf, (lcp)(lds + L_V + cur), lane, hi); ATT_SCHED(); }
        if (an) { qk_mfma(n0, n1, kf, qf); post(t + 1, n0, n1); }
        if (ac) pv(t, vf, pf);
    };
    auto last = [&](int t, f32x16& c0, f32x16& c1) { ATT_WAIT_BAR(0);
        if constexpr (FAST) {
            St& st = *fst; bool live; float cadd; call_r<0>(sargs, t, live, cadd); lcp vc = (lcp)(lds + L_V + (t & 1) * 8192);
            bf16x8 vf[8]; load_vf(vf, vc, lane, hi);
            float tmax; const float ms = softmax_head(st, c0, c1, live, cadd, tmax); float sacc = 0.f; Pf pf;
            pf.f[0] = exp_chunk<0>(c0, ms, sacc, hook, t, 0); pf.f[1] = exp_chunk<8>(c0, ms, sacc, hook, t, 1); pf.f[2] = exp_chunk<0>(c1, ms, sacc, hook, t, 2); pf.f[3] = exp_chunk<8>(c1, ms, sacc, hook, t, 3);
            st.l += sacc; pv_mfma(st, vf, pf);
        } else {
        if (act(t)) { bf16x8 vf[8]; Pf pf; load_vf(vf, (lcp)(lds + L_V + (t & 1) * 8192), lane, hi); valu(t, c0, c1, pf); pv(t, vf, pf); } } };
    int t = 0;
    for (; t + 2 < nt; t += 2) { step(t, a0, a1, b0, b1); step(t + 1, b0, b1, a0, a1); }
    if (t + 1 < nt) { step(t, a0, a1, b0, b1); last(t + 1, b0, b1); } else last(t, a0, a1);
    ATT_BAR();
}
__device__ __forceinline__ void prologue_dma(LAS unsigned char* lds, int nt, int pitch, const bf16* k0, const bf16* v0, const bf16* k1, int wid, int lane) {
    dma_k(k0, pitch, lds + L_K, wid, lane); dma_v(v0, pitch, lds + L_V, wid, lane);
    if (nt > 1) dma_k(k1, pitch, lds + L_K + 8192, wid, lane);
}
template <class Src, class Act, class Init, class Post, class Valu, class Pv>
__device__ __forceinline__ void tile_loop(LAS unsigned char* lds, int nt, int pitch, const bf16x8 (&qf)[4], Src src, Act act, Init init, Post post, Valu valu, Pv pv, int wid, int lane) {
    tile_loop_x<false, false, 0>(lds, nt, pitch, qf, (St*)nullptr, src, act, init, post, valu, pv, [](int, bool&, float&) {}, [](int, int, const float (&)[8], float) {}, wid, lane);
}
template <int STAG = 0, int PRE = 0, class Src, class Act, class Init, class Post, class Sargs>
__device__ __forceinline__ void tile_loop_std(LAS unsigned char* lds, int nt, int pitch, const bf16x8 (&qf)[4], St& st, Src src, Act act, Init init, Post post, Sargs sargs, int wid, int lane) {
    auto valu = [&](int t, f32x16& p0, f32x16& p1, Pf& pf) { bool live; float cadd; call_r<0>(sargs, t, live, cadd); softmax(st, p0, p1, pf, live, cadd); };
    auto pv = [&](int t, const bf16x8 (&vf)[8], const Pf& pf) { pv_mfma(st, vf, pf); };
    auto nohook = [](int, int, const float (&)[8], float) {};
    if (STAG && wid >= STAG_FROM) tile_loop_x<true, false, 1, PRE>(lds, nt, pitch, qf, &st, src, act, init, post, valu, pv, sargs, nohook, wid, lane);
    else tile_loop_x<true, false, 0, PRE>(lds, nt, pitch, qf, &st, src, act, init, post, valu, pv, sargs, nohook, wid, lane);
}
template <int STAG = 0, int PRE = 0, class Src, class Init, class Post, class Sargs, class Hook>
__device__ __forceinline__ void tile_loop_hooked(LAS unsigned char* lds, int nt, int pitch, const bf16x8 (&qf)[4], St& st, Src src, Init init, Post post, Sargs sargs, Hook hook, int wid, int lane) {
    auto act = [](int) { return true; }; auto valu = [&](int t, f32x16& p0, f32x16& p1, Pf& pf) {}; auto pv = [&](int t, const bf16x8 (&vf)[8], const Pf& pf) {};
    if (STAG && wid >= STAG_FROM) tile_loop_x<true, true, 1, PRE>(lds, nt, pitch, qf, &st, src, act, init, post, valu, pv, sargs, hook, wid, lane);
    else tile_loop_x<true, true, 0, PRE>(lds, nt, pitch, qf, &st, src, act, init, post, valu, pv, sargs, hook, wid, lane);
}
#define SARGS_STD [](int, bool& live, float& cadd) { live = true; cadd = 0.f; }
#define ACT_ALL [](int) { return true; }
#define POST_NONE [](int, f32x16&, f32x16&) {}

__device__ __forceinline__ void fox_unit(LAS unsigned char* lds, int wv, const bf16* proj, const float* cum, bf16* O, float* ssq, int b, int h, int qb) {
    int tid_l = wv * 64 + lane_id_fresh(); asm volatile("" : "+v"(tid_l));
    const int tid = tid_l, lane = tid & 63, r32 = lane & 31, hi = lane >> 5, wid = __builtin_amdgcn_readfirstlane(tid >> 6);
    const int t0 = qb * 256, tw0 = t0 + 32 * wid, tq = tw0 + r32;
    bf16x8 qf[4];
    { const bf16* qp = proj + (size_t)(b * SEQ + tq) * NPROJ + C_QB + h * 64 + 8 * hi;
#pragma unroll
      for (int d0 = 0; d0 < 4; ++d0) qf[d0] = *(const GAS bf16x8*)(qp + 16 * d0); }
    const bf16* Kb = proj + (size_t)(b * SEQ) * NPROJ + C_KB + h * 64; const bf16* Vb = proj + (size_t)(b * SEQ) * NPROJ + C_VB + h * 64;
    const int NT = 4 * (qb + 1);
    if (HOIST_FOX) prologue_dma(lds, NT, NPROJ, Kb + (size_t)(64 * (NT - 1)) * NPROJ, Vb + (size_t)(64 * (NT - 1)) * NPROJ, Kb + (size_t)(64 * (NT - 2)) * NPROJ, wid, lane);
    LAS float* cs = (LAS float*)(lds + L_AUX);
    { LAS float* wt = (LAS float*)(lds + L_AUX + 16384);
      const float* src = cum + (size_t)(b * 4 + h) * SEQ + tid * 8;
      f32x4 v0 = {0.f, 0.f, 0.f, 0.f}, v1 = v0;
      if (tid * 8 < t0 + 256) { v0 = *(const GAS f32x4*)src; v1 = *(const GAS f32x4*)(src + 4); }
      const float sm = ((v0.x + v0.y) + (v0.z + v0.w)) + ((v1.x + v1.y) + (v1.z + v1.w));
      float x = sm;
#pragma unroll
      for (int o = 1; o < 64; o <<= 1) { const float tt = __shfl_up(x, o); if (lane >= o) x += tt; }
      if (lane == 63) wt[wid] = x;
      ATT_BAR();
      float run = x - sm;
      for (int w = 0; w < wid; ++w) run += wt[w];
      f32x4 o0, o1; run += v0.x; o0.x = run; run += v0.y; o0.y = run; run += v0.z; o0.z = run; run += v0.w; o0.w = run;
      run += v1.x; o1.x = run; run += v1.y; o1.y = run; run += v1.z; o1.z = run; run += v1.w; o1.w = run;
      *(LAS f32x4*)(cs + tid * 8) = o0 * (-LOG2E); *(LAS f32x4*)(cs + tid * 8 + 4) = o1 * (-LOG2E); }
    St st; st_init(st, -1e30f, 0.f);
    tile_loop_std<STAG_FOX, HOIST_FOX>(lds, NT, NPROJ, qf, st,
        [&](int i, const bf16*& kp, const bf16*& vp) { const int s0 = 64 * (NT - 1 - i); kp = Kb + (size_t)s0 * NPROJ; vp = Vb + (size_t)s0 * NPROJ; },
        [&](int i) { return 64 * (NT - 1 - i) <= tw0 + 31; },
        [&](int i, f32x16& p0, f32x16& p1) { const int s0 = 64 * (NT - 1 - i);
#pragma unroll
            for (int a = 0; a < 4; ++a) { const f32x4 c0 = *(const LAS f32x4*)(cs + s0 + 8 * a + 4 * hi), c1 = *(const LAS f32x4*)(cs + s0 + 32 + 8 * a + 4 * hi);
#pragma unroll
                for (int e = 0; e < 4; ++e) { p0[4 * a + e] = c0[e]; p1[4 * a + e] = c1[e]; } } },
        [&](int i, f32x16& p0, f32x16& p1) { const int s0 = 64 * (NT - 1 - i);
            if (s0 + 63 > tw0) { asm volatile("" ::: "memory");
#pragma unroll
                for (int r = 0; r < 16; ++r) { const int kv = s0 + (r & 3) + 8 * (r >> 2) + 4 * hi; if (kv > tq) p0[r] = NEG_INF; if (kv + 32 > tq) p1[r] = NEG_INF; } } },
        SARGS_STD, wid, lane);
    const float inv = 1.f / xhalf_sum(st.l);
    store_o(O + (size_t)(b * SEQ + tw0) * DM + 256 + h * 64, st.o0, st.o1, inv, lane, ssq + (size_t)(b * SEQ + tq) * 16 + 4 + h, lds + wid * 4608);
}
__device__ __forceinline__ void fox_phase(LAS unsigned char* lds, int wv, const bf16* proj, const float* cum, bf16* O, float* ssq, unsigned* ctr) {
    volatile LAS int* slot = (volatile LAS int*)(lds + LDSCTL_OFF + 64);
    for (int idx = (int)blockIdx.x; idx < 512; idx = (int)gridDim.x + next_unit(ctr, slot, wv)) {
        fox_unit(lds, wv, proj, cum, O, ssq, (idx & 31) >> 2, idx & 3, 15 - (idx >> 5));
    }
}

__device__ __forceinline__ void swa_unit(LAS unsigned char* lds, int wv, const bf16* proj, const float* rel_bias, const float* sinks, bf16* O, float* ssq, int b, int hkv, int qblk) {
    int tid_l = wv * 64 + lane_id_fresh(); asm volatile("" : "+v"(tid_l));
    const int tid = tid_l, lane = tid & 63, r32 = lane & 31, hi = lane >> 5, wid = __builtin_amdgcn_readfirstlane(tid >> 6);
    const int hq = 2 * hkv + (wid >> 2), t0 = qblk * 128, tq = t0 + 32 * (wid & 3) + r32;
    bf16x8 qf[4];
    { const bf16* qp = proj + (size_t)(b * SEQ + tq) * NPROJ + C_QA + hq * 64 + 8 * hi;
#pragma unroll
      for (int d0 = 0; d0 < 4; ++d0) qf[d0] = *(const GAS bf16x8*)(qp + 16 * d0); }
    const int k0 = (t0 == 0) ? 2 : 0;
    const bf16* Kb = proj + (size_t)(b * SEQ) * NPROJ + C_KA + hkv * 64; const bf16* Vb = proj + (size_t)(b * SEQ) * NPROJ + C_VA + hkv * 64;
    if (HOIST_SWA) { const int s00 = t0 - 128 + 64 * k0; prologue_dma(lds, 4 - k0, NPROJ, Kb + (size_t)s00 * NPROJ, Vb + (size_t)s00 * NPROJ, Kb + (size_t)(s00 + 64) * NPROJ, wid, lane); }
    LAS float* T = (LAS float*)(lds + L_AUX);
    { TabVals<384> ta, tb; tab_load(ta, 255, rel_bias, 2 * hkv, tid); tab_load(tb, 255, rel_bias, 2 * hkv + 1, tid);
      ATT_SCHED();
      tab_store(ta, T, 255, 0, 128, tid); tab_store(tb, T + 384, 255, 0, 128, tid); }
    const LAS float* Tw = T + (wid >> 2) * 384;
    St st; st_init(st, sinks[hq] * LOG2E, hi == 0 ? 1.f : 0.f);
    tile_loop_std<STAG_SWA, HOIST_SWA>(lds, 4 - k0, NPROJ, qf, st,
        [&](int t, const bf16*& kp, const bf16*& vp) { const int s0 = t0 - 128 + 64 * (k0 + t); kp = Kb + (size_t)s0 * NPROJ; vp = Vb + (size_t)s0 * NPROJ; },
        ACT_ALL,
        [&](int t, f32x16& p0, f32x16& p1) { const int s0 = t0 - 128 + 64 * (k0 + t); init_tab(p0, p1, Tw + (255 - (tq - s0) + 4 * hi)); },
        POST_NONE,
        SARGS_STD, wid, lane);
    const float inv = 1.f / xhalf_sum(st.l);
    store_o(O + (size_t)(b * SEQ + t0 + 32 * (wid & 3)) * DM + hq * 64, st.o0, st.o1, inv, lane, ssq + (size_t)(b * SEQ + tq) * 16 + hq, lds + wid * 4608);
}
__device__ __forceinline__ void swa_phase(LAS unsigned char* lds, int wv, const bf16* proj, const float* rel_bias, const float* sinks, bf16* O, float* ssq, unsigned* ctr) {
    volatile LAS int* slot = (volatile LAS int*)(lds + LDSCTL_OFF + 64);
    for (int idx = (int)blockIdx.x; idx < 512; idx = (int)gridDim.x + next_unit(ctr, slot, wv)) {
        swa_unit(lds, wv, proj, rel_bias, sinks, O, ssq, idx >> 6, (idx >> 5) & 1, idx & 31);
    }
}

constexpr int L_TSLC = L_AUX, N_TSLC = 1216, L_TWIN = L_TSLC + 4 * N_TSLC * 4, N_TWIN = 704, L_IMPB = L_TWIN + 4 * N_TWIN * 4, IMP_LD = 65;
static_assert(L_IMPB + 4 * 64 * IMP_LD * 4 <= RING_BYTES, "NSA LDS map");
constexpr int L_SELM = LDSCTL_OFF + 256, L_TLIST = LDSCTL_OFF + 1024, L_MREF = LDSCTL_OFF + 2048, L_MFIN = L_MREF + 4096;
__device__ __forceinline__ void nsa_unit(LAS unsigned char* lds, int wv, const bf16* proj, const bf16* kcmp, const bf16* vcmp, const float* rel_bias, const float* gates, bf16* O, float* ssq, int b, int hkv, int qb) {
    int tid_l = wv * 64 + lane_id_fresh(); asm volatile("" : "+v"(tid_l));
    const int tid = tid_l, lane = tid & 63, r32 = lane & 31, hi = lane >> 5, wid = __builtin_amdgcn_readfirstlane(tid >> 6);
    const int g = wid >> 1, h8 = 4 * hkv + g, t0 = qb * 64, qrow = 32 * (wid & 1) + r32, tw0 = t0 + 32 * (wid & 1), tq = t0 + qrow;
    bf16x8 qf[4];
    { const bf16* qp = proj + (size_t)(b * SEQ + tq) * NPROJ + C_QC + h8 * 64 + 8 * hi;
#pragma unroll
      for (int d0 = 0; d0 < 4; ++d0) qf[d0] = *(const GAS bf16x8*)(qp + 16 * d0); }
    const float* gp = gates + (size_t)(b * SEQ + tq) * 24 + h8 * 3;
    const float g_cmp = gp[0], g_slc = gp[1], g_win = gp[2];
    const bf16* Kc = kcmp + (size_t)((b * 2 + hkv) * 256) * 64; const bf16* Vc = vcmp + (size_t)((b * 2 + hkv) * 256) * 64;
    const int NTC = (4 * qb + 2) / 64 + 1;
    if (HOIST_CMP) prologue_dma(lds, NTC, 64, Kc, Vc, Kc + 64 * 64, wid, lane);
    LAS float* TS = (LAS float*)(lds + L_TSLC); LAS float* TW = (LAS float*)(lds + L_TWIN);
    { TabVals<N_TSLC> vs[4]; TabVals<N_TWIN> vw[4];
#pragma unroll
      for (int gg = 0; gg < 4; ++gg) { tab_load(vs[gg], 1151, rel_bias, 4 + 4 * hkv + gg, tid); tab_load(vw[gg], 639, rel_bias, 4 + 4 * hkv + gg, tid); }
      ATT_SCHED();
#pragma unroll
      for (int gg = 0; gg < 4; ++gg) { tab_store(vs[gg], TS + gg * N_TSLC, 1151, 0, 1 << 30, tid); tab_store(vw[gg], TW + gg * N_TWIN, 639, 0, 512, tid); } }
    const LAS float* Ts = TS + g * N_TSLC; const LAS float* Tw = TW + g * N_TWIN;
    LAS float* impb = (LAS float*)(lds + L_IMPB);
    volatile LAS unsigned long long* selm = (volatile LAS unsigned long long*)(lds + L_SELM);
    volatile LAS int* tlist = (volatile LAS int*)(lds + L_TLIST);
    f32x16 os0, os1;
    auto cmp_src = [&](int t, const bf16*& kp, const bf16*& vp) { kp = Kc + (size_t)t * 64 * 64; vp = Vc + (size_t)t * 64 * 64; };
    auto cmp_init = [&](int t, f32x16& p0, f32x16& p1) {
        const int dbase = tq - 31 - 16 * (64 * t + 4 * hi);
#pragma unroll
        for (int r = 0; r < 16; ++r) { const int kr = (r & 3) + 8 * (r >> 2);
            int d0 = dbase - 16 * kr, d1 = d0 - 512; d0 = d0 < -1 ? -1 : d0 > 1151 ? 1151 : d0; d1 = d1 < -1 ? -1 : d1 > 1151 ? 1151 : d1;
            p0[r] = Ts[1151 - d0]; p1[r] = Ts[1151 - d1]; }
    };
    LAS float* mref = (LAS float*)(lds + L_MREF);
    LAS float* mfin = (LAS float*)(lds + L_MFIN);
    { St st; st_init(st, -1e30f, 0.f); float carry = 0.f, ms_prev = 0.f;
      LAS float* ip = impb + (g * 64 + qrow) * IMP_LD + hi;
      tile_loop_hooked<STAG_CMP, HOIST_CMP>(lds, NTC, 64, qf, st, cmp_src, cmp_init, POST_NONE, SARGS_STD,
        [&](int t, int k, const float (&e)[8], float ms) {
            if (k == 0) { if (t > 0) carry *= ex2(ms_prev - ms); ms_prev = ms; if (hi == 0) mref[(g * 64 + qrow) * 4 + t] = ms; }
            const float own0 = (e[0] + e[1]) + (e[2] + 0.5f * e[3]), own1 = (e[4] + e[5]) + (e[6] + 0.5f * e[7]);
            const float pl0 = __shfl_xor(e[3], 32), pl1 = __shfl_xor(e[7], 32);
            const int j0 = 16 * t + 4 * k;
            ip[j0] = own0 + 0.5f * (hi ? pl0 : carry); ip[j0 + 2] = own1 + 0.5f * (hi ? pl1 : pl0);
            carry = pl1; },
        wid, lane);
      const float lt = xhalf_sum(st.l); const float inv_l = lt > 0.f ? 1.f / lt : 0.f;
      if (hi == 0) { mfin[g * 64 + qrow] = st.m; mfin[256 + g * 64 + qrow] = inv_l; }
      const float sc = g_cmp * inv_l;
      os0 = st.o0 * sc; os1 = st.o1 * sc; }
    ATT_BAR();
    if (HOIST_SLC) { const bf16* Kb0 = proj + (size_t)(b * SEQ) * NPROJ + C_KS + hkv * 64; const bf16* Vb0 = proj + (size_t)(b * SEQ) * NPROJ + C_VS + hkv * 64;
      dma_k(Kb0, NPROJ, lds + L_K, wid, lane); dma_v(Vb0, NPROJ, lds + L_V, wid, lane); }
    if (qb >= 16) {
        const int q = tid >> 3, part = tid & 7;
        LAS float* v = impb + q * IMP_LD;
        float fac[4];
#pragma unroll
        for (int gg = 0; gg < 4; ++gg) fac[gg] = ex2(mref[(gg * 64 + q) * 4 + (part >> 1)] - mfin[gg * 64 + q]) * mfin[256 + gg * 64 + q];
#pragma unroll
        for (int jj = 0; jj < 8; ++jj) { const int j = 8 * part + jj; v[j] = (v[j] * fac[0] + v[64 * IMP_LD + j] * fac[1]) + (v[2 * 64 * IMP_LD + j] * fac[2] + v[3 * 64 * IMP_LD + j] * fac[3]); }
        ATT_BAR();
        unsigned long long mk = part == 0 ? (1ull | (1ull << qb) | (1ull << (qb - 1))) : 0ull;
        unsigned long long kj[8]; int rank[8];
#pragma unroll
        for (int jj = 0; jj < 8; ++jj) { kj[jj] = ((unsigned long long)__float_as_uint(v[8 * part + jj]) << 6) | (unsigned)(63 - (8 * part + jj)); rank[jj] = 3; }
        for (int k = 1; k <= qb - 2; ++k) { const unsigned long long kk = ((unsigned long long)__float_as_uint(v[k]) << 6) | (unsigned)(63 - k);
#pragma unroll
            for (int jj = 0; jj < 8; ++jj) rank[jj] += kk > kj[jj] ? 1 : 0; }
#pragma unroll
        for (int jj = 0; jj < 8; ++jj) { const int j = 8 * part + jj; if (j >= 1 && j <= qb - 2 && rank[jj] < 16) mk |= 1ull << j; }
        unsigned lo = (unsigned)mk, hh = (unsigned)(mk >> 32);
#pragma unroll
        for (int o = 1; o < 8; o <<= 1) { lo |= __shfl_xor(lo, o); hh |= __shfl_xor(hh, o); }
        if (part == 0) selm[q] = ((unsigned long long)hh << 32) | lo;
    } else {
        if (tid < 64) selm[tid] = (2ull << qb) - 1ull;
    }
    ATT_BAR();
    if (wid == 0) {
        const unsigned long long mine = selm[lane]; unsigned lo = (unsigned)mine, hh = (unsigned)(mine >> 32);
#pragma unroll
        for (int o = 1; o < 64; o <<= 1) { lo |= __shfl_xor(lo, o); hh |= __shfl_xor(hh, o); }
        if (lane == 0) { tlist[0] = __builtin_popcount(lo) + __builtin_popcount(hh); tlist[65] = (int)lo; tlist[66] = (int)hh; }
    }
    ATT_BAR();
    const unsigned long long mysel = selm[qrow];
    const int ntl = tlist[0];
    LAS float* osl = (LAS float*)(lds + L_IMPB) + wid * 2048 + lane;
#pragma unroll
    for (int r = 0; r < 16; ++r) { osl[r * 64] = os0[r]; osl[(16 + r) * 64] = os1[r]; }
    { St st; st_init(st, -1e30f, 0.f);
      const bf16* Kb = proj + (size_t)(b * SEQ) * NPROJ + C_KS + hkv * 64; const bf16* Vb = proj + (size_t)(b * SEQ) * NPROJ + C_VS + hkv * 64;
      const float cfar = Ts[1151 - 1100];
      unsigned long long rem = ((unsigned long long)(unsigned)__builtin_amdgcn_readfirstlane(tlist[66]) << 32) | (unsigned)__builtin_amdgcn_readfirstlane(tlist[65]);
      auto pop = [&]() { const int j = rem ? __builtin_ctzll(rem) : 0; rem &= rem - 1ull; return j; };
      int tc = 0, w0 = pop(), w1 = pop(), w2 = pop();
      auto tile = [&](auto rel) { constexpr int R = decltype(rel)::value; return R == 0 ? w0 : R == 1 ? w1 : w2; };
      tile_loop_std<STAG_SLC, 2 * HOIST_SLC>(lds, ntl, NPROJ, qf, st,
        [&](auto rel, int t, const bf16*& kp, const bf16*& vp) { const int s0 = 64 * tile(rel); kp = Kb + (size_t)s0 * NPROJ; vp = Vb + (size_t)s0 * NPROJ; },
        ACT_ALL,
        [&](auto rel, int t, f32x16& p0, f32x16& p1) -> bool { const int s0 = 64 * tile(rel);
            if (tw0 - s0 <= 852) { init_tab(p0, p1, Ts + (1151 - (tq - s0) + 4 * hi)); return false; }
            return true; },
        [&](int t, f32x16&, f32x16&) { if (t > tc) { tc = t; w0 = w1; w1 = w2; w2 = pop(); } },
        [&](auto rel, int t, bool& live, float& cadd) { const int j = tile(rel); live = (mysel >> j) & 1ull; cadd = (tw0 - 64 * j <= 852) ? 0.f : cfar; },
        wid, lane);
      const float sc = g_slc / xhalf_sum(st.l);
#pragma unroll
      for (int r = 0; r < 16; ++r) { osl[r * 64] += st.o0[r] * sc; osl[(16 + r) * 64] += st.o1[r] * sc; } }
    { St st; st_init(st, -1e30f, 0.f);
      const bf16* Kb = proj + (size_t)(b * SEQ) * NPROJ + C_KW + hkv * 64; const bf16* Vb = proj + (size_t)(b * SEQ) * NPROJ + C_VW + hkv * 64;
      const int j0 = qb >= 8 ? qb - 8 : 0;
      tile_loop_std<STAG_WIN>(lds, qb - j0 + 1, NPROJ, qf, st,
        [&](int t, const bf16*& kp, const bf16*& vp) { const int s0 = 64 * (j0 + t); kp = Kb + (size_t)s0 * NPROJ; vp = Vb + (size_t)s0 * NPROJ; },
        ACT_ALL,
        [&](int t, f32x16& p0, f32x16& p1) { const int s0 = 64 * (j0 + t); init_tab(p0, p1, Tw + (639 - (tq - s0) + 4 * hi)); },
        POST_NONE,
        SARGS_STD, wid, lane);
      const float sc = g_win / xhalf_sum(st.l);
#pragma unroll
      for (int r = 0; r < 16; ++r) { os0[r] = osl[r * 64] + st.o0[r] * sc; os1[r] = osl[(16 + r) * 64] + st.o1[r] * sc; } }
    { int tq2 = tq; asm volatile("" : "+v"(tq2));
      store_o(O + (size_t)(b * SEQ + tw0) * DM + 512 + h8 * 64, os0, os1, 1.f, lane, ssq + (size_t)(b * SEQ + tq2) * 16 + 8 + h8, lds + wid * 4608); }
}
__device__ __forceinline__ void nsa_phase(LAS unsigned char* lds, int wv, const bf16* proj, const bf16* kcmp, const bf16* vcmp, const float* rel_bias, const float* gates, bf16* O, float* ssq, unsigned* ctr) {
    volatile LAS int* slot = (volatile LAS int*)(lds + LDSCTL_OFF + 64);
    for (int idx = (int)blockIdx.x; idx < 1024; idx = (int)gridDim.x + next_unit(ctr, slot, wv)) {
        nsa_unit(lds, wv, proj, kcmp, vcmp, rel_bias, gates, O, ssq, (idx & 15) >> 1, idx & 1, 63 - (idx >> 4));
    }
}

constexpr int L_RED = 0, L_HID = 16384, HID_LD = 136, L_HID2 = LDSCTL_OFF + 2048;
__device__ __forceinline__ void compress_unit(LAS unsigned char* lds, int wv, const bf16* proj, const bf16* w1t, const bf16* w2t, const float* cb1, bf16* kcmp, bf16* vcmp, int u) {
    int tid_l = wv * 64 + lane_id_fresh(); asm volatile("" : "+v"(tid_l));
    const int tid = tid_l, lane = tid & 63, r32 = lane & 31, hi = lane >> 5, wid = __builtin_amdgcn_readfirstlane(tid >> 6);
    const int i16 = lane & 15, kg = lane >> 4;
    const int mt = u & 7, kv = (u >> 3) & 1, hk = (u >> 4) & 1, b = u >> 5, n0 = 32 * mt;
    const int col0 = (kv ? C_VC : C_KC) + hk * 64;
    typedef float f32x4v __attribute__((ext_vector_type(4)));
    f32x4v acc[2][8];
#pragma unroll
    for (int rb = 0; rb < 2; ++rb)
#pragma unroll
        for (int cb = 0; cb < 8; ++cb) acc[rb][cb] = (f32x4v){0.f, 0.f, 0.f, 0.f};
    const bf16x8 zero8 = {0, 0, 0, 0, 0, 0, 0, 0};
    const int na = n0 + i16, nb = n0 + 16 + i16;
    const bf16* ar0 = proj + (size_t)(b * SEQ + 16 * (na < 255 ? na : 0)) * NPROJ + col0 + 8 * kg;
    const bf16* ar1 = proj + (size_t)(b * SEQ + 16 * (nb < 255 ? nb : 0)) * NPROJ + col0 + 8 * kg;
    const bf16* br = w1t + ((size_t)kv * 128 + i16) * 2048 + 8 * kg;
#pragma unroll 2
    for (int s8 = 0; s8 < 8; ++s8) { const int k = 256 * wid + 32 * s8;
        const size_t ao = (size_t)(k >> 6) * NPROJ + (k & 63);
        bf16x8 a0 = *(const GAS bf16x8*)(ar0 + ao), a1 = *(const GAS bf16x8*)(ar1 + ao);
        if (na >= 255) a0 = zero8; if (nb >= 255) a1 = zero8;
        bf16x8 bf[8];
#pragma unroll
        for (int cb = 0; cb < 8; ++cb) bf[cb] = *(const GAS bf16x8*)(br + (size_t)cb * 16 * 2048 + k);
#pragma unroll
        for (int cb = 0; cb < 8; ++cb) { acc[0][cb] = __builtin_amdgcn_mfma_f32_16x16x32_bf16(a0, bf[cb], acc[0][cb], 0, 0, 0); acc[1][cb] = __builtin_amdgcn_mfma_f32_16x16x32_bf16(a1, bf[cb], acc[1][cb], 0, 0, 0); } }
    LAS float* part = (LAS float*)lds;
#pragma unroll
    for (int rb = 0; rb < 2; ++rb)
#pragma unroll
        for (int cb = 0; cb < 8; ++cb)
#pragma unroll
            for (int e = 0; e < 4; ++e) part[(wid * 64 + (rb * 8 + cb) * 4 + e) * 64 + lane] = acc[rb][cb][e];
    ATT_BAR();
    LAS bf16* hid = (LAS bf16*)(lds + L_HID2);
#pragma unroll
    for (int q = 0; q < 8; ++q) { const int rr = 8 * wid + q; float x = 0.f;
#pragma unroll
        for (int w8 = 0; w8 < 8; ++w8) x += part[(w8 * 64 + rr) * 64 + lane];
        const int rb = rr >> 5, cb = (rr >> 2) & 7, e = rr & 3, row = 16 * rb + 4 * kg + e, col = 16 * cb + i16;
        x += cb1[kv * 128 + col];
        const float z = 0.7978845608028654f * (x + 0.044715f * x * x * x); const float th = 1.f - 2.f / (1.f + __expf(2.f * z));
        hid[row * HID_LD + col] = (bf16)f2bf(0.5f * x * (1.f + th)); }
    ATT_BAR();
    if (wid < 2) {
        f32x16 a2;
#pragma unroll
        for (int r = 0; r < 16; ++r) a2[r] = 0.f;
        const bf16* b2 = w2t + ((size_t)kv * 64 + 32 * wid + r32) * 128 + 8 * hi;
#pragma unroll
        for (int ks = 0; ks < 8; ++ks) { const bf16x8 a = *(const LAS bf16x8*)(hid + r32 * HID_LD + 16 * ks + 8 * hi); const bf16x8 bb = *(const GAS bf16x8*)(b2 + 16 * ks);
            a2 = __builtin_amdgcn_mfma_f32_32x32x16_bf16(a, bb, a2, 0, 0, 0); }
        bf16* out = (kv ? vcmp : kcmp) + (size_t)((b * 2 + hk) * 256 + n0) * 64 + 32 * wid + r32;
#pragma unroll
        for (int r = 0; r < 16; ++r) { const int row = (r & 3) + 8 * (r >> 2) + 4 * hi; out[(size_t)row * 64] = (n0 + row < 255) ? (bf16)f2bf(a2[r]) : (bf16)0; }
    }
    ATT_BAR();
}
__device__ __forceinline__ void thin_block(LAS unsigned char* lds, int wv, const bf16* hbuf, const bf16* wt, const float* fbias, float* logf, float* gates, int tb) {
    int tid_l = wv * 64 + lane_id_fresh(); asm volatile("" : "+v"(tid_l));
    const int tid = tid_l, lane = tid & 63, wid = __builtin_amdgcn_readfirstlane(tid >> 6), i16 = lane & 15, kg = lane >> 4, r0 = 128 * tb;
    typedef float f32x4v __attribute__((ext_vector_type(4)));
    f32x4v acc[8][2];
#pragma unroll
    for (int rb = 0; rb < 8; ++rb) { acc[rb][0] = (f32x4v){0.f, 0.f, 0.f, 0.f}; acc[rb][1] = (f32x4v){0.f, 0.f, 0.f, 0.f}; }
    const bf16* ar = hbuf + (size_t)(r0 + i16) * DM + 128 * wid + 8 * kg;
    const bf16* br = wt + (size_t)(C_FB + i16) * DM + 128 * wid + 8 * kg;
#pragma unroll 2
    for (int s4 = 0; s4 < 4; ++s4) {
        bf16x8 af[8];
#pragma unroll
        for (int rb = 0; rb < 8; ++rb) af[rb] = *(const GAS bf16x8*)(ar + (size_t)rb * 16 * DM + 32 * s4);
        const bf16x8 b0 = *(const GAS bf16x8*)(br + 32 * s4), b1 = *(const GAS bf16x8*)(br + (size_t)16 * DM + 32 * s4);
#pragma unroll
        for (int rb = 0; rb < 8; ++rb) { acc[rb][0] = __builtin_amdgcn_mfma_f32_16x16x32_bf16(af[rb], b0, acc[rb][0], 0, 0, 0); acc[rb][1] = __builtin_amdgcn_mfma_f32_16x16x32_bf16(af[rb], b1, acc[rb][1], 0, 0, 0); } }
    LAS float* part = (LAS float*)lds;
#pragma unroll
    for (int rb = 0; rb < 8; ++rb)
#pragma unroll
        for (int cb = 0; cb < 2; ++cb)
#pragma unroll
            for (int e = 0; e < 4; ++e) part[(wid * 64 + (rb * 2 + cb) * 4 + e) * 64 + lane] = acc[rb][cb][e];
    ATT_BAR();
#pragma unroll
    for (int q = 0; q < 8; ++q) { const int rr = 8 * wid + q; float v = 0.f;
#pragma unroll
        for (int w8 = 0; w8 < 8; ++w8) v += part[(w8 * 64 + rr) * 64 + lane];
        const int rb = rr >> 3, cb = (rr >> 2) & 1, e = rr & 3, row = r0 + 16 * rb + 4 * kg + e, c = 16 * cb + i16;
        if (c < 4) { const float z = v + fbias[c]; logf[(size_t)((row / SEQ) * 4 + c) * SEQ + (row % SEQ)] = fminf(z, 0.f) - log1pf(__expf(-fabsf(z))); }
        else if (c < 28) gates[(size_t)row * 24 + (c - 4)] = 1.f / (1.f + __expf(-v)); }
    ATT_BAR();
}
__device__ __forceinline__ void prep_phase(LAS unsigned char* lds, int wv, const bf16* proj, const bf16* w1t, const bf16* w2t, const float* cb1, bf16* kcmp, bf16* vcmp,
                                           const bf16* hbuf, const bf16* wint, const float* fbias, float* logf, float* gates) {
    int G = gridDim.x, bx = blockIdx.x; asm volatile("" : "+s"(G), "+s"(bx));
    for (int tb = bx; tb < M / 128; tb += G) thin_block(lds, wv, hbuf, wint, fbias, logf, gates, tb);
    for (int u = bx; u < 256; u += G) compress_unit(lds, wv, proj, w1t, w2t, cb1, kcmp, vcmp, u);
}
}
#define GBX() int G = G0, bx = bx0; asm volatile("" : "+s"(G), "+s"(bx))
#define FRAME() GBX(); Frame F; { int t_ = wv * 64 + lane_id_fresh(); asm volatile("" : "+v"(t_)); F.lds = lds_raw; F.tid = t_; F.lane = t_ & 63; F.wave = __builtin_amdgcn_readfirstlane(t_ >> 6); \
        const int vcu_ = (G % 8 == 0) ? (bx % 8) * (G / 8) + bx / 8 : bx; F.gw = vcu_ * NWAVES + F.wave; F.NGW = G * NWAVES; }
#define GRID_BAR() do { if (KINT(5)) xcd_barrier(bar); } while (0)
#define WSB(off) (KWS + (off))
#define P_H ((bf16*)WSB(WS_RH))
#define P_O ((bf16*)WSB(WS_RH))
#define P_PROJ ((bf16*)WSB(WS_R1))
#define P_U ((bf16*)WSB(WS_R1))
#define P_Y ((bf16*)WSB(WS_Y))
#define P_Y2 ((bf16*)WSB(WS_Y + 64 * MiB))
#define P_MOD(l) ((const float*)WSB(WS_MOD) + (size_t)(l) * 8 * 6144)
#define P_WL(l, off) ((const bf16*)(WSB(WS_W) + (size_t)(l) * WL_STRIDE + (off)))
#define IN(p) (KINT(2) <= (p) && (p) < KINT(3))
template <int l>
__device__ __forceinline__ void layer_body(LAS unsigned char* lds_raw, int wv, const XcdBarrier& bar, int G0, int bx0) {
    if (!(l >= KINT(0) && l < KINT(1))) return;
        if (IN(PH_PROJ)) for (int rep = 0; rep <= ((KINT(7) >> PH_PROJ) & 1); ++rep) {
            GBX(); pg8::Gemm g{P_H, P_WL(l, WL_IN), M, C_FB, DM}; pg8::StaticOrder S; S.init(M, C_FB, G, bx);
            pg8::EpiProj E{P_PROJ, (float*)WSB(WS_LOGF), (float*)WSB(WS_GATES), KIN(10) + l * 4};
            pg8::gemm_phase<pg8::EpiProj, pg8::StaticOrder, true, true>(lds_raw, g, S, E, wv);
            GRID_BAR();
        }
        if (IN(PH_PREP)) for (int rep = 0; rep <= ((KINT(7) >> PH_PREP) & 1); ++rep) {
            att::prep_phase(lds_raw, wv, P_PROJ, P_WL(l, WL_CW1), P_WL(l, WL_CW2), (const float*)WSB(WS_CB1) + l * 256, (bf16*)WSB(WS_KCMP), (bf16*)WSB(WS_VCMP),
                            P_H, P_WL(l, WL_IN), KIN(10) + l * 4, (float*)WSB(WS_LOGF), (float*)WSB(WS_GATES));
            GRID_BAR();
        }
        if (IN(PH_ATT)) for (int rep = 0; rep <= ((KINT(7) >> PH_ATT) & 1); ++rep) {
            if ((rep ? KINT(7) >> 16 : KINT(6)) & 4) att::nsa_phase(lds_raw, wv, P_PROJ, (const bf16*)WSB(WS_KCMP), (const bf16*)WSB(WS_VCMP), (const float*)WSB(WS_B2), (const float*)WSB(WS_GATES), P_O, (float*)WSB(WS_SS), (unsigned*)KWS + CW_Q + 64 * (16 * rep + 4 * l + 1));
            if ((rep ? KINT(7) >> 16 : KINT(6)) & 1) att::fox_phase(lds_raw, wv, P_PROJ, (const float*)WSB(WS_LOGF), P_O, (float*)WSB(WS_SS), (unsigned*)KWS + CW_Q + 64 * (16 * rep + 4 * l + 0));
            if ((rep ? KINT(7) >> 16 : KINT(6)) & 2) att::swa_phase(lds_raw, wv, P_PROJ, (const float*)WSB(WS_B2), KIN(11) + l * 4, P_O, (float*)WSB(WS_SS), (unsigned*)KWS + CW_Q + 64 * (16 * rep + 4 * l + 2));
            GRID_BAR();
        }
        if (IN(PH_WOUT)) for (int rep = 0; rep <= ((KINT(7) >> PH_WOUT) & 1); ++rep) {
            GBX(); pg8::Gemm g{P_O, P_WL(l, WL_OUT), M, DM, DM}; pg8::StaticOrder S; S.init(M, DM, G, bx);
            LAS f32x4* rf = (LAS f32x4*)(lds_raw + L_RF);
            pg8::Unit u0, u1; const bool h0 = S.next(0, u0), h1 = S.next(1, u1);
            { int t_ = wv * 64 + lane_id_fresh(); asm volatile("" : "+v"(t_));
              const bool hv = t_ < 256 ? h0 : h1; const int row = (t_ < 256 ? u0.pm : u1.pm) * 256 + (t_ & 255);
              if (hv) { const GAS f32x4* sp = (const GAS f32x4*)((const float*)WSB(WS_SS) + (size_t)row * 16); const f32x4 a = sp[0], b = sp[1], c = sp[2], d = sp[3];
                  const float qa = ((a[0] + a[1]) + (a[2] + a[3])) * (1.f / 256.f) + RMS_EPS, qb = ((b[0] + b[1]) + (b[2] + b[3])) * (1.f / 256.f) + RMS_EPS,
                              qc = (((c[0] + c[1]) + (c[2] + c[3])) + ((d[0] + d[1]) + (d[2] + d[3]))) * (1.f / 512.f) + RMS_EPS;
                  rf[t_] = (f32x4){sqrtf(qb / qa), sqrtf(qc / qb), rsqrtf(qc), 0.f}; } }
            __syncthreads();
            pg8::EpiYGn E{P_Y, DM, rf, u0.pm}; pg8::GnHook KH{rf};
            pg8::gemm_phase<pg8::EpiYGn, pg8::StaticOrder, true, true, pg8::GnHook>(lds_raw, g, S, E, wv, KH);
            GRID_BAR();
        }
        if (IN(PH_NORM2)) for (int rep = 0; rep <= ((KINT(7) >> PH_NORM2) & 1); ++rep) { FRAME(); norm_phase(F, KIN(0), P_Y, KIN(6) + l * DM, P_MOD(l), 2, nullptr, nullptr, 0, nullptr, KIN(7) + l * DM, P_MOD(l), 4, 3, P_H, l == 0 ? (const bf16*)nullptr : (const bf16*)KOUT); GRID_BAR(); }
        if (IN(PH_GU)) for (int rep = 0; rep <= ((KINT(7) >> PH_GU) & 1); ++rep) {
            GBX(); pg8::Gemm g{P_H, P_WL(l, WL_GU), M, 2 * FFN, DM}; pg8::StaticOrder S; S.init(M, 2 * FFN, G, bx);
            pg8::EpiSwiglu E{P_U};
            pg8::gemm_phase<pg8::EpiSwiglu, pg8::StaticOrder, true, true>(lds_raw, g, S, E, wv);
            GRID_BAR();
        }
        if (IN(PH_DOWN)) for (int rep = 0; rep <= ((KINT(7) >> PH_DOWN) & 1); ++rep) {
            GBX(); pg8::Gemm g{P_U, P_WL(l, WL_DOWN), M, DM, FFN}; pg8::StaticOrder S; S.init(M, DM, G, bx);
            pg8::EpiY E{P_Y2, DM};
            pg8::gemm_phase<pg8::EpiY, pg8::StaticOrder, true, true>(lds_raw, g, S, E, wv);
            GRID_BAR();
        }
        if (IN(PH_NORM3)) {
            const bool last = (l == DEPTH - 1); FRAME();
            norm_phase(F, KIN(0), P_Y, KIN(6) + l * DM, P_MOD(l), 2, P_Y2, KIN(8) + l * DM, 5, KOUT, KIN(5) + (last ? l : l + 1) * DM, P_MOD(last ? l : l + 1), 1, 0, last ? (bf16*)nullptr : P_H,
                       l == 0 ? (const bf16*)nullptr : (const bf16*)KOUT, last ? (bf16*)nullptr : (bf16*)KOUT);
            if (!last) GRID_BAR();
        }
}
__global__ void __launch_bounds__(NTHR, 2) __attribute__((target("no-packed-fp32-ops"))) mega(MArgs a) {
    extern __shared__ __attribute__((aligned(16))) unsigned char lds_dyn[];
    LAS unsigned char* lds_raw = (LAS unsigned char*)lds_dyn;
    const int G0 = gridDim.x, bx0 = blockIdx.x;
    const int wv = __builtin_amdgcn_readfirstlane((int)(threadIdx.x >> 6));
    { FRAME();
    for (int u = F.tid; u < (LDS_BYTES - LDSCTL_OFF) / 4; u += NTHR) ((LAS unsigned*)(F.lds + LDSCTL_OFF))[u] = 0u;
    __syncthreads(); }
    XcdBarrier bar; bar.bar = (unsigned*)KWS + CW_BAR; bar.x = 0; bar.st = nullptr; bar.wv = wv;
    if (KINT(5)) bar = xcd_barrier_post((unsigned*)KWS + CW_BAR, (volatile LAS unsigned*)(lds_raw + LDSCTL_OFF + 32), wv);
    if (KINT(4) & 1) for (int rep = 0; rep <= ((KINT(7) >> 9) & 1); ++rep) { FRAME(); pro_a(F); GRID_BAR(); }
    if (KINT(4) & 2) { FRAME(); cb1_finish(F); norm_phase(F, KIN(0), nullptr, nullptr, nullptr, 0, nullptr, nullptr, 0, nullptr, KIN(5), P_MOD(0), 1, 0, P_H); GRID_BAR(); }
    layer_body<0>(lds_raw, wv, bar, G0, bx0);
    layer_body<1>(lds_raw, wv, bar, G0, bx0);
    layer_body<2>(lds_raw, wv, bar, G0, bx0);
    layer_body<3>(lds_raw, wv, bar, G0, bx0);
}
#ifndef DUP_MASK
#define DUP_MASK 0
#endif
extern "C" void kernel_launch(void* const* d_in, const int* in_sizes, int n_in, void* d_out, int out_size, void* d_ws, size_t ws_size, hipStream_t stream) {
    if (n_in != 20 || out_size != M * DM || ws_size < WS_END) { fprintf(stderr, "kernel_launch: unexpected sizes n_in %d out %d ws %zu\n", n_in, out_size, ws_size); return; }
    static int grid = 0;
    if (grid == 0) {
        int dev = 0, cus = 0;
        if (hipGetDevice(&dev) != hipSuccess || hipDeviceGetAttribute(&cus, hipDeviceAttributeMultiprocessorCount, dev) != hipSuccess) { grid = -1; return; }
        if (hipFuncSetAttribute((const void*)mega, hipFuncAttributeMaxDynamicSharedMemorySize, LDS_BYTES) != hipSuccess) { fprintf(stderr, "hipFuncSetAttribute failed\n"); grid = -1; return; }
        int per_cu = 0;
        if (hipOccupancyMaxActiveBlocksPerMultiprocessor(&per_cu, (const void*)mega, NTHR, LDS_BYTES) != hipSuccess || per_cu < 1) { fprintf(stderr, "occupancy query reports %d workgroups per CU\n", per_cu); (void)hipGetLastError(); grid = -1; return; }
        grid = cus;
        if (grid != 256) { fprintf(stderr, "kernel_launch: this kernel is laid out for a 256-CU device (one workgroup per CU); found %d CUs\n", cus); grid = -1; return; }
    }
    if (grid < 0) return;
    (void)hipMemsetAsync(d_ws, 0, 64 * 1024, stream);
    MArgs a{};
    for (int i = 0; i < 20; ++i) a.in[i] = (const float*)d_in[i];
    a.out = (float*)d_out; a.ws = (unsigned char*)d_ws;
    a.lay_lo = 0; a.lay_hi = DEPTH; a.ph_lo = 0; a.ph_hi = NPH; a.do_pro = 3; a.use_bar = 1; a.att_mask = 7; a.pad = DUP_MASK;
    hipLaunchKernelGGL(mega, dim3(grid), dim3(NTHR), LDS_BYTES, stream, a);
}
```
